# Optimizing an MI355X kernel written in HIP

```python
import math
import jax
import jax.numpy as jnp
from jax import lax
import numpy as np

D_MODEL = 1024
BATCH = 16
SEQ = 256
DEPTH = 2
DEC_BATCH = 2
DEC_SEQ = 1024
PAST_LEN = 512

GRID_W = 64
Q_BLOCK = 128
CHUNK = 32
ROPE_THETA = 10000.0
EPS = 1e-6
LB_FLOOR = 1e-30
N_MOD = 6
N_BRANCH = 4
BRANCH_W = D_MODEL // 4
A_HEADS = 4
A_KV_HEADS = 2
A_HEAD_DIM = BRANCH_W // A_HEADS
C_HEADS = 4
C_HEAD_DIM = BRANCH_W // (2 * C_HEADS)
B_HEADS = 4
B_KEY_DIM = BRANCH_W // B_HEADS
B_VAL_DIM = BRANCH_W // B_HEADS
D_HEADS = 4
D_KEY_DIM = BRANCH_W // (2 * D_HEADS)
D_VAL_DIM = BRANCH_W // D_HEADS
D_GATE_RANK = 16
D_GATE_TAU = 16.0
D_FF = 11 * D_MODEL // 4
CONV_WIDTH = 3
IN_SPLITS = (
    A_HEADS * A_HEAD_DIM, A_KV_HEADS * A_HEAD_DIM, A_KV_HEADS * A_HEAD_DIM,
    2 * C_HEADS * C_HEAD_DIM, 2 * C_HEADS * C_HEAD_DIM, 2 * C_HEADS * C_HEAD_DIM,
    B_HEADS * B_KEY_DIM, B_HEADS * B_VAL_DIM, B_HEADS * B_KEY_DIM, B_HEADS * B_KEY_DIM, B_HEADS * B_VAL_DIM,
    D_HEADS * D_KEY_DIM, D_HEADS * D_KEY_DIM, D_HEADS * D_VAL_DIM, D_HEADS * D_VAL_DIM, D_GATE_RANK, D_GATE_RANK,
    N_BRANCH * D_MODEL,
)
IN_WIDTH = sum(IN_SPLITS)

kernel_name = 'hybrid_diffusion_prefix_trunk_step'


def rms_norm(x, g):
    xf = x.astype(jnp.float32)
    y = xf * lax.rsqrt(jnp.mean(xf * xf, axis=-1, keepdims=True) + EPS)
    return (y * g.astype(jnp.float32)).astype(x.dtype)


def axial_rope_tables(n_tokens, head_dim):
    rows = n_tokens // GRID_W
    row = jnp.repeat(jnp.arange(rows), GRID_W).astype(jnp.float32)
    col = jnp.tile(jnp.arange(GRID_W), rows).astype(jnp.float32)
    half = head_dim // 2
    freqs = ROPE_THETA ** (-jnp.arange(0, half, 2, dtype=jnp.float32) / half)
    ang_r = row[:, None] * freqs
    ang_c = col[:, None] * freqs
    ang = jnp.concatenate([ang_r, ang_r, ang_c, ang_c], axis=-1)
    return jnp.cos(ang), jnp.sin(ang)


def apply_rope(x, cos, sin):
    q4 = x.shape[-1] // 4
    xs = x.reshape(x.shape[:-1] + (2, 2, q4))
    rot = jnp.concatenate([-xs[..., 1:2, :], xs[..., 0:1, :]], axis=-2).reshape(x.shape)
    y = x.astype(jnp.float32) * cos[:, None, :] + rot.astype(jnp.float32) * sin[:, None, :]
    return y.astype(x.dtype)


def attend(q, k, v, scale):
    b, tq = q.shape[:2]
    nb = tq // Q_BLOCK
    qb = jnp.moveaxis(q.reshape((b, nb, Q_BLOCK) + q.shape[2:]), 1, 0)
    kf = k.astype(jnp.float32)
    vf = v.astype(jnp.float32)

    def block(qblk):
        s = jnp.einsum('bqgrd,bkgd->bgrqk', qblk.astype(jnp.float32), kf) * scale
        p = jax.nn.softmax(s, axis=-1)
        return jnp.einsum('bgrqk,bkgv->bqgrv', p, vf)

    o = lax.map(block, qb)
    return jnp.moveaxis(o, 0, 1).reshape((b, tq) + o.shape[3:]).astype(q.dtype)


def chunked_gla(q, k, v, log_a, s0):
    bsz, t, h, dk = q.shape
    dv = v.shape[-1]
    n = t // CHUNK
    q, k, log_a = [a.astype(jnp.float32).reshape(bsz, n, CHUNK, h, dk) for a in (q, k, log_a)]
    v = v.astype(jnp.float32).reshape(bsz, n, CHUNK, h, dv)
    cum = jnp.cumsum(log_a, axis=2)
    cum_last = cum[:, :, -1]
    mask = jnp.tril(jnp.ones((CHUNK, CHUNK), dtype=bool))[:, :, None, None]
    diff = cum[:, :, :, None] - cum[:, :, None, :]
    decay = jnp.where(mask, jnp.exp(jnp.where(mask, diff, 0.0)), 0.0)
    scores = jnp.einsum('bnthk,bnshk,bntshk->bnhts', q, k, decay)
    o_intra = jnp.einsum('bnhts,bnshv->bnthv', scores, v)
    q_in = q * jnp.exp(cum)
    k_out = k * jnp.exp(cum_last[:, :, None] - cum)

    def step(s, xs):
        qi, ko, vc, cl = xs
        o = jnp.einsum('bthk,bhkv->bthv', qi, s)
        s = jnp.exp(cl)[..., None] * s + jnp.einsum('bthk,bthv->bhkv', ko, vc)
        return s, o

    xs = tuple(jnp.moveaxis(a, 1, 0) for a in (q_in, k_out, v, cum_last))
    s_final, o_inter = lax.scan(step, s0.astype(jnp.float32), xs)
    o = o_intra + jnp.moveaxis(o_inter, 0, 1)
    return o.reshape(bsz, t, h, dv), s_final


def bidir_gla(q, k_f, k_b, v, la_f, la_b, s0_f, s0_b):
    o_f, s_f = chunked_gla(q, k_f, v, la_f, s0_f)
    flip = lambda a: jnp.flip(a, axis=1)
    o_b, s_b = chunked_gla(flip(q), flip(k_b), flip(v), flip(la_b), s0_b)
    return o_f + flip(o_b), s_f, s_b


def hgrn_forget(z, lb):
    z = z.astype(jnp.float32)
    log_f = jnp.logaddexp(jnp.log(jnp.maximum(lb, LB_FLOOR)), jnp.log1p(-lb) + jax.nn.log_sigmoid(z))
    k = (1.0 - lb) * jax.nn.sigmoid(-z)
    return k, log_f


def conv_ffn(h, w_up, conv_w, conv_b, w_down):
    u = h @ w_up
    pad = CONV_WIDTH // 2
    t = u.shape[1]
    up = jnp.pad(u, ((0, 0), (pad, pad), (0, 0)))
    u = sum(up[:, j:j + t] * conv_w[j] for j in range(CONV_WIDTH)) + conv_b
    a, g = jnp.split(u, 2, axis=-1)
    return (jax.nn.silu(g) * a) @ w_down


def trunk_layer(x, cond, ctx, p, lam_init):
    bsz, t, _ = x.shape
    dt = x.dtype
    mod = jax.nn.silu(cond) @ p['w_ada'] + p['b_ada']
    sh1, sc1, g1, sh2, sc2, g2 = [m[:, None, :] for m in jnp.split(mod, N_MOD, axis=-1)]
    h = rms_norm(x, p['norm1_g']) * (1 + sc1) + sh1
    z = h @ p['w_in']
    (a_q, a_k, a_v, c_q, c_k, c_v, b_q, b_i, b_ff, b_fb, b_g,
     d_q, d_k, d_v, d_g, d_rf, d_rb, merge_logits) = jnp.split(z, np.cumsum(IN_SPLITS)[:-1].tolist(), axis=-1)

    aq = rms_norm(a_q.reshape(bsz, t, A_HEADS, A_HEAD_DIM), p['a_qn_g'])
    ak = rms_norm(a_k.reshape(bsz, t, A_KV_HEADS, A_HEAD_DIM), p['a_kn_g'])
    av = a_v.reshape(bsz, t, A_KV_HEADS, A_HEAD_DIM)
    cq = rms_norm(c_q.reshape(bsz, t, 2 * C_HEADS, C_HEAD_DIM), p['c_qn_g'])
    ck = rms_norm(c_k.reshape(bsz, t, 2 * C_HEADS, C_HEAD_DIM), p['c_kn_g'])
    cv = c_v.reshape(bsz, t, C_HEADS, 2 * C_HEAD_DIM)

    if ctx is None:
        ctx_out = [ak, av, ck.reshape(bsz, t, C_HEADS, 2, C_HEAD_DIM), cv]
        s_hgrn = jnp.zeros((bsz, 2, B_HEADS, B_KEY_DIM, B_VAL_DIM), jnp.float32)
        s_gla = jnp.zeros((bsz, 2, D_HEADS, D_KEY_DIM, D_VAL_DIM), jnp.float32)
    else:
        ctx_ak, ctx_av, ctx_ck, ctx_cv, s_hgrn, s_gla = ctx
        cos_a, sin_a = axial_rope_tables(t, A_HEAD_DIM)
        cos_c, sin_c = axial_rope_tables(t, C_HEAD_DIM)
        aq = apply_rope(aq, cos_a, sin_a)
        ak = jnp.concatenate([ctx_ak, apply_rope(ak, cos_a, sin_a)], axis=1)
        av = jnp.concatenate([ctx_av, av], axis=1)
        cq = apply_rope(cq, cos_c, sin_c)
        ck = jnp.concatenate([ctx_ck.reshape(bsz, -1, 2 * C_HEADS, C_HEAD_DIM), apply_rope(ck, cos_c, sin_c)], axis=1)
        cv = jnp.concatenate([ctx_cv, cv], axis=1)

    y_a = attend(aq.reshape(bsz, t, A_KV_HEADS, A_HEADS // A_KV_HEADS, A_HEAD_DIM), ak, av,
                 A_HEAD_DIM ** -0.5).reshape(bsz, t, BRANCH_W)

    cq = cq.reshape(bsz, t, C_HEADS, 2, C_HEAD_DIM)
    ck = ck.reshape(bsz, -1, C_HEADS, 2, C_HEAD_DIM)
    o1 = attend(cq[:, :, :, 0:1], ck[:, :, :, 0], cv, C_HEAD_DIM ** -0.5)
    o2 = attend(cq[:, :, :, 1:2], ck[:, :, :, 1], cv, C_HEAD_DIM ** -0.5)
    lq1, lk1, lq2, lk2 = p['c_lambda'].astype(jnp.float32)
    lam = jnp.exp(jnp.sum(lq1 * lk1)) - jnp.exp(jnp.sum(lq2 * lk2)) + lam_init
    y_c = (rms_norm((o1 - lam * o2)[:, :, :, 0], p['c_subln_g']) * (1.0 - lam_init)).reshape(bsz, t, BRANCH_W)

    bq = jax.nn.silu(b_q).reshape(bsz, t, B_HEADS, B_KEY_DIM)
    bi = b_i.reshape(bsz, t, B_HEADS, B_VAL_DIM)
    lb = p['b_lb'].reshape(2, B_HEADS, B_KEY_DIM)
    kb_f, lf_f = hgrn_forget(b_ff.reshape(bsz, t, B_HEADS, B_KEY_DIM), lb[0])
    kb_b, lf_b = hgrn_forget(b_fb.reshape(bsz, t, B_HEADS, B_KEY_DIM), lb[1])
    o_b, sb_f, sb_b = bidir_gla(bq, kb_f, kb_b, bi, lf_f, lf_b, s_hgrn[:, 0], s_hgrn[:, 1])
    y_b = (rms_norm(o_b, p['b_norm_g']) * jax.nn.silu(b_g.reshape(bsz, t, B_HEADS, B_VAL_DIM))).reshape(bsz, t, BRANCH_W)

    dq = d_q.reshape(bsz, t, D_HEADS, D_KEY_DIM) * D_KEY_DIM ** -0.5
    dk = d_k.reshape(bsz, t, D_HEADS, D_KEY_DIM)
    dv = d_v.reshape(bsz, t, D_HEADS, D_VAL_DIM)
    la_f, la_b = [(jax.nn.log_sigmoid((r @ p['d_alpha_w'][i] + p['d_alpha_b'][i]).astype(jnp.float32))
                   / D_GATE_TAU).reshape(bsz, t, D_HEADS, D_KEY_DIM) for i, r in enumerate((d_rf, d_rb))]
    o_d, sd_f, sd_b = bidir_gla(dq, dk, dk, dv, la_f, la_b, s_gla[:, 0], s_gla[:, 1])
    y_d = (rms_norm(o_d, p['d_norm_g']) * jax.nn.silu(d_g.reshape(bsz, t, D_HEADS, D_VAL_DIM))).reshape(bsz, t, BRANCH_W)

    branches = jnp.stack([y_a, y_b, y_c, y_d], axis=2).astype(dt)
    proj = jnp.einsum('btnw,nwd->btnd', branches, p['w_branch'])
    gates = jax.nn.sigmoid(merge_logits.reshape(bsz, t, N_BRANCH, D_MODEL))
    mixed = jnp.sum(gates * proj, axis=2) @ p['w_out']
    x = x + g1 * mixed

    h2 = rms_norm(x, p['norm2_g']) * (1 + sc2) + sh2
    x = x + g2 * conv_ffn(h2, p['w_up'], p['conv_w'], p['conv_b'], p['w_down'])
    if ctx is None:
        ctx_out = ctx_out + [jnp.stack([sb_f, sb_b], axis=1), jnp.stack([sd_f, sd_b], axis=1)]
        return x, ctx_out
    return x, None


def setup_inputs(seed: int = 0) -> dict:
    key = jax.random.key(seed)
    ks = iter(jax.random.split(key, 40))

    def nrm(shape, scale):
        return jax.random.normal(next(ks), shape, jnp.float32) * scale

    def gain(shape):
        return 1.0 + nrm(shape, 0.02)

    return {
        'x_prompt': nrm((BATCH, SEQ, D_MODEL), 1.0),
        'x_sample': nrm((DEC_BATCH, DEC_SEQ, D_MODEL), 1.0),
        'cache_a_k': nrm((DEC_BATCH, DEPTH, PAST_LEN, A_KV_HEADS, A_HEAD_DIM), 1.0),
        'cache_a_v': nrm((DEC_BATCH, DEPTH, PAST_LEN, A_KV_HEADS, A_HEAD_DIM), 1.0),
        'cache_c_k': nrm((DEC_BATCH, DEPTH, PAST_LEN, C_HEADS, 2, C_HEAD_DIM), 1.0),
        'cache_c_v': nrm((DEC_BATCH, DEPTH, PAST_LEN, C_HEADS, 2 * C_HEAD_DIM), 1.0),
        'state_hgrn': nrm((DEC_BATCH, DEPTH, 2, B_HEADS, B_KEY_DIM, B_VAL_DIM), 0.5),
        'state_gla': nrm((DEC_BATCH, DEPTH, 2, D_HEADS, D_KEY_DIM, D_VAL_DIM), 0.5),
        'c': nrm((DEC_BATCH, D_MODEL), 1.0),
        'c_ctx': nrm((D_MODEL,), 1.0),
        'w_ada': nrm((DEPTH, D_MODEL, N_MOD * D_MODEL), 0.5 * D_MODEL ** -0.5),
        'b_ada': nrm((DEPTH, N_MOD * D_MODEL), 0.02),
        'norm1_g': gain((DEPTH, D_MODEL)),
        'norm2_g': gain((DEPTH, D_MODEL)),
        'w_in': nrm((DEPTH, D_MODEL, IN_WIDTH), D_MODEL ** -0.5),
        'a_qn_g': gain((DEPTH, A_HEAD_DIM)),
        'a_kn_g': gain((DEPTH, A_HEAD_DIM)),
        'c_qn_g': gain((DEPTH, C_HEAD_DIM)),
        'c_kn_g': gain((DEPTH, C_HEAD_DIM)),
        'c_lambda': nrm((DEPTH, 4, C_HEAD_DIM), 0.1),
        'c_subln_g': gain((DEPTH, 2 * C_HEAD_DIM)),
        'b_lb_logits': nrm((2, DEPTH, B_HEADS * B_KEY_DIM), 0.5),
        'b_norm_g': gain((DEPTH, B_VAL_DIM)),
        'd_alpha_w': nrm((DEPTH, 2, D_GATE_RANK, D_HEADS * D_KEY_DIM), D_GATE_RANK ** -0.5),
        'd_alpha_b': nrm((DEPTH, 2, D_HEADS * D_KEY_DIM), 0.1),
        'd_norm_g': gain((DEPTH, D_VAL_DIM)),
        'w_branch': nrm((DEPTH, N_BRANCH, BRANCH_W, D_MODEL), BRANCH_W ** -0.5),
        'w_out': nrm((DEPTH, D_MODEL, D_MODEL), D_MODEL ** -0.5),
        'w_up': nrm((DEPTH, D_MODEL, 2 * D_FF), D_MODEL ** -0.5),
        'conv_w': nrm((DEPTH, CONV_WIDTH, 2 * D_FF), CONV_WIDTH ** -0.5),
        'conv_b': nrm((DEPTH, 2 * D_FF), 0.01),
        'w_down': nrm((DEPTH, D_FF, D_MODEL), D_FF ** -0.5),
    }


def reference(x_prompt, x_sample, cache_a_k, cache_a_v, cache_c_k, cache_c_v, state_hgrn, state_gla,
              c, c_ctx, w_ada, b_ada, norm1_g, norm2_g, w_in, a_qn_g, a_kn_g, c_qn_g, c_kn_g,
              c_lambda, c_subln_g, b_lb_logits, b_norm_g, d_alpha_w, d_alpha_b, d_norm_g,
              w_branch, w_out, w_up, conv_w, conv_b, w_down):
    lb_p = jax.nn.softmax(b_lb_logits.astype(jnp.float32), axis=1)
    lb_all = jnp.cumsum(lb_p, axis=1) - lb_p[:, :1]
    y_prompt = x_prompt
    y_sample = x_sample
    collected = [[] for _ in range(6)]
    for l in range(DEPTH):
        p = {
            'w_ada': w_ada[l], 'b_ada': b_ada[l], 'norm1_g': norm1_g[l], 'norm2_g': norm2_g[l],
            'w_in': w_in[l], 'a_qn_g': a_qn_g[l], 'a_kn_g': a_kn_g[l], 'c_qn_g': c_qn_g[l],
            'c_kn_g': c_kn_g[l], 'c_lambda': c_lambda[l], 'c_subln_g': c_subln_g[l],
            'b_lb': lb_all[:, l], 'b_norm_g': b_norm_g[l], 'd_alpha_w': d_alpha_w[l],
            'd_alpha_b': d_alpha_b[l], 'd_norm_g': d_norm_g[l], 'w_branch': w_branch[l],
            'w_out': w_out[l], 'w_up': w_up[l], 'conv_w': conv_w[l], 'conv_b': conv_b[l],
            'w_down': w_down[l],
        }
        lam_init = 0.8 - 0.6 * math.exp(-0.3 * l)
        y_prompt, ctx_l = trunk_layer(y_prompt, c_ctx[None, :], None, p, lam_init)
        cached = (cache_a_k[:, l], cache_a_v[:, l], cache_c_k[:, l], cache_c_v[:, l],
                  state_hgrn[:, l], state_gla[:, l])
        y_sample, _ = trunk_layer(y_sample, c, cached, p, lam_init)
        for acc, arr in zip(collected, ctx_l):
            acc.append(arr)
    new_cache_a_k, new_cache_a_v, new_cache_c_k, new_cache_c_v, new_state_hgrn, new_state_gla = [
        jnp.stack(acc, axis=1) for acc in collected]
    return (y_prompt, y_sample, new_cache_a_k, new_cache_a_v, new_cache_c_k, new_cache_c_v, new_state_hgrn, new_state_gla)
```

```cpp
#include <hip/hip_runtime.h>
#include <hip/hip_bf16.h>
#include <hip/hip_cooperative_groups.h>
#include <cstdio>
namespace cg = cooperative_groups;

#ifndef MULTI
#define MULTI 0
#endif

#define DI __device__ __forceinline__
typedef unsigned short u16;
using bf16x8 = __attribute__((ext_vector_type(8))) short;
using s16x4  = __attribute__((ext_vector_type(4))) short;
using f32x16 = __attribute__((ext_vector_type(16))) float;
using u32x4  = __attribute__((ext_vector_type(4))) unsigned;
using u32x2  = __attribute__((ext_vector_type(2))) unsigned;
#define MFMA(a, b, c) __builtin_amdgcn_mfma_f32_32x32x16_bf16((a), (b), (c), 0, 0, 0)

constexpr int NTOK = 6144, NCTX = 4096, DM = 1024, INW = 7456, DFF = 2816, DFF2 = 5632;
constexpr int ZA_Q = 0, ZA_K = 256, ZA_V = 384, ZC_Q = 512, ZC_K = 768, ZC_V = 1024, ZB_Q = 1280, ZB_I = 1536, ZB_FF = 1792,
              ZB_FB = 2048, ZB_G = 2304, ZD_Q = 2560, ZD_K = 2688, ZD_V = 2816, ZD_G = 3072, ZD_RF = 3328, Z_ML = 3360;
constexpr float EPSN = 1e-6f;
constexpr size_t O_CAK = 6291456, O_CAV = 7340032, O_CCK = 8388608, O_CCV = 10485760, O_SH = 12582912, O_SG = 13631488;
constexpr size_t WS_WIN = 0;
constexpr size_t WS_WBR = WS_WIN + (size_t)INW * 1024 * 2;
constexpr size_t WS_WOUT = WS_WBR + (size_t)4 * 1024 * 256 * 2;
constexpr size_t WS_WUP = WS_WOUT + (size_t)1024 * 1024 * 2;
constexpr size_t WS_WDN = WS_WUP + (size_t)DFF2 * 1024 * 2;
constexpr size_t WS_MOD = WS_WDN + (size_t)1024 * DFF * 2;
constexpr size_t WS_H = WS_MOD + (size_t)2 * 3 * 6144 * 4;
constexpr size_t WS_Z = WS_H + (size_t)NTOK * 1024 * 2;
constexpr size_t WS_QA = WS_Z + (size_t)NTOK * INW * 2;
constexpr size_t WS_QC = WS_QA + (size_t)NTOK * 256 * 2;
constexpr size_t WS_KA = WS_QC + (size_t)NTOK * 256 * 2;
constexpr size_t WS_VA = WS_KA + (size_t)7168 * 128 * 2;
constexpr size_t WS_KC = WS_VA + (size_t)7168 * 128 * 2;
constexpr size_t WS_VC = WS_KC + (size_t)7168 * 256 * 2;
constexpr size_t WS_YCAT = WS_VC + (size_t)7168 * 256 * 2;
constexpr size_t WS_ACT = WS_YCAT + (size_t)NTOK * 1024 * 2;
constexpr size_t WS_MIX = WS_ACT + (size_t)NTOK * DFF * 2;
constexpr size_t WS_CL = WS_MIX + (size_t)NTOK * 1024 * 2;
constexpr size_t WS_U = WS_ACT;
constexpr size_t WS_S = WS_CL + (size_t)2304 * 64 * 4;
constexpr size_t WS_END = WS_S + (size_t)2304 * 4096 * 4;
static_assert((size_t)2304 * 4096 * 4 <= (size_t)NTOK * DFF * 2 + (size_t)NTOK * 1024 * 2, "U alias");
static_assert(WS_END <= (size_t)256 * 1024 * 1024, "ws budget");
constexpr int SMEM_BYTES = 73728;
constexpr int NPHASE = 23;

struct Params {
  const float *x_prompt, *x_sample, *cache_a_k, *cache_a_v, *cache_c_k, *cache_c_v, *state_hgrn, *state_gla, *c, *c_ctx,
      *w_ada, *b_ada, *norm1_g, *norm2_g, *w_in, *a_qn_g, *a_kn_g, *c_qn_g, *c_kn_g, *c_lambda, *c_subln_g, *b_lb_logits,
      *b_norm_g, *d_alpha_w, *d_alpha_b, *d_norm_g, *w_branch, *w_out, *w_up, *conv_w, *conv_b, *w_down;
  float* out;
  char* ws;
  int phase_begin, phase_end, coop, pad;
};

DI int tid_() { int t = __builtin_amdgcn_workitem_id_x(); asm volatile("" : "+v"(t)); return t; }
DI float bf2f(u16 u) { return __uint_as_float(((unsigned)u) << 16); }
DI u16 f2bf(float a) { __hip_bfloat16 b = __float2bfloat16(a); return *(u16*)&b; }
DI unsigned pack2(float a, float b) { __hip_bfloat162 q = __float22bfloat162_rn(make_float2(a, b)); return *(unsigned*)&q; }
DI float lo_bf(unsigned u) { return __uint_as_float(u << 16); }
DI float hi_bf(unsigned u) { return __uint_as_float(u & 0xffff0000u); }
DI float sigmoidf_(float x) { return 1.f / (1.f + __expf(-x)); }
DI int crow(int e, int h) { return (e & 3) + 8 * (e >> 2) + 4 * h; }
DI bf16x8 pack8(const f32x16& x, int s) {
  u32x4 q;
  q[0] = pack2(x[8 * s + 0], x[8 * s + 1]); q[1] = pack2(x[8 * s + 2], x[8 * s + 3]);
  q[2] = pack2(x[8 * s + 4], x[8 * s + 5]); q[3] = pack2(x[8 * s + 6], x[8 * s + 7]);
  return __builtin_bit_cast(bf16x8, q);
}
DI s16x4 trread(const u16* pl) {
  return __builtin_amdgcn_ds_read_tr16_b64_v4i16((__attribute__((address_space(3))) s16x4*)pl);
}
DI bf16x8 trpair(const u16* p0, const u16* p1) {
  s16x4 a = trread(p0), b = trread(p1);
  return __builtin_shufflevector(a, b, 0, 1, 2, 3, 4, 5, 6, 7);
}
DI float wave_sum(float v) {
#pragma unroll
  for (int o = 32; o >= 1; o >>= 1) v += __shfl_xor(v, o);
  return v;
}
DI int tok_cond(int t) { return t < NCTX ? 0 : 1 + ((t - NCTX) >> 10); }
DI const float* xin_row(const Params& p, int l, int tok) {
  if (l > 0) return p.out + (size_t)tok * DM;
  return tok < NCTX ? p.x_prompt + (size_t)tok * DM : p.x_sample + (size_t)(tok - NCTX) * DM;
}

DI void convw_tile(const float* __restrict__ src, u16* __restrict__ dst, int K, int N, int item, float* T) {
  const int t = tid_();
  const int ntn = N >> 5;
  const int n0 = (item % ntn) * 32, k0 = (item / ntn) * 64;
#pragma unroll
  for (int i = 0; i < 2; ++i) {
    const int kl = (t >> 3) + 32 * i, n4 = t & 7;
    const float4 v = *(const float4*)(src + (size_t)(k0 + kl) * N + n0 + 4 * n4);
    T[(4 * n4 + 0) * 65 + kl] = v.x; T[(4 * n4 + 1) * 65 + kl] = v.y;
    T[(4 * n4 + 2) * 65 + kl] = v.z; T[(4 * n4 + 3) * 65 + kl] = v.w;
  }
  __syncthreads();
  {
    const int n = t >> 3, k8 = (t & 7) * 8;
    const float* tr = T + n * 65 + k8;
    u32x4 q;
    q[0] = pack2(tr[0], tr[1]); q[1] = pack2(tr[2], tr[3]); q[2] = pack2(tr[4], tr[5]); q[3] = pack2(tr[6], tr[7]);
    *(u32x4*)(dst + (size_t)(n0 + n) * K + k0 + k8) = q;
  }
  __syncthreads();
}
constexpr int CONVW_ITEMS = 8976;
DI void convw_item(const Params& p, int l, int item, char* sm) {
  float* T = (float*)sm;
  char* ws = p.ws;
  if (item < 3728) convw_tile(p.w_in + (size_t)l * 1024 * INW, (u16*)(ws + WS_WIN), 1024, INW, item, T);
  else if (item < 4240) {
    const int it = item - 3728, n = it >> 7;
    convw_tile(p.w_branch + (size_t)(l * 4 + n) * 256 * 1024, (u16*)(ws + WS_WBR) + (size_t)n * 1024 * 256, 256, 1024, it & 127, T);
  } else if (item < 4752) convw_tile(p.w_out + (size_t)l * 1024 * 1024, (u16*)(ws + WS_WOUT), 1024, 1024, item - 4240, T);
  else if (item < 7568) convw_tile(p.w_up + (size_t)l * 1024 * DFF2, (u16*)(ws + WS_WUP), 1024, DFF2, item - 4752, T);
  else convw_tile(p.w_down + (size_t)l * DFF * 1024, (u16*)(ws + WS_WDN), DFF, 1024, item - 7568, T);
}

DI void mod_item(const Params& p, int item, char* sm) {
  float* sc = (float*)sm;
  float* red = sc + 3072;
  const int t = tid_();
  const int l = item / 96, j0 = (item % 96) * 64;
  for (int i = t; i < 3072; i += 256) {
    const int cnd = i >> 10, k = i & 1023;
    const float v = cnd == 0 ? p.c_ctx[k] : p.c[(cnd - 1) * 1024 + k];
    sc[i] = v * sigmoidf_(v);
  }
  __syncthreads();
  const int cq = t & 15, ks = t >> 4;
  float a0[4] = {0, 0, 0, 0}, a1[4] = {0, 0, 0, 0}, a2[4] = {0, 0, 0, 0};
  const float* wp = p.w_ada + (size_t)l * 1024 * 6144 + j0 + 4 * cq;
#pragma unroll 4
  for (int rr = 0; rr < 64; ++rr) {
    const int row = ks * 64 + rr;
    const float4 w4 = *(const float4*)(wp + (size_t)row * 6144);
    const float s0 = sc[row], s1 = sc[1024 + row], s2 = sc[2048 + row];
    a0[0] += s0 * w4.x; a0[1] += s0 * w4.y; a0[2] += s0 * w4.z; a0[3] += s0 * w4.w;
    a1[0] += s1 * w4.x; a1[1] += s1 * w4.y; a1[2] += s1 * w4.z; a1[3] += s1 * w4.w;
    a2[0] += s2 * w4.x; a2[1] += s2 * w4.y; a2[2] += s2 * w4.z; a2[3] += s2 * w4.w;
  }
#pragma unroll
  for (int q = 0; q < 4; ++q) {
    red[(ks * 3 + 0) * 64 + 4 * cq + q] = a0[q];
    red[(ks * 3 + 1) * 64 + 4 * cq + q] = a1[q];
    red[(ks * 3 + 2) * 64 + 4 * cq + q] = a2[q];
  }
  __syncthreads();
  if (t < 192) {
    const int cnd = t >> 6, col = t & 63;
    float s = p.b_ada[l * 6144 + j0 + col];
    for (int k = 0; k < 16; ++k) s += red[(k * 3 + cnd) * 64 + col];
    ((float*)(p.ws + WS_MOD))[(l * 3 + cnd) * 6144 + j0 + col] = s;
  }
  __syncthreads();
}

DI void norm_tok(const Params& p, int l, int which, int tok) {
  const int lane = tid_() & 63;
  const float* xr = which == 0 ? xin_row(p, l, tok) : p.out + (size_t)tok * DM;
  const float* g = (which == 0 ? p.norm1_g : p.norm2_g) + l * 1024;
  const float* mod = (const float*)(p.ws + WS_MOD) + (l * 3 + tok_cond(tok)) * 6144 + which * 3072;
  float4 v[4];
  float ss = 0.f;
#pragma unroll
  for (int i = 0; i < 4; ++i) {
    v[i] = *(const float4*)(xr + 4 * lane + 256 * i);
    ss += v[i].x * v[i].x + v[i].y * v[i].y + v[i].z * v[i].z + v[i].w * v[i].w;
  }
  ss = wave_sum(ss);
  const float rstd = rsqrtf(ss * (1.f / 1024.f) + EPSN);
  u16* hr = (u16*)(p.ws + WS_H) + (size_t)tok * DM;
#pragma unroll
  for (int i = 0; i < 4; ++i) {
    const int c0 = 4 * lane + 256 * i;
    const float4 gg = *(const float4*)(g + c0);
    const float4 sh = *(const float4*)(mod + c0);
    const float4 scv = *(const float4*)(mod + 1024 + c0);
    u32x2 q;
    q[0] = pack2(v[i].x * rstd * gg.x * (1.f + scv.x) + sh.x, v[i].y * rstd * gg.y * (1.f + scv.y) + sh.y);
    q[1] = pack2(v[i].z * rstd * gg.z * (1.f + scv.z) + sh.z, v[i].w * rstd * gg.w * (1.f + scv.w) + sh.w);
    *(u32x2*)(hr + c0) = q;
  }
}

template <int NJ>
DI void gemm_core(const u16* __restrict__ A, int lda, const u16* __restrict__ Bt, int ldb, int K, int m0, int n0, int N,
                  f32x16 (&acc)[2][NJ], u16* sm) {
  const int t = tid_(), lane = t & 63, w = t >> 6, r = lane & 31, h = lane >> 5;
  const int wm = w & 1, wn = w >> 1;
  u16* As = sm;
  u16* Bs = sm + 2 * 128 * 72;
  const int lrow = t >> 3, lc8 = (t & 7) * 8;
  int aoff[4], boff[2 * NJ];
#pragma unroll
  for (int i = 0; i < 4; ++i) aoff[i] = (m0 + lrow + 32 * i) * lda + lc8;
#pragma unroll
  for (int i = 0; i < 2 * NJ; ++i) {
    int bn = n0 + lrow + 32 * i;
    bn = bn < N ? bn : N - 1;
    boff[i] = bn * ldb + lc8;
  }
  u32x4 ra[4], rb[2 * NJ];
#pragma unroll
  for (int i = 0; i < 4; ++i) ra[i] = *(const u32x4*)(A + aoff[i]);
#pragma unroll
  for (int i = 0; i < 2 * NJ; ++i) rb[i] = *(const u32x4*)(Bt + boff[i]);
#pragma unroll
  for (int i = 0; i < 4; ++i) *(u32x4*)(As + (lrow + 32 * i) * 72 + lc8) = ra[i];
#pragma unroll
  for (int i = 0; i < 2 * NJ; ++i) *(u32x4*)(Bs + (lrow + 32 * i) * 72 + lc8) = rb[i];
  __syncthreads();
  const int KT = K >> 6;
  for (int kt = 0; kt < KT; ++kt) {
    const int buf = kt & 1;
    if (kt + 1 < KT) {
      const int k0 = (kt + 1) * 64;
#pragma unroll
      for (int i = 0; i < 4; ++i) ra[i] = *(const u32x4*)(A + aoff[i] + k0);
#pragma unroll
      for (int i = 0; i < 2 * NJ; ++i) rb[i] = *(const u32x4*)(Bt + boff[i] + k0);
    }
    const u16* as = As + buf * 128 * 72 + (wm * 64 + r) * 72 + 8 * h;
    const u16* bs = Bs + buf * 128 * 72 + (wn * 32 * NJ + r) * 72 + 8 * h;
#pragma unroll
    for (int ks = 0; ks < 4; ++ks) {
      const bf16x8 a0 = *(const bf16x8*)(as + ks * 16), a1 = *(const bf16x8*)(as + 32 * 72 + ks * 16);
#pragma unroll
      for (int j = 0; j < NJ; ++j) {
        const bf16x8 b0 = *(const bf16x8*)(bs + j * 32 * 72 + ks * 16);
        acc[0][j] = MFMA(a0, b0, acc[0][j]);
        acc[1][j] = MFMA(a1, b0, acc[1][j]);
      }
    }
    if (kt + 1 < KT) {
      const int nb = (buf ^ 1) * 128 * 72;
#pragma unroll
      for (int i = 0; i < 4; ++i) *(u32x4*)(As + nb + (lrow + 32 * i) * 72 + lc8) = ra[i];
#pragma unroll
      for (int i = 0; i < 2 * NJ; ++i) *(u32x4*)(Bs + nb + (lrow + 32 * i) * 72 + lc8) = rb[i];
    }
    __syncthreads();
  }
}
template <int NJ>
DI void zero_acc(f32x16 (&acc)[2][NJ]) {
#pragma unroll
  for (int i = 0; i < 2; ++i)
#pragma unroll
    for (int j = 0; j < NJ; ++j)
#pragma unroll
      for (int e = 0; e < 16; ++e) acc[i][j][e] = 0.f;
}
#define EPI_LOOP_N(NJ_, body)                                                       \
  {                                                                                 \
    const int lane_ = tid_() & 63, w_ = tid_() >> 6, r_ = lane_ & 31, h_ = lane_ >> 5; \
    _Pragma("unroll") for (int i_ = 0; i_ < 2; ++i_)                                 \
    _Pragma("unroll") for (int j_ = 0; j_ < NJ_; ++j_)                               \
    _Pragma("unroll") for (int e_ = 0; e_ < 16; ++e_) {                              \
      const int row = m0 + (w_ & 1) * 64 + i_ * 32 + crow(e_, h_);                  \
      const int col = n0 + (w_ >> 1) * 32 * NJ_ + j_ * 32 + r_;                     \
      body                                                                          \
    }                                                                               \
  }
#define EPI_LOOP(body) EPI_LOOP_N(2, body)

DI void gemm_in_item(const Params& p, int item, char* sm) {
  const int m0 = (item % 48) * 128, n0 = (item / 48) * 128;
  f32x16 acc[2][2];
  zero_acc<2>(acc);
  gemm_core<2>((const u16*)(p.ws + WS_H), 1024, (const u16*)(p.ws + WS_WIN), 1024, 1024, m0, n0, INW, acc, (u16*)sm);
  u16* z = (u16*)(p.ws + WS_Z);
  EPI_LOOP(if (col < INW) z[(size_t)row * INW + col] = f2bf(acc[i_][j_][e_]);)
}
DI void gemm_branch_item(const Params& p, int item, char* sm) {
  const int m0 = (item % 48) * 128, n0 = (item / 48) * 64;
  f32x16 tot[2][1];
  zero_acc<1>(tot);
  const u16* z = (const u16*)(p.ws + WS_Z);
#pragma unroll 1
  for (int n = 0; n < 4; ++n) {
    f32x16 acc[2][1];
    zero_acc<1>(acc);
    gemm_core<1>((const u16*)(p.ws + WS_YCAT) + n * 256, 1024, (const u16*)(p.ws + WS_WBR) + (size_t)n * 1024 * 256, 256, 256, m0, n0,
                 1024, acc, (u16*)sm);
    EPI_LOOP_N(1, const float gte = sigmoidf_(bf2f(z[(size_t)row * INW + Z_ML + n * 1024 + col]));
               tot[i_][j_][e_] += gte * acc[i_][j_][e_];)
  }
  u16* mix = (u16*)(p.ws + WS_MIX);
  EPI_LOOP_N(1, mix[(size_t)row * 1024 + col] = f2bf(tot[i_][j_][e_]);)
}
DI void gemm_out_item(const Params& p, int l, int item, char* sm) {
  const int m0 = (item % 48) * 128, n0 = (item / 48) * 128;
  f32x16 acc[2][2];
  zero_acc<2>(acc);
  gemm_core<2>((const u16*)(p.ws + WS_MIX), 1024, (const u16*)(p.ws + WS_WOUT), 1024, 1024, m0, n0, 1024, acc, (u16*)sm);
  const float* g1 = (const float*)(p.ws + WS_MOD) + (l * 3 + tok_cond(m0)) * 6144 + 2048;
  EPI_LOOP(const float xo = xin_row(p, l, row)[col]; p.out[(size_t)row * DM + col] = xo + g1[col] * acc[i_][j_][e_];)
}
DI void gemm_up_item(const Params& p, int item, char* sm) {
  const int m0 = (item % 48) * 128, n0 = (item / 48) * 128;
  f32x16 acc[2][2];
  zero_acc<2>(acc);
  gemm_core<2>((const u16*)(p.ws + WS_H), 1024, (const u16*)(p.ws + WS_WUP), 1024, 1024, m0, n0, DFF2, acc, (u16*)sm);
  u16* u = (u16*)(p.ws + WS_Z);
  EPI_LOOP(u[(size_t)row * DFF2 + col] = f2bf(acc[i_][j_][e_]);)
}
DI void gemm_down_item(const Params& p, int l, int item, char* sm) {
  const int m0 = (item % 48) * 128, n0 = (item / 48) * 128;
  f32x16 acc[2][2];
  zero_acc<2>(acc);
  gemm_core<2>((const u16*)(p.ws + WS_ACT), DFF, (const u16*)(p.ws + WS_WDN), DFF, DFF, m0, n0, 1024, acc, (u16*)sm);
  const float* g2 = (const float*)(p.ws + WS_MOD) + (l * 3 + tok_cond(m0)) * 6144 + 5120;
  EPI_LOOP(float* xp = p.out + (size_t)row * DM + col; *xp = *xp + g2[col] * acc[i_][j_][e_];)
}

DI void conv_act(const Params& p, int l, int gid, int gstride) {
  const u16* u = (const u16*)(p.ws + WS_Z);
  u16* act = (u16*)(p.ws + WS_ACT);
  const float* cw = p.conv_w + (size_t)l * 3 * DFF2;
  const float* cb = p.conv_b + (size_t)l * DFF2;
  for (int idx = gid; idx < NTOK * 352; idx += gstride) {
    const int tok = idx / 352, c0 = (idx % 352) * 8;
    int pos, L;
    if (tok < NCTX) { pos = tok & 255; L = 256; } else { pos = (tok - NCTX) & 1023; L = 1024; }
    float av[8], gv[8];
#pragma unroll
    for (int j = 0; j < 8; ++j) { av[j] = cb[c0 + j]; gv[j] = cb[DFF + c0 + j]; }
#pragma unroll
    for (int d = 0; d < 3; ++d) {
      const int pp = pos + d - 1;
      if (pp < 0 || pp >= L) continue;
      const u16* ur = u + (size_t)(tok + d - 1) * DFF2;
      const u32x4 ua = *(const u32x4*)(ur + c0), ug = *(const u32x4*)(ur + DFF + c0);
      const float* wa = cw + d * DFF2 + c0;
      const float* wg = wa + DFF;
#pragma unroll
      for (int q = 0; q < 4; ++q) {
        av[2 * q] += wa[2 * q] * lo_bf(ua[q]); av[2 * q + 1] += wa[2 * q + 1] * hi_bf(ua[q]);
        gv[2 * q] += wg[2 * q] * lo_bf(ug[q]); gv[2 * q + 1] += wg[2 * q + 1] * hi_bf(ug[q]);
      }
    }
    u32x4 o;
#pragma unroll
    for (int q = 0; q < 4; ++q)
      o[q] = pack2(gv[2 * q] * sigmoidf_(gv[2 * q]) * av[2 * q], gv[2 * q + 1] * sigmoidf_(gv[2 * q + 1]) * av[2 * q + 1]);
    *(u32x4*)(act + (size_t)tok * DFF + c0) = o;
  }
}

DI void prep_item(const Params& p, int l, int item) {
  const int lane = tid_() & 63, w = tid_() >> 6;
  char* ws = p.ws;
  u16* qA = (u16*)(ws + WS_QA); u16* qC = (u16*)(ws + WS_QC);
  u16* kA = (u16*)(ws + WS_KA); u16* vA = (u16*)(ws + WS_VA);
  u16* kC = (u16*)(ws + WS_KC); u16* vC = (u16*)(ws + WS_VC);
  if (item >= NTOK) {
    const int cr = item - NTOK, b = cr >> 9, key = cr & 511;
    const size_t keyrow = 4096 + b * 1536 + key;
    const size_t srow = (size_t)(b * 2 + l) * 512 + key;
    for (int u = w; u < 12; u += 4) {
      if (u < 2) kA[keyrow * 128 + u * 64 + lane] = f2bf(p.cache_a_k[srow * 128 + u * 64 + lane]);
      else if (u < 4) vA[keyrow * 128 + (u - 2) * 64 + lane] = f2bf(p.cache_a_v[srow * 128 + (u - 2) * 64 + lane]);
      else if (u < 8) kC[keyrow * 256 + (u - 4) * 64 + lane] = f2bf(p.cache_c_k[srow * 256 + (u - 4) * 64 + lane]);
      else vC[keyrow * 256 + (u - 8) * 64 + lane] = f2bf(p.cache_c_v[srow * 256 + (u - 8) * 64 + lane]);
    }
    return;
  }
  const int tok = item;
  const bool sample = tok >= NCTX;
  int b, pos;
  size_t keyrow;
  if (!sample) { b = tok >> 8; pos = tok & 255; keyrow = tok; }
  else { b = (tok - NCTX) >> 10; pos = (tok - NCTX) & 1023; keyrow = 4096 + b * 1536 + 512 + pos; }
  const size_t crow_o = (size_t)(b * 2 + l) * 256 + pos;
  const u16* zr = (const u16*)(ws + WS_Z) + (size_t)tok * INW;
  const float rowp = (float)(pos >> 6), colp = (float)(pos & 63);
  for (int u = w; u < 20; u += 4) {
    if (u < 6) {
      const bool isq = u < 4;
      const int hd = isq ? u : u - 4;
      const float x = bf2f(zr[(isq ? ZA_Q : ZA_K) + hd * 64 + lane]);
      const float ss = wave_sum(x * x);
      float y = x * rsqrtf(ss * (1.f / 64.f) + EPSN) * (isq ? p.a_qn_g : p.a_kn_g)[l * 64 + lane];
      if (!sample && !isq) p.out[O_CAK + crow_o * 128 + hd * 64 + lane] = y;
      if (sample) {
        const int a = lane >> 5, pb = (lane >> 4) & 1, i = lane & 15;
        const float freq = exp2f(-(float)i * (0.0625f * 13.287712379549449f));
        const float ang = (a ? colp : rowp) * freq;
        const float pr = __shfl_xor(y, 16);
        y = y * __cosf(ang) + (pb ? pr : -pr) * __sinf(ang);
      }
      if (isq) qA[(size_t)tok * 256 + hd * 64 + lane] = f2bf(y);
      else kA[keyrow * 128 + hd * 64 + lane] = f2bf(y);
    } else if (u < 8) {
      const int hd = u - 6;
      const u16 raw = zr[ZA_V + hd * 64 + lane];
      if (!sample) p.out[O_CAV + crow_o * 128 + hd * 64 + lane] = bf2f(raw);
      vA[keyrow * 128 + hd * 64 + lane] = raw;
    } else if (u < 16) {
      const bool isq = u < 12;
      const int pr2 = isq ? u - 8 : u - 12;
      const float x = bf2f(zr[(isq ? ZC_Q : ZC_K) + pr2 * 64 + lane]);
      float ss = x * x;
#pragma unroll
      for (int o = 16; o >= 1; o >>= 1) ss += __shfl_xor(ss, o);
      float y = x * rsqrtf(ss * (1.f / 32.f) + EPSN) * (isq ? p.c_qn_g : p.c_kn_g)[l * 32 + (lane & 31)];
      if (!sample && !isq) p.out[O_CCK + crow_o * 256 + pr2 * 64 + lane] = y;
      if (sample) {
        const int dd = lane & 31, a = dd >> 4, pb = (dd >> 3) & 1, i = dd & 7;
        const float freq = exp2f(-(float)i * (0.125f * 13.287712379549449f));
        const float ang = (a ? colp : rowp) * freq;
        const float pr = __shfl_xor(y, 8);
        y = y * __cosf(ang) + (pb ? pr : -pr) * __sinf(ang);
      }
      if (isq) qC[(size_t)tok * 256 + pr2 * 64 + lane] = f2bf(y);
      else kC[keyrow * 256 + pr2 * 64 + lane] = f2bf(y);
    } else {
      const int hd = u - 16;
      const u16 raw = zr[ZC_V + hd * 64 + lane];
      if (!sample) p.out[O_CCV + crow_o * 256 + hd * 64 + lane] = bf2f(raw);
      vC[keyrow * 256 + hd * 64 + lane] = raw;
    }
  }
}

template <bool ISC>
DI void attn_item(const Params& p, int l, int tok0, int keyrow0, int nkeys, int head, char* smraw) {
  constexpr int NM = ISC ? 2 : 1;
  u16* Ks = (u16*)smraw;
  u16* Vs = Ks + 2 * 64 * 72;
  const u16* qbuf = (const u16*)(p.ws + (ISC ? WS_QC : WS_QA));
  const u16* kbuf = (const u16*)(p.ws + (ISC ? WS_KC : WS_KA));
  const u16* vbuf = (const u16*)(p.ws + (ISC ? WS_VC : WS_VA));
  const int kstride = ISC ? 256 : 128;
  const int koff = ISC ? head * 64 : (head >> 1) * 64;
  const float c2 = (ISC ? 0.17677669529663687f : 0.125f) * 1.4426950408889634f;
  const int t = tid_(), lane = t & 63, w = t >> 6, r = lane & 31, h = lane >> 5;
  const int i16 = lane & 15, tq = i16 >> 2, tp = i16 & 3, blk = (lane >> 4) & 1;
  bf16x8 qf[4];
  {
    const u16* qp = qbuf + (size_t)(tok0 + 32 * w + r) * 256 + head * 64 + 8 * h;
#pragma unroll
    for (int s = 0; s < 4; ++s) qf[s] = *(const bf16x8*)(qp + 16 * s);
  }
  f32x16 O[NM][2];
  float mrun[NM], lsum[NM];
#pragma unroll
  for (int m = 0; m < NM; ++m) {
    mrun[m] = -INFINITY; lsum[m] = 0.f;
#pragma unroll
    for (int d = 0; d < 2; ++d)
#pragma unroll
      for (int e = 0; e < 16; ++e) O[m][d][e] = 0.f;
  }
  const int lrow = t >> 3, lc8 = (t & 7) * 8;
  const u16* kg = kbuf + (size_t)(keyrow0 + lrow) * kstride + koff + lc8;
  const u16* vg = vbuf + (size_t)(keyrow0 + lrow) * kstride + koff + lc8;
  u32x4 rk[2], rv[2];
#pragma unroll
  for (int i = 0; i < 2; ++i) { rk[i] = *(const u32x4*)(kg + (size_t)(32 * i) * kstride); rv[i] = *(const u32x4*)(vg + (size_t)(32 * i) * kstride); }
#pragma unroll
  for (int i = 0; i < 2; ++i) {
    *(u32x4*)(Ks + (lrow + 32 * i) * 72 + lc8) = rk[i];
    *(u32x4*)(Vs + (lrow + 32 * i) * 72 + lc8) = rv[i];
  }
  __syncthreads();
  const int NT = nkeys >> 6;
  for (int kt = 0; kt < NT; ++kt) {
    const int buf = kt & 1;
    if (kt + 1 < NT) {
#pragma unroll
      for (int i = 0; i < 2; ++i) {
        rk[i] = *(const u32x4*)(kg + (size_t)((kt + 1) * 64 + 32 * i) * kstride);
        rv[i] = *(const u32x4*)(vg + (size_t)((kt + 1) * 64 + 32 * i) * kstride);
      }
    }
    const u16* kb_ = Ks + buf * 64 * 72;
    const u16* vb_ = Vs + buf * 64 * 72;
#pragma unroll
    for (int kb = 0; kb < 2; ++kb) {
      f32x16 S[NM];
#pragma unroll
      for (int m = 0; m < NM; ++m)
#pragma unroll
        for (int e = 0; e < 16; ++e) S[m][e] = 0.f;
#pragma unroll
      for (int s = 0; s < 4; ++s) {
        const int m = ISC ? (s >> 1) : 0;
        const bf16x8 kf = *(const bf16x8*)(kb_ + (kb * 32 + r) * 72 + 16 * s + 8 * h);
        S[m] = MFMA(kf, qf[s], S[m]);
      }
#pragma unroll
      for (int m = 0; m < NM; ++m) {
        float mx = S[m][0];
#pragma unroll
        for (int e = 1; e < 16; ++e) mx = fmaxf(mx, S[m][e]);
        mx = fmaxf(mx, __shfl_xor(mx, 32));
        const float mnew = fmaxf(mrun[m], mx);
        const float alpha = exp2f((mrun[m] - mnew) * c2);
        mrun[m] = mnew;
        const float mc = mnew * c2;
        float ps = 0.f;
#pragma unroll
        for (int e = 0; e < 16; ++e) { const float pe = exp2f(S[m][e] * c2 - mc); S[m][e] = pe; ps += pe; }
        lsum[m] = lsum[m] * alpha + ps;
        if (__any(alpha != 1.f)) {
#pragma unroll
          for (int d = 0; d < 2; ++d)
#pragma unroll
            for (int e = 0; e < 16; ++e) O[m][d][e] *= alpha;
        }
      }
#pragma unroll
      for (int st = 0; st < 2; ++st) {
        bf16x8 pf[NM];
#pragma unroll
        for (int m = 0; m < NM; ++m) pf[m] = pack8(S[m], st);
#pragma unroll
        for (int d = 0; d < 2; ++d) {
          const u16* vp = vb_ + (kb * 32 + 16 * st + 4 * h + tq) * 72 + d * 32 + 16 * blk + 4 * tp;
          const bf16x8 vf = trpair(vp, vp + 8 * 72);
#pragma unroll
          for (int m = 0; m < NM; ++m) O[m][d] = MFMA(vf, pf[m], O[m][d]);
        }
      }
    }
    if (kt + 1 < NT) {
      const int nb = (buf ^ 1) * 64 * 72;
#pragma unroll
      for (int i = 0; i < 2; ++i) {
        *(u32x4*)(Ks + nb + (lrow + 32 * i) * 72 + lc8) = rk[i];
        *(u32x4*)(Vs + nb + (lrow + 32 * i) * 72 + lc8) = rv[i];
      }
    }
    __syncthreads();
  }
  float inv[NM];
#pragma unroll
  for (int m = 0; m < NM; ++m) { const float lt = lsum[m] + __shfl_xor(lsum[m], 32); inv[m] = 1.f / lt; }
  const int tok = tok0 + 32 * w + r;
  u16* yc = (u16*)(p.ws + WS_YCAT) + (size_t)tok * 1024;
  if (!ISC) {
#pragma unroll
    for (int d = 0; d < 2; ++d)
#pragma unroll
      for (int g = 0; g < 4; ++g) {
        u32x2 q;
        q[0] = pack2(O[0][d][4 * g] * inv[0], O[0][d][4 * g + 1] * inv[0]);
        q[1] = pack2(O[0][d][4 * g + 2] * inv[0], O[0][d][4 * g + 3] * inv[0]);
        *(u32x2*)(yc + head * 64 + d * 32 + 8 * g + 4 * h) = q;
      }
  } else {
    const float* cl = p.c_lambda + l * 128;
    float d1 = 0.f, d2 = 0.f;
    for (int i = 0; i < 32; ++i) { d1 += cl[i] * cl[32 + i]; d2 += cl[64 + i] * cl[96 + i]; }
    const float lam_init = 0.8f - 0.6f * __expf(-0.3f * (float)l);
    const float lam = __expf(d1) - __expf(d2) + lam_init;
    float ss = 0.f;
#pragma unroll
    for (int d = 0; d < 2; ++d)
#pragma unroll
      for (int e = 0; e < 16; ++e) {
        const float dv = O[0][d][e] * inv[0] - lam * (O[NM - 1][d][e] * inv[NM - 1]);
        O[0][d][e] = dv; ss += dv * dv;
      }
    ss += __shfl_xor(ss, 32);
    const float sc = rsqrtf(ss * (1.f / 64.f) + EPSN) * (1.f - lam_init);
    const float* sg = p.c_subln_g + l * 64;
#pragma unroll
    for (int d = 0; d < 2; ++d)
#pragma unroll
      for (int g = 0; g < 4; ++g) {
        const int dv0 = d * 32 + 8 * g + 4 * h;
        u32x2 q;
        q[0] = pack2(O[0][d][4 * g] * sc * sg[dv0], O[0][d][4 * g + 1] * sc * sg[dv0 + 1]);
        q[1] = pack2(O[0][d][4 * g + 2] * sc * sg[dv0 + 2], O[0][d][4 * g + 3] * sc * sg[dv0 + 3]);
        *(u32x2*)(yc + 512 + head * 64 + dv0) = q;
      }
  }
}
DI void attn_dispatch(const Params& p, int l, int item, char* sm) {
  if (item < 128) {
    const int j = item & 63, b = j >> 5, qb = (j >> 2) & 7, head = j & 3;
    const int tok0 = NCTX + b * 1024 + qb * 128, kr0 = 4096 + b * 1536;
    if (item < 64) attn_item<true>(p, l, tok0, kr0, 1536, head, sm);
    else attn_item<false>(p, l, tok0, kr0, 1536, head, sm);
  } else {
    const int j = (item - 128) & 127, s = j >> 3, qb = (j >> 2) & 1, head = j & 3;
    const int tok0 = s * 256 + qb * 128, kr0 = s * 256;
    if (item < 256) attn_item<true>(p, l, tok0, kr0, 256, head, sm);
    else attn_item<false>(p, l, tok0, kr0, 256, head, sm);
  }
}

template <bool GLA>
struct ScanCtx { float wa[16]; float ba, lbm, oml; int ldir; };
template <bool GLA>
DI void scan_init(const Params& p, int l, int head, int dirh, int lane, ScanCtx<GLA>& cx) {
  const int ldir = GLA ? (lane >> 5) : dirh;
  cx.ldir = ldir;
  if (GLA) {
    const int kc = lane & 31;
#pragma unroll
    for (int j = 0; j < 16; ++j) cx.wa[j] = p.d_alpha_w[((size_t)(l * 2 + ldir) * 16 + j) * 128 + head * 32 + kc];
    cx.ba = p.d_alpha_b[(l * 2 + ldir) * 128 + head * 32 + kc];
  } else {
    float lb = 0.f;
    if (l > 0) {
      const float x0 = p.b_lb_logits[(ldir * 2 + 0) * 256 + head * 64 + lane], x1 = p.b_lb_logits[(ldir * 2 + 1) * 256 + head * 64 + lane];
      lb = 1.f / (1.f + __expf(x0 - x1));
    }
    cx.lbm = fmaxf(lb, 1e-30f); cx.oml = 1.f - lb;
  }
}
template <bool GLA>
DI float scan_la(const Params& p, const ScanCtx<GLA>& cx, int tok, int head, int lane, float& kk) {
  const u16* zr = (const u16*)(p.ws + WS_Z) + (size_t)tok * INW;
  if (GLA) {
    const u32x4 r0 = *(const u32x4*)(zr + ZD_RF + cx.ldir * 16), r1 = *(const u32x4*)(zr + ZD_RF + cx.ldir * 16 + 8);
    float v = cx.ba;
#pragma unroll
    for (int q = 0; q < 4; ++q) {
      v += cx.wa[2 * q] * lo_bf(r0[q]) + cx.wa[2 * q + 1] * hi_bf(r0[q]);
      v += cx.wa[8 + 2 * q] * lo_bf(r1[q]) + cx.wa[8 + 2 * q + 1] * hi_bf(r1[q]);
    }
    kk = bf2f(zr[ZD_K + head * 32 + (lane & 31)]);
    return (fminf(v, 0.f) - __logf(1.f + __expf(-fabsf(v)))) * (1.f / 16.f);
  } else {
    const float zz = bf2f(zr[(cx.ldir ? ZB_FB : ZB_FF) + head * 64 + lane]);
    const float sig = 1.f / (1.f + __expf(-zz));
    kk = cx.oml / (1.f + __expf(zz));
    return __logf(cx.lbm + cx.oml * sig);
  }
}
DI int tile_id(bool gla, int chunk, int head, int dir) { return gla ? 1536 + chunk * 4 + head : (chunk * 4 + head) * 2 + dir; }

template <bool GLA>
DI void scan_s1(const Params& p, int l, int chunk, int head, int dir, bool valid, u16* smw) {
  const int lane = tid_() & 63, r = lane & 31, h = lane >> 5;
  const int i16 = lane & 15, tq = i16 >> 2, tp = i16 & 3, blk = (lane >> 4) & 1;
  u16* ko = smw;
  u16* vt = smw + 32 * 72;
  const int start = chunk * 32;
  const u16* z = (const u16*)(p.ws + WS_Z);
  {
    ScanCtx<GLA> cx;
    scan_init<GLA>(p, l, head, dir, lane, cx);
    const int ldir = cx.ldir;
    float cl = 0.f, kk;
#pragma unroll 4
    for (int i = 0; i < 32; ++i) cl += scan_la<GLA>(p, cx, start + (ldir ? 31 - i : i), head, lane, kk);
    float cum = 0.f;
#pragma unroll 4
    for (int i = 0; i < 32; ++i) {
      const int pp = ldir ? 31 - i : i;
      cum += scan_la<GLA>(p, cx, start + pp, head, lane, kk);
      ko[pp * 72 + lane] = f2bf(kk * __expf(cl - cum));
    }
    if (valid) ((float*)(p.ws + WS_CL))[tile_id(GLA, chunk, head, dir) * 64 + lane] = cl;
  }
  {
    const int vcol = (GLA ? ZD_V : ZB_I) + head * 64;
#pragma unroll
    for (int i = 0; i < 4; ++i) {
      const int row = (lane >> 3) + 8 * i, c8 = (lane & 7) * 8;
      *(u32x4*)(vt + row * 72 + c8) = *(const u32x4*)(z + (size_t)(start + row) * INW + vcol + c8);
    }
  }
  __syncthreads();
  f32x16 acc[2][2];
  zero_acc<2>(acc);
#pragma unroll
  for (int st = 0; st < 2; ++st) {
    bf16x8 a[2], b[2];
#pragma unroll
    for (int x = 0; x < 2; ++x) {
      const u16* ap = vt + (16 * st + 8 * h + tq) * 72 + x * 32 + 16 * blk + 4 * tp;
      a[x] = trpair(ap, ap + 4 * 72);
      const u16* bp = ko + (16 * st + 8 * h + tq) * 72 + x * 32 + 16 * blk + 4 * tp;
      b[x] = trpair(bp, bp + 4 * 72);
    }
#pragma unroll
    for (int x = 0; x < 2; ++x)
#pragma unroll
      for (int y = 0; y < 2; ++y) acc[x][y] = MFMA(a[x], b[y], acc[x][y]);
  }
  if (valid) {
    float* U = (float*)(p.ws + WS_U) + (size_t)tile_id(GLA, chunk, head, dir) * 4096;
#pragma unroll
    for (int x = 0; x < 2; ++x)
#pragma unroll
      for (int y = 0; y < 2; ++y)
#pragma unroll
        for (int e = 0; e < 16; ++e) U[(x * 32 + crow(e, h)) * 64 + y * 32 + r] = acc[x][y][e];
  }
  __syncthreads();
}
DI void scan_s1_block(const Params& p, int l, int bitem, char* sm) {
  const int w = tid_() >> 6;
  int wi = bitem * 4 + w;
  u16* smw = (u16*)sm + w * (2 * 32 * 72);
  if (bitem < 384) scan_s1<false>(p, l, wi >> 3, (wi >> 1) & 3, wi & 1, true, smw);
  else { wi -= 1536; scan_s1<true>(p, l, wi >> 2, wi & 3, 0, true, smw); }
}

DI void scan_s2_item(const Params& p, int l, int item) {
  const int t = tid_();
  const int unit = item >> 2, vq = item & 3;
  const bool gla = unit >= 144;
  int seq, head, dir;
  if (!gla) { seq = unit >> 3; head = (unit >> 1) & 3; dir = unit & 1; }
  else { const int g = unit - 144; seq = g >> 2; head = g & 3; dir = 0; }
  const int c = t & 63;
  const int dc = gla ? (c >> 5) : dir;
  int N, chunk0;
  if (seq < 16) { N = 8; chunk0 = seq * 8; } else { N = 32; chunk0 = 128 + (seq - 16) * 32; }
  float S[4];
  int vv[4];
#pragma unroll
  for (int i = 0; i < 4; ++i) {
    vv[i] = vq * 16 + (t >> 6) + 4 * i;
    if (seq < 16) S[i] = 0.f;
    else {
      const int b = seq - 16;
      S[i] = gla ? p.state_gla[(size_t)(((b * 2 + l) * 2 + dc) * 4 + head) * 2048 + (c & 31) * 64 + vv[i]]
                 : p.state_hgrn[(size_t)(((b * 2 + l) * 2 + dc) * 4 + head) * 4096 + c * 64 + vv[i]];
    }
  }
  const float* __restrict__ U = (const float*)(p.ws + WS_U);
  const float* __restrict__ CL = (const float*)(p.ws + WS_CL);
  float* __restrict__ SS = (float*)(p.ws + WS_S);
  for (int m0 = 0; m0 < N; m0 += 4) {
    float tmp[4][4], a[4];
    int ids[4];
#pragma unroll
    for (int mm = 0; mm < 4; ++mm) {
      const int m = m0 + mm;
      ids[mm] = tile_id(gla, chunk0 + (dc ? N - 1 - m : m), head, dir);
      a[mm] = CL[ids[mm] * 64 + c];
#pragma unroll
      for (int i = 0; i < 4; ++i) tmp[mm][i] = U[(size_t)ids[mm] * 4096 + vv[i] * 64 + c];
    }
#pragma unroll
    for (int mm = 0; mm < 4; ++mm) {
      const float ea = __expf(a[mm]);
#pragma unroll
      for (int i = 0; i < 4; ++i) {
        SS[(size_t)ids[mm] * 4096 + vv[i] * 64 + c] = S[i];
        S[i] = ea * S[i] + tmp[mm][i];
      }
    }
  }
  if (seq < 16) {
#pragma unroll
    for (int i = 0; i < 4; ++i) {
      if (gla) p.out[O_SG + (size_t)(((seq * 2 + l) * 2 + dc) * 4 + head) * 2048 + (c & 31) * 64 + vv[i]] = S[i];
      else p.out[O_SH + (size_t)(((seq * 2 + l) * 2 + dc) * 4 + head) * 4096 + c * 64 + vv[i]] = S[i];
    }
  }
}

template <bool GLA>
DI void scan_s3(const Params& p, int l, int chunk, int head, u16* smw) {
  const int lane = tid_() & 63, r = lane & 31, h = lane >> 5;
  const int i16 = lane & 15, tq = i16 >> 2, tp = i16 & 3, blk = (lane >> 4) & 1;
  u16* qt = smw;
  u16* kt = smw + 32 * 72;
  u16* vt = smw + 2 * 32 * 72;
  float* sref = (float*)(smw + 3 * 32 * 72);
  const int start = chunk * 32;
  const u16* z = (const u16*)(p.ws + WS_Z);
  {
    const int vcol = (GLA ? ZD_V : ZB_I) + head * 64;
#pragma unroll
    for (int i = 0; i < 4; ++i) {
      const int row = (lane >> 3) + 8 * i, c8 = (lane & 7) * 8;
      *(u32x4*)(vt + row * 72 + c8) = *(const u32x4*)(z + (size_t)(start + row) * INW + vcol + c8);
    }
  }
  f32x16 o[2];
#pragma unroll
  for (int x = 0; x < 2; ++x)
#pragma unroll
    for (int e = 0; e < 16; ++e) o[x][e] = 0.f;
  constexpr int NPASS = GLA ? 1 : 2;
#pragma unroll 1
  for (int pass = 0; pass < NPASS; ++pass) {
    {
      ScanCtx<GLA> cx;
      scan_init<GLA>(p, l, head, pass, lane, cx);
      const int ldir = cx.ldir;
      float ref = 0.f, kk, cum = 0.f;
#pragma unroll 4
      for (int i = 0; i < 16; ++i) ref += scan_la<GLA>(p, cx, start + (ldir ? 31 - i : i), head, lane, kk);
      sref[lane] = __expf(ref);
#pragma unroll 4
      for (int i = 0; i < 32; ++i) {
        const int pp = ldir ? 31 - i : i;
        const int tok = start + pp;
        cum += scan_la<GLA>(p, cx, tok, head, lane, kk);
        float qv;
        if (GLA) qv = bf2f(z[(size_t)tok * INW + ZD_Q + head * 32 + (lane & 31)]) * 0.17677669529663687f;
        else { const float zq = bf2f(z[(size_t)tok * INW + ZB_Q + head * 64 + lane]); qv = zq * sigmoidf_(zq); }
        qt[pp * 72 + lane] = f2bf(qv * __expf(cum - ref));
        kt[pp * 72 + lane] = f2bf(kk * __expf(ref - cum));
      }
    }
    __syncthreads();
    constexpr int NS = GLA ? 2 : 1;
    f32x16 sc[NS];
#pragma unroll
    for (int m = 0; m < NS; ++m)
#pragma unroll
      for (int e = 0; e < 16; ++e) sc[m][e] = 0.f;
    bf16x8 qfr[4];
#pragma unroll
    for (int st = 0; st < 4; ++st) {
      qfr[st] = *(const bf16x8*)(qt + r * 72 + 16 * st + 8 * h);
      const bf16x8 kf = *(const bf16x8*)(kt + r * 72 + 16 * st + 8 * h);
      const int m = GLA ? (st >> 1) : 0;
      sc[m] = MFMA(kf, qfr[st], sc[m]);
    }
#pragma unroll
    for (int m = 0; m < NS; ++m) {
      const int d = GLA ? m : pass;
#pragma unroll
      for (int e = 0; e < 16; ++e) {
        const int s = crow(e, h);
        const bool keep = d ? (s >= r) : (s <= r);
        sc[m][e] = keep ? sc[m][e] : 0.f;
      }
#pragma unroll
      for (int st = 0; st < 2; ++st) {
        const bf16x8 pf = pack8(sc[m], st);
#pragma unroll
        for (int x = 0; x < 2; ++x) {
          const u16* vp = vt + (16 * st + 4 * h + tq) * 72 + x * 32 + 16 * blk + 4 * tp;
          const bf16x8 vf = trpair(vp, vp + 8 * 72);
          o[x] = MFMA(vf, pf, o[x]);
        }
      }
    }
    const float* Sg = (const float*)(p.ws + WS_S) + (size_t)tile_id(GLA, chunk, head, pass) * 4096;
#pragma unroll
    for (int x = 0; x < 2; ++x)
#pragma unroll
      for (int st = 0; st < 4; ++st) {
        const float* sp = Sg + (x * 32 + r) * 64 + 16 * st + 8 * h;
        const float4 s0 = *(const float4*)sp, s1 = *(const float4*)(sp + 4);
        const float4 e0 = *(const float4*)(sref + 16 * st + 8 * h), e1 = *(const float4*)(sref + 16 * st + 8 * h + 4);
        u32x4 q;
        q[0] = pack2(s0.x * e0.x, s0.y * e0.y); q[1] = pack2(s0.z * e0.z, s0.w * e0.w);
        q[2] = pack2(s1.x * e1.x, s1.y * e1.y); q[3] = pack2(s1.z * e1.z, s1.w * e1.w);
        o[x] = MFMA(__builtin_bit_cast(bf16x8, q), qfr[st], o[x]);
      }
    __syncthreads();
  }
  float ss = 0.f;
#pragma unroll
  for (int x = 0; x < 2; ++x)
#pragma unroll
    for (int e = 0; e < 16; ++e) ss += o[x][e] * o[x][e];
  ss += __shfl_xor(ss, 32);
  const float rstd = rsqrtf(ss * (1.f / 64.f) + EPSN);
  const int tok = start + r;
  const float* gn = (GLA ? p.d_norm_g : p.b_norm_g) + l * 64;
  const u16* gz = z + (size_t)tok * INW + (GLA ? ZD_G : ZB_G) + head * 64;
  u16* yc = (u16*)(p.ws + WS_YCAT) + (size_t)tok * 1024 + (GLA ? 768 : 256) + head * 64;
#pragma unroll
  for (int x = 0; x < 2; ++x)
#pragma unroll
    for (int g = 0; g < 4; ++g) {
      const int v0 = x * 32 + 8 * g + 4 * h;
      const u32x2 gr = *(const u32x2*)(gz + v0);
      const float g0 = lo_bf(gr[0]), g1 = hi_bf(gr[0]), g2 = lo_bf(gr[1]), g3 = hi_bf(gr[1]);
      u32x2 q;
      q[0] = pack2(o[x][4 * g] * rstd * gn[v0] * g0 * sigmoidf_(g0), o[x][4 * g + 1] * rstd * gn[v0 + 1] * g1 * sigmoidf_(g1));
      q[1] = pack2(o[x][4 * g + 2] * rstd * gn[v0 + 2] * g2 * sigmoidf_(g2), o[x][4 * g + 3] * rstd * gn[v0 + 3] * g3 * sigmoidf_(g3));
      *(u32x2*)(yc + v0) = q;
    }
}
DI void scan_s3_block(const Params& p, int l, int bitem, char* sm) {
  const int w = tid_() >> 6;
  u16* smw = (u16*)sm + w * (3 * 32 * 72 + 128);
  int wi = bitem * 4 + w;
  if (bitem < 192) scan_s3<false>(p, l, wi >> 2, wi & 3, smw);
  else { wi -= 768; scan_s3<true>(p, l, wi >> 2, wi & 3, smw); }
}

DI void run_phase(const Params& p, int ph, char* sm) {
  const int bid = blockIdx.x, nb = gridDim.x;
#ifdef PHASE_ONLY
  if (ph != 0 && (ph - 1) % 11 != PHASE_ONLY - 1) return;
  if (ph == 0 && PHASE_ONLY != 0) return;
#endif
  if (ph == 0) {
    for (int it = bid; it < 192 + CONVW_ITEMS; it += nb) {
      if (it < 192) mod_item(p, it, sm); else convw_item(p, 0, it - 192, sm);
    }
    return;
  }
  const int l = (ph - 1) / 11, s = (ph - 1) % 11;
  switch (s) {
    case 0: {
      const int w = tid_() >> 6;
      for (int tk = bid * 4 + w; tk < NTOK; tk += nb * 4) norm_tok(p, l, 0, tk);
      if (l > 0) for (int it = bid; it < CONVW_ITEMS; it += nb) convw_item(p, l, it, sm);
    } break;
    case 1: for (int it = bid; it < 48 * 59; it += nb) gemm_in_item(p, it, sm); break;
    case 2:
      for (int it = bid; it < 576 + 7168; it += nb) {
        if (it < 576) scan_s1_block(p, l, it, sm); else prep_item(p, l, it - 576);
      }
      break;
    case 3:
      for (int it = bid; it < 384 + 864; it += nb) {
        if (it < 128) attn_dispatch(p, l, it, sm);
        else if (it < 128 + 864) scan_s2_item(p, l, it - 128);
        else attn_dispatch(p, l, it - 864, sm);
      }
      break;
    case 4: for (int it = bid; it < 384; it += nb) scan_s3_block(p, l, it, sm); break;
    case 5: for (int it = bid; it < 768; it += nb) gemm_branch_item(p, it, sm); break;
    case 6: for (int it = bid; it < 384; it += nb) gemm_out_item(p, l, it, sm); break;
    case 7: {
      const int w = tid_() >> 6;
      for (int tk = bid * 4 + w; tk < NTOK; tk += nb * 4) norm_tok(p, l, 1, tk);
    } break;
    case 8: for (int it = bid; it < 48 * 44; it += nb) gemm_up_item(p, it, sm); break;
    case 9: conv_act(p, l, bid * 256 + tid_(), nb * 256); break;
    case 10: for (int it = bid; it < 384; it += nb) gemm_down_item(p, l, it, sm); break;
  }
}

__global__ void __launch_bounds__(256, 2) fwd_mega(Params p) {
  __shared__ __attribute__((aligned(16))) char sm[SMEM_BYTES];
  cg::grid_group grid = cg::this_grid();
  for (int ph = p.phase_begin; ph < p.phase_end; ++ph) {
    if (ph > p.phase_begin && p.coop) grid.sync();
    run_phase(p, ph, sm);
  }
}

extern "C" void kernel_launch(void* const* d_in, const int* in_sizes, int n_in, void* d_out, int out_size, void* d_ws,
                              size_t ws_size, hipStream_t stream) {
  static int grid_blocks = 0;
  if (!grid_blocks) {
    int dev = 0, cus = 0, per_cu = 0;
    hipGetDevice(&dev);
    hipDeviceGetAttribute(&cus, hipDeviceAttributeMultiprocessorCount, dev);
    hipOccupancyMaxActiveBlocksPerMultiprocessor(&per_cu, fwd_mega, 256, 0);
    if (per_cu > 2) per_cu = 2;
    if (per_cu < 1) per_cu = 1;
    grid_blocks = cus * per_cu;
  }
  Params p{};
  const float** pp = (const float**)&p;
  for (int i = 0; i < 32; ++i) pp[i] = (const float*)d_in[i];
  p.out = (float*)d_out;
  p.ws = (char*)d_ws;
  if (ws_size < WS_END) { fprintf(stderr, "workspace too small: %zu < %zu\n", ws_size, (size_t)WS_END); return; }
#if MULTI
  for (int ph = 0; ph < NPHASE; ++ph) {
    p.phase_begin = ph; p.phase_end = ph + 1; p.coop = 0; p.pad = 0;
    hipLaunchKernelGGL(fwd_mega, dim3(grid_blocks), dim3(256), 0, stream, p);
  }
#else
  p.phase_begin = 0; p.phase_end = NPHASE; p.coop = 1; p.pad = 0;
  void* args[] = {&p};
  hipError_t e = hipLaunchCooperativeKernel((void*)fwd_mega, dim3(grid_blocks), dim3(256), args, 0, stream);
  if (e != hipSuccess) fprintf(stderr, "cooperative launch failed: %s (grid %d)\n", hipGetErrorString(e), grid_blocks);
#endif
}
```

```cpp
#include <hip/hip_runtime.h>
#include <hip/hip_bf16.h>
#include <hip/hip_cooperative_groups.h>
#include <cstdio>
namespace cg = cooperative_groups;

#ifndef MULTI
#define MULTI 0
#endif

#define DI __device__ __forceinline__
typedef unsigned short u16;
using bf16x8 = __attribute__((ext_vector_type(8))) short;
using s16x4  = __attribute__((ext_vector_type(4))) short;
using f32x16 = __attribute__((ext_vector_type(16))) float;
using u32x4  = __attribute__((ext_vector_type(4))) unsigned;
using u32x2  = __attribute__((ext_vector_type(2))) unsigned;
#define MFMA(a, b, c) __builtin_amdgcn_mfma_f32_32x32x16_bf16((a), (b), (c), 0, 0, 0)

constexpr int NTOK = 6144, NCTX = 4096, DM = 1024, INW = 7456, DFF = 2816, DFF2 = 5632;
constexpr int ZA_Q = 0, ZA_K = 256, ZA_V = 384, ZC_Q = 512, ZC_K = 768, ZC_V = 1024, ZB_Q = 1280, ZB_I = 1536, ZB_FF = 1792,
              ZB_FB = 2048, ZB_G = 2304, ZD_Q = 2560, ZD_K = 2688, ZD_V = 2816, ZD_G = 3072, ZD_RF = 3328, Z_ML = 3360;
constexpr float EPSN = 1e-6f;
constexpr size_t O_CAK = 6291456, O_CAV = 7340032, O_CCK = 8388608, O_CCV = 10485760, O_SH = 12582912, O_SG = 13631488;
constexpr size_t WS_WIN = 0;
constexpr size_t WS_WBR = WS_WIN + (size_t)INW * 1024 * 2;
constexpr size_t WS_WOUT = WS_WBR + (size_t)4 * 1024 * 256 * 2;
constexpr size_t WS_WUP = WS_WOUT + (size_t)1024 * 1024 * 2;
constexpr size_t WS_WDN = WS_WUP + (size_t)DFF2 * 1024 * 2;
constexpr size_t WS_MOD = WS_WDN + (size_t)1024 * DFF * 2;
constexpr size_t WS_H = WS_MOD + (size_t)2 * 3 * 6144 * 4;
constexpr size_t WS_Z = WS_H + (size_t)NTOK * 1024 * 2;
constexpr size_t WS_QA = WS_Z + (size_t)NTOK * INW * 2;
constexpr size_t WS_QC = WS_QA + (size_t)NTOK * 256 * 2;
constexpr size_t WS_KA = WS_QC + (size_t)NTOK * 256 * 2;
constexpr size_t WS_VA = WS_KA + (size_t)7168 * 128 * 2;
constexpr size_t WS_KC = WS_VA + (size_t)7168 * 128 * 2;
constexpr size_t WS_VC = WS_KC + (size_t)7168 * 256 * 2;
constexpr size_t WS_YCAT = WS_VC + (size_t)7168 * 256 * 2;
constexpr size_t WS_ACT = WS_YCAT + (size_t)NTOK * 1024 * 2;
constexpr size_t WS_MIX = WS_ACT + (size_t)NTOK * DFF * 2;
constexpr size_t WS_CL = WS_MIX + (size_t)NTOK * 1024 * 2;
constexpr size_t WS_U = WS_ACT;
constexpr size_t WS_S = WS_CL + (size_t)2304 * 64 * 4;
constexpr size_t WS_BAR = WS_S + (size_t)2304 * 4096 * 4;
constexpr size_t WS_END = WS_BAR + 16384;
static_assert((size_t)2304 * 4096 * 4 <= (size_t)NTOK * DFF * 2 + (size_t)NTOK * 1024 * 2, "U alias");
static_assert(WS_END <= (size_t)256 * 1024 * 1024, "ws budget");
constexpr int SMEM_BYTES = 73728;
constexpr int NPHASE = 23;

struct Params {
  const float *x_prompt, *x_sample, *cache_a_k, *cache_a_v, *cache_c_k, *cache_c_v, *state_hgrn, *state_gla, *c, *c_ctx,
      *w_ada, *b_ada, *norm1_g, *norm2_g, *w_in, *a_qn_g, *a_kn_g, *c_qn_g, *c_kn_g, *c_lambda, *c_subln_g, *b_lb_logits,
      *b_norm_g, *d_alpha_w, *d_alpha_b, *d_norm_g, *w_branch, *w_out, *w_up, *conv_w, *conv_b, *w_down;
  float* out;
  char* ws;
  int phase_begin, phase_end, coop, pad;
};

DI int tid_() { int t = __builtin_amdgcn_workitem_id_x(); asm volatile("" : "+v"(t)); return t; }
DI float bf2f(u16 u) { return __uint_as_float(((unsigned)u) << 16); }
DI u16 f2bf(float a) { __hip_bfloat16 b = __float2bfloat16(a); return *(u16*)&b; }
DI unsigned pack2(float a, float b) { __hip_bfloat162 q = __float22bfloat162_rn(make_float2(a, b)); return *(unsigned*)&q; }
DI float lo_bf(unsigned u) { return __uint_as_float(u << 16); }
DI float hi_bf(unsigned u) { return __uint_as_float(u & 0xffff0000u); }
DI float sigmoidf_(float x) { return 1.f / (1.f + __expf(-x)); }
DI int crow(int e, int h) { return (e & 3) + 8 * (e >> 2) + 4 * h; }
DI bf16x8 pack8(const f32x16& x, int s) {
  u32x4 q;
  q[0] = pack2(x[8 * s + 0], x[8 * s + 1]); q[1] = pack2(x[8 * s + 2], x[8 * s + 3]);
  q[2] = pack2(x[8 * s + 4], x[8 * s + 5]); q[3] = pack2(x[8 * s + 6], x[8 * s + 7]);
  return __builtin_bit_cast(bf16x8, q);
}
DI s16x4 trread(const u16* pl) {
  return __builtin_amdgcn_ds_read_tr16_b64_v4i16((__attribute__((address_space(3))) s16x4*)pl);
}
DI bf16x8 trpair(const u16* p0, const u16* p1) {
  s16x4 a = trread(p0), b = trread(p1);
  return __builtin_shufflevector(a, b, 0, 1, 2, 3, 4, 5, 6, 7);
}
DI float wave_sum(float v) {
#pragma unroll
  for (int o = 32; o >= 1; o >>= 1) v += __shfl_xor(v, o);
  return v;
}
DI int tok_cond(int t) { return t < NCTX ? 0 : 1 + ((t - NCTX) >> 10); }
DI const float* xin_row(const Params& p, int l, int tok) {
  if (l > 0) return p.out + (size_t)tok * DM;
  return tok < NCTX ? p.x_prompt + (size_t)tok * DM : p.x_sample + (size_t)(tok - NCTX) * DM;
}


#define XB_TMO      128
#define XB_XCNT(j)  (256  + 64 * (j))
#define XB_XSUB(j)  (1280 + 64 * (j))
#define XB_XGEN(j)  (2304 + 64 * (j))
#define XB_TOP      3328
#define XB_TOPGEN   3392
#define XCD_BAR_WORDS 3456
#define XB_SPIN_CAP (1u << 22)
#define LAS __attribute__((address_space(3)))
DI unsigned xb_ld(unsigned* p) { return __hip_atomic_load(p, __ATOMIC_RELAXED, __HIP_MEMORY_SCOPE_AGENT); }
DI unsigned xb_add(unsigned* p, unsigned v) { return __hip_atomic_fetch_add(p, v, __ATOMIC_RELAXED, __HIP_MEMORY_SCOPE_AGENT); }
DI unsigned xb_xcc_id() { return (unsigned)__builtin_amdgcn_s_getreg((3 << 11) | 20) & 0xFu; }
#define XB_SPIN(cond, bar) do { unsigned _sp = 0; while (cond) { __builtin_amdgcn_s_sleep(1); \
    if ((++_sp & 255u) == 0u) { if (xb_ld(&(bar)[XB_TMO])) break; if (_sp > XB_SPIN_CAP) { atomicAdd(&(bar)[XB_TMO], 1u); break; } } } } while (0)
struct XcdBarrier { unsigned* bar; unsigned x; volatile LAS unsigned* st; };
DI XcdBarrier xcd_barrier_post(unsigned* bar, volatile LAS unsigned* st) {
  XcdBarrier b; b.bar = bar; b.x = xb_xcc_id(); b.st = st;
  if (__builtin_amdgcn_workitem_id_x() == 0) (void)xb_add(&bar[XB_XCNT(b.x)], 1u);
  return b;
}
DI void xcd_barrier_complete(unsigned* bar, unsigned x, unsigned& nloc, unsigned& nx) {
  const unsigned G = gridDim.x * gridDim.y * gridDim.z;
  unsigned sum, cnt, mine, sp = 0u;
  for (;;) {
    sum = 0u; cnt = 0u; mine = 0u;
#pragma unroll
    for (unsigned j = 0; j < 16; ++j) { const unsigned c = xb_ld(&bar[XB_XCNT(j)]); sum += c; cnt += (c > 0u) ? 1u : 0u; mine = (j == x) ? c : mine; }
    if (sum == G) break;
    __builtin_amdgcn_s_sleep(1);
    if ((++sp & 255u) == 0u) { if (xb_ld(&bar[XB_TMO])) break; if (sp > XB_SPIN_CAP) { atomicAdd(&bar[XB_TMO], 1u); break; } }
  }
  nloc = mine > 0u ? mine : 1u; nx = cnt > 0u ? cnt : 1u;
}
DI void xcd_barrier(const XcdBarrier& b) {
  asm volatile("s_waitcnt vmcnt(0)" ::: "memory");
  __syncthreads();
  if (__builtin_amdgcn_workitem_id_x() == 0) {
    unsigned* bar = b.bar;
    __builtin_amdgcn_s_waitcnt(0);
    unsigned nloc = b.st[0], nx = b.st[1];
    if (nloc == 0u) { xcd_barrier_complete(bar, b.x, nloc, nx); b.st[0] = nloc; b.st[1] = nx; }
    const unsigned old = xb_add(&bar[XB_XSUB(b.x)], 1u);
    const unsigned gen = old / nloc;
    if (old + 1u == (gen + 1u) * nloc) {
      __builtin_amdgcn_fence(__ATOMIC_RELEASE, "agent");
      asm volatile("s_waitcnt vmcnt(0)" ::: "memory");
      const unsigned og = xb_add(&bar[XB_TOP], 1u);
      const unsigned tg = og / nx;
      if (og + 1u == (tg + 1u) * nx) xb_add(&bar[XB_TOPGEN], 1u);
      else XB_SPIN(xb_ld(&bar[XB_TOPGEN]) == tg, bar);
      __builtin_amdgcn_fence(__ATOMIC_ACQUIRE, "agent");
      xb_add(&bar[XB_XGEN(b.x)], 1u);
      asm volatile("s_waitcnt vmcnt(0)" ::: "memory");
    } else {
      XB_SPIN(xb_ld(&bar[XB_XGEN(b.x)]) == gen, bar);
      __builtin_amdgcn_fence(__ATOMIC_ACQUIRE, "agent");
      asm volatile("s_waitcnt vmcnt(0)" ::: "memory");
    }
  }
  __syncthreads();
}

DI void convw_tile(const float* __restrict__ src, u16* __restrict__ dst, int K, int N, int item, float* T) {
  const int t = tid_();
  const int ntn = N >> 5;
  const int n0 = (item % ntn) * 32, k0 = (item / ntn) * 64;
#pragma unroll
  for (int i = 0; i < 2; ++i) {
    const int kl = (t >> 3) + 32 * i, n4 = t & 7;
    const float4 v = *(const float4*)(src + (size_t)(k0 + kl) * N + n0 + 4 * n4);
    T[(4 * n4 + 0) * 65 + kl] = v.x; T[(4 * n4 + 1) * 65 + kl] = v.y;
    T[(4 * n4 + 2) * 65 + kl] = v.z; T[(4 * n4 + 3) * 65 + kl] = v.w;
  }
  __syncthreads();
  {
    const int n = t >> 3, k8 = (t & 7) * 8;
    const float* tr = T + n * 65 + k8;
    u32x4 q;
    q[0] = pack2(tr[0], tr[1]); q[1] = pack2(tr[2], tr[3]); q[2] = pack2(tr[4], tr[5]); q[3] = pack2(tr[6], tr[7]);
    *(u32x4*)(dst + (size_t)(n0 + n) * K + k0 + k8) = q;
  }
  __syncthreads();
}
constexpr int CONVW_ITEMS = 8976;
DI void convw_item(const Params& p, int l, int item, char* sm) {
  float* T = (float*)sm;
  char* ws = p.ws;
  if (item < 3728) convw_tile(p.w_in + (size_t)l * 1024 * INW, (u16*)(ws + WS_WIN), 1024, INW, item, T);
  else if (item < 4240) {
    const int it = item - 3728, n = it >> 7;
    convw_tile(p.w_branch + (size_t)(l * 4 + n) * 256 * 1024, (u16*)(ws + WS_WBR) + (size_t)n * 1024 * 256, 256, 1024, it & 127, T);
  } else if (item < 4752) convw_tile(p.w_out + (size_t)l * 1024 * 1024, (u16*)(ws + WS_WOUT), 1024, 1024, item - 4240, T);
  else if (item < 7568) convw_tile(p.w_up + (size_t)l * 1024 * DFF2, (u16*)(ws + WS_WUP), 1024, DFF2, item - 4752, T);
  else convw_tile(p.w_down + (size_t)l * DFF * 1024, (u16*)(ws + WS_WDN), DFF, 1024, item - 7568, T);
}

DI void mod_item(const Params& p, int item, char* sm) {
  float* sc = (float*)sm;
  float* red = sc + 3072;
  const int t = tid_();
  const int l = item / 96, j0 = (item % 96) * 64;
  for (int i = t; i < 3072; i += 256) {
    const int cnd = i >> 10, k = i & 1023;
    const float v = cnd == 0 ? p.c_ctx[k] : p.c[(cnd - 1) * 1024 + k];
    sc[i] = v * sigmoidf_(v);
  }
  __syncthreads();
  const int cq = t & 15, ks = t >> 4;
  float a0[4] = {0, 0, 0, 0}, a1[4] = {0, 0, 0, 0}, a2[4] = {0, 0, 0, 0};
  const float* wp = p.w_ada + (size_t)l * 1024 * 6144 + j0 + 4 * cq;
#pragma unroll 4
  for (int rr = 0; rr < 64; ++rr) {
    const int row = ks * 64 + rr;
    const float4 w4 = *(const float4*)(wp + (size_t)row * 6144);
    const float s0 = sc[row], s1 = sc[1024 + row], s2 = sc[2048 + row];
    a0[0] += s0 * w4.x; a0[1] += s0 * w4.y; a0[2] += s0 * w4.z; a0[3] += s0 * w4.w;
    a1[0] += s1 * w4.x; a1[1] += s1 * w4.y; a1[2] += s1 * w4.z; a1[3] += s1 * w4.w;
    a2[0] += s2 * w4.x; a2[1] += s2 * w4.y; a2[2] += s2 * w4.z; a2[3] += s2 * w4.w;
  }
#pragma unroll
  for (int q = 0; q < 4; ++q) {
    red[(ks * 3 + 0) * 64 + 4 * cq + q] = a0[q];
    red[(ks * 3 + 1) * 64 + 4 * cq + q] = a1[q];
    red[(ks * 3 + 2) * 64 + 4 * cq + q] = a2[q];
  }
  __syncthreads();
  if (t < 192) {
    const int cnd = t >> 6, col = t & 63;
    float s = p.b_ada[l * 6144 + j0 + col];
    for (int k = 0; k < 16; ++k) s += red[(k * 3 + cnd) * 64 + col];
    ((float*)(p.ws + WS_MOD))[(l * 3 + cnd) * 6144 + j0 + col] = s;
  }
  __syncthreads();
}

DI void norm_tok(const Params& p, int l, int which, int tok) {
  const int lane = tid_() & 63;
  const float* xr = which == 0 ? xin_row(p, l, tok) : p.out + (size_t)tok * DM;
  const float* g = (which == 0 ? p.norm1_g : p.norm2_g) + l * 1024;
  const float* mod = (const float*)(p.ws + WS_MOD) + (l * 3 + tok_cond(tok)) * 6144 + which * 3072;
  float4 v[4];
  float ss = 0.f;
#pragma unroll
  for (int i = 0; i < 4; ++i) {
    v[i] = *(const float4*)(xr + 4 * lane + 256 * i);
    ss += v[i].x * v[i].x + v[i].y * v[i].y + v[i].z * v[i].z + v[i].w * v[i].w;
  }
  ss = wave_sum(ss);
  const float rstd = rsqrtf(ss * (1.f / 1024.f) + EPSN);
  u16* hr = (u16*)(p.ws + WS_H) + (size_t)tok * DM;
#pragma unroll
  for (int i = 0; i < 4; ++i) {
    const int c0 = 4 * lane + 256 * i;
    const float4 gg = *(const float4*)(g + c0);
    const float4 sh = *(const float4*)(mod + c0);
    const float4 scv = *(const float4*)(mod + 1024 + c0);
    u32x2 q;
    q[0] = pack2(v[i].x * rstd * gg.x * (1.f + scv.x) + sh.x, v[i].y * rstd * gg.y * (1.f + scv.y) + sh.y);
    q[1] = pack2(v[i].z * rstd * gg.z * (1.f + scv.z) + sh.z, v[i].w * rstd * gg.w * (1.f + scv.w) + sh.w);
    *(u32x2*)(hr + c0) = q;
  }
}

template <int NJ>
DI void gemm_core(const u16* __restrict__ A, int lda, const u16* __restrict__ Bt, int ldb, int K, int m0, int n0, int N,
                  f32x16 (&acc)[2][NJ], u16* sm) {
  const int t = tid_(), lane = t & 63, w = t >> 6, r = lane & 31, h = lane >> 5;
  const int wm = w & 1, wn = w >> 1;
  u16* As = sm;
  u16* Bs = sm + 2 * 128 * 72;
  const int lrow = t >> 3, lc8 = (t & 7) * 8;
  int aoff[4], boff[2 * NJ];
#pragma unroll
  for (int i = 0; i < 4; ++i) aoff[i] = (m0 + lrow + 32 * i) * lda + lc8;
#pragma unroll
  for (int i = 0; i < 2 * NJ; ++i) {
    int bn = n0 + lrow + 32 * i;
    bn = bn < N ? bn : N - 1;
    boff[i] = bn * ldb + lc8;
  }
  u32x4 ra[4], rb[2 * NJ];
#pragma unroll
  for (int i = 0; i < 4; ++i) ra[i] = *(const u32x4*)(A + aoff[i]);
#pragma unroll
  for (int i = 0; i < 2 * NJ; ++i) rb[i] = *(const u32x4*)(Bt + boff[i]);
#pragma unroll
  for (int i = 0; i < 4; ++i) *(u32x4*)(As + (lrow + 32 * i) * 72 + lc8) = ra[i];
#pragma unroll
  for (int i = 0; i < 2 * NJ; ++i) *(u32x4*)(Bs + (lrow + 32 * i) * 72 + lc8) = rb[i];
  __syncthreads();
  const int KT = K >> 6;
  for (int kt = 0; kt < KT; ++kt) {
    const int buf = kt & 1;
    if (kt + 1 < KT) {
      const int k0 = (kt + 1) * 64;
#pragma unroll
      for (int i = 0; i < 4; ++i) ra[i] = *(const u32x4*)(A + aoff[i] + k0);
#pragma unroll
      for (int i = 0; i < 2 * NJ; ++i) rb[i] = *(const u32x4*)(Bt + boff[i] + k0);
    }
    const u16* as = As + buf * 128 * 72 + (wm * 64 + r) * 72 + 8 * h;
    const u16* bs = Bs + buf * 128 * 72 + (wn * 32 * NJ + r) * 72 + 8 * h;
#pragma unroll
    for (int ks = 0; ks < 4; ++ks) {
      const bf16x8 a0 = *(const bf16x8*)(as + ks * 16), a1 = *(const bf16x8*)(as + 32 * 72 + ks * 16);
#pragma unroll
      for (int j = 0; j < NJ; ++j) {
        const bf16x8 b0 = *(const bf16x8*)(bs + j * 32 * 72 + ks * 16);
        acc[0][j] = MFMA(a0, b0, acc[0][j]);
        acc[1][j] = MFMA(a1, b0, acc[1][j]);
      }
    }
    if (kt + 1 < KT) {
      const int nb = (buf ^ 1) * 128 * 72;
#pragma unroll
      for (int i = 0; i < 4; ++i) *(u32x4*)(As + nb + (lrow + 32 * i) * 72 + lc8) = ra[i];
#pragma unroll
      for (int i = 0; i < 2 * NJ; ++i) *(u32x4*)(Bs + nb + (lrow + 32 * i) * 72 + lc8) = rb[i];
    }
    __syncthreads();
  }
}
template <int NJ>
DI void zero_acc(f32x16 (&acc)[2][NJ]) {
#pragma unroll
  for (int i = 0; i < 2; ++i)
#pragma unroll
    for (int j = 0; j < NJ; ++j)
#pragma unroll
      for (int e = 0; e < 16; ++e) acc[i][j][e] = 0.f;
}
#define EPI_LOOP_N(NJ_, body)                                                       \
  {                                                                                 \
    const int lane_ = tid_() & 63, w_ = tid_() >> 6, r_ = lane_ & 31, h_ = lane_ >> 5; \
    _Pragma("unroll") for (int i_ = 0; i_ < 2; ++i_)                                 \
    _Pragma("unroll") for (int j_ = 0; j_ < NJ_; ++j_)                               \
    _Pragma("unroll") for (int e_ = 0; e_ < 16; ++e_) {                              \
      const int row = m0 + (w_ & 1) * 64 + i_ * 32 + crow(e_, h_);                  \
      const int col = n0 + (w_ >> 1) * 32 * NJ_ + j_ * 32 + r_;                     \
      body                                                                          \
    }                                                                               \
  }
#define EPI_LOOP(body) EPI_LOOP_N(2, body)

DI void gemm_in_item(const Params& p, int item, char* sm) {
  const int m0 = (item % 48) * 128, n0 = (item / 48) * 128;
  f32x16 acc[2][2];
  zero_acc<2>(acc);
  gemm_core<2>((const u16*)(p.ws + WS_H), 1024, (const u16*)(p.ws + WS_WIN), 1024, 1024, m0, n0, INW, acc, (u16*)sm);
  u16* z = (u16*)(p.ws + WS_Z);
  EPI_LOOP(if (col < INW) z[(size_t)row * INW + col] = f2bf(acc[i_][j_][e_]);)
}
DI void gemm_branch_item(const Params& p, int item, char* sm) {
  const int m0 = (item % 48) * 128, n0 = (item / 48) * 64;
  f32x16 tot[2][1];
  zero_acc<1>(tot);
  const u16* z = (const u16*)(p.ws + WS_Z);
#pragma unroll 1
  for (int n = 0; n < 4; ++n) {
    f32x16 acc[2][1];
    zero_acc<1>(acc);
    gemm_core<1>((const u16*)(p.ws + WS_YCAT) + n * 256, 1024, (const u16*)(p.ws + WS_WBR) + (size_t)n * 1024 * 256, 256, 256, m0, n0,
                 1024, acc, (u16*)sm);
    EPI_LOOP_N(1, const float gte = sigmoidf_(bf2f(z[(size_t)row * INW + Z_ML + n * 1024 + col]));
               tot[i_][j_][e_] += gte * acc[i_][j_][e_];)
  }
  u16* mix = (u16*)(p.ws + WS_MIX);
  EPI_LOOP_N(1, mix[(size_t)row * 1024 + col] = f2bf(tot[i_][j_][e_]);)
}
DI void gemm_out_item(const Params& p, int l, int item, char* sm) {
  const int m0 = (item % 48) * 128, n0 = (item / 48) * 128;
  f32x16 acc[2][2];
  zero_acc<2>(acc);
  gemm_core<2>((const u16*)(p.ws + WS_MIX), 1024, (const u16*)(p.ws + WS_WOUT), 1024, 1024, m0, n0, 1024, acc, (u16*)sm);
  const float* g1 = (const float*)(p.ws + WS_MOD) + (l * 3 + tok_cond(m0)) * 6144 + 2048;
  EPI_LOOP(const float xo = xin_row(p, l, row)[col]; p.out[(size_t)row * DM + col] = xo + g1[col] * acc[i_][j_][e_];)
}
DI void gemm_up_item(const Params& p, int item, char* sm) {
  const int m0 = (item % 48) * 128, n0 = (item / 48) * 128;
  f32x16 acc[2][2];
  zero_acc<2>(acc);
  gemm_core<2>((const u16*)(p.ws + WS_H), 1024, (const u16*)(p.ws + WS_WUP), 1024, 1024, m0, n0, DFF2, acc, (u16*)sm);
  u16* u = (u16*)(p.ws + WS_Z);
  EPI_LOOP(u[(size_t)row * DFF2 + col] = f2bf(acc[i_][j_][e_]);)
}
DI void gemm_down_item(const Params& p, int l, int item, char* sm) {
  const int m0 = (item % 48) * 128, n0 = (item / 48) * 128;
  f32x16 acc[2][2];
  zero_acc<2>(acc);
  gemm_core<2>((const u16*)(p.ws + WS_ACT), DFF, (const u16*)(p.ws + WS_WDN), DFF, DFF, m0, n0, 1024, acc, (u16*)sm);
  const float* g2 = (const float*)(p.ws + WS_MOD) + (l * 3 + tok_cond(m0)) * 6144 + 5120;
  EPI_LOOP(float* xp = p.out + (size_t)row * DM + col; *xp = *xp + g2[col] * acc[i_][j_][e_];)
}

DI void conv_act(const Params& p, int l, int gid, int gstride) {
  const u16* u = (const u16*)(p.ws + WS_Z);
  u16* act = (u16*)(p.ws + WS_ACT);
  const float* cw = p.conv_w + (size_t)l * 3 * DFF2;
  const float* cb = p.conv_b + (size_t)l * DFF2;
  for (int idx = gid; idx < NTOK * 352; idx += gstride) {
    const int tok = idx / 352, c0 = (idx % 352) * 8;
    int pos, L;
    if (tok < NCTX) { pos = tok & 255; L = 256; } else { pos = (tok - NCTX) & 1023; L = 1024; }
    float av[8], gv[8];
#pragma unroll
    for (int j = 0; j < 8; ++j) { av[j] = cb[c0 + j]; gv[j] = cb[DFF + c0 + j]; }
#pragma unroll
    for (int d = 0; d < 3; ++d) {
      const int pp = pos + d - 1;
      if (pp < 0 || pp >= L) continue;
      const u16* ur = u + (size_t)(tok + d - 1) * DFF2;
      const u32x4 ua = *(const u32x4*)(ur + c0), ug = *(const u32x4*)(ur + DFF + c0);
      const float* wa = cw + d * DFF2 + c0;
      const float* wg = wa + DFF;
#pragma unroll
      for (int q = 0; q < 4; ++q) {
        av[2 * q] += wa[2 * q] * lo_bf(ua[q]); av[2 * q + 1] += wa[2 * q + 1] * hi_bf(ua[q]);
        gv[2 * q] += wg[2 * q] * lo_bf(ug[q]); gv[2 * q + 1] += wg[2 * q + 1] * hi_bf(ug[q]);
      }
    }
    u32x4 o;
#pragma unroll
    for (int q = 0; q < 4; ++q)
      o[q] = pack2(gv[2 * q] * sigmoidf_(gv[2 * q]) * av[2 * q], gv[2 * q + 1] * sigmoidf_(gv[2 * q + 1]) * av[2 * q + 1]);
    *(u32x4*)(act + (size_t)tok * DFF + c0) = o;
  }
}

DI void prep_item(const Params& p, int l, int item) {
  const int lane = tid_() & 63, w = tid_() >> 6;
  char* ws = p.ws;
  u16* qA = (u16*)(ws + WS_QA); u16* qC = (u16*)(ws + WS_QC);
  u16* kA = (u16*)(ws + WS_KA); u16* vA = (u16*)(ws + WS_VA);
  u16* kC = (u16*)(ws + WS_KC); u16* vC = (u16*)(ws + WS_VC);
  if (item >= NTOK) {
    const int cr = item - NTOK, b = cr >> 9, key = cr & 511;
    const size_t keyrow = 4096 + b * 1536 + key;
    const size_t srow = (size_t)(b * 2 + l) * 512 + key;
    for (int u = w; u < 12; u += 4) {
      if (u < 2) kA[keyrow * 128 + u * 64 + lane] = f2bf(p.cache_a_k[srow * 128 + u * 64 + lane]);
      else if (u < 4) vA[keyrow * 128 + (u - 2) * 64 + lane] = f2bf(p.cache_a_v[srow * 128 + (u - 2) * 64 + lane]);
      else if (u < 8) kC[keyrow * 256 + (u - 4) * 64 + lane] = f2bf(p.cache_c_k[srow * 256 + (u - 4) * 64 + lane]);
      else vC[keyrow * 256 + (u - 8) * 64 + lane] = f2bf(p.cache_c_v[srow * 256 + (u - 8) * 64 + lane]);
    }
    return;
  }
  const int tok = item;
  const bool sample = tok >= NCTX;
  int b, pos;
  size_t keyrow;
  if (!sample) { b = tok >> 8; pos = tok & 255; keyrow = tok; }
  else { b = (tok - NCTX) >> 10; pos = (tok - NCTX) & 1023; keyrow = 4096 + b * 1536 + 512 + pos; }
  const size_t crow_o = (size_t)(b * 2 + l) * 256 + pos;
  const u16* zr = (const u16*)(ws + WS_Z) + (size_t)tok * INW;
  const float rowp = (float)(pos >> 6), colp = (float)(pos & 63);
  for (int u = w; u < 20; u += 4) {
    if (u < 6) {
      const bool isq = u < 4;
      const int hd = isq ? u : u - 4;
      const float x = bf2f(zr[(isq ? ZA_Q : ZA_K) + hd * 64 + lane]);
      const float ss = wave_sum(x * x);
      float y = x * rsqrtf(ss * (1.f / 64.f) + EPSN) * (isq ? p.a_qn_g : p.a_kn_g)[l * 64 + lane];
      if (!sample && !isq) p.out[O_CAK + crow_o * 128 + hd * 64 + lane] = y;
      if (sample) {
        const int a = lane >> 5, pb = (lane >> 4) & 1, i = lane & 15;
        const float freq = exp2f(-(float)i * (0.0625f * 13.287712379549449f));
        const float ang = (a ? colp : rowp) * freq;
        const float pr = __shfl_xor(y, 16);
        y = y * __cosf(ang) + (pb ? pr : -pr) * __sinf(ang);
      }
      if (isq) qA[(size_t)tok * 256 + hd * 64 + lane] = f2bf(y);
      else kA[keyrow * 128 + hd * 64 + lane] = f2bf(y);
    } else if (u < 8) {
      const int hd = u - 6;
      const u16 raw = zr[ZA_V + hd * 64 + lane];
      if (!sample) p.out[O_CAV + crow_o * 128 + hd * 64 + lane] = bf2f(raw);
      vA[keyrow * 128 + hd * 64 + lane] = raw;
    } else if (u < 16) {
      const bool isq = u < 12;
      const int pr2 = isq ? u - 8 : u - 12;
      const float x = bf2f(zr[(isq ? ZC_Q : ZC_K) + pr2 * 64 + lane]);
      float ss = x * x;
#pragma unroll
      for (int o = 16; o >= 1; o >>= 1) ss += __shfl_xor(ss, o);
      float y = x * rsqrtf(ss * (1.f / 32.f) + EPSN) * (isq ? p.c_qn_g : p.c_kn_g)[l * 32 + (lane & 31)];
      if (!sample && !isq) p.out[O_CCK + crow_o * 256 + pr2 * 64 + lane] = y;
      if (sample) {
        const int dd = lane & 31, a = dd >> 4, pb = (dd >> 3) & 1, i = dd & 7;
        const float freq = exp2f(-(float)i * (0.125f * 13.287712379549449f));
        const float ang = (a ? colp : rowp) * freq;
        const float pr = __shfl_xor(y, 8);
        y = y * __cosf(ang) + (pb ? pr : -pr) * __sinf(ang);
      }
      if (isq) qC[(size_t)tok * 256 + pr2 * 64 + lane] = f2bf(y);
      else kC[keyrow * 256 + pr2 * 64 + lane] = f2bf(y);
    } else {
      const int hd = u - 16;
      const u16 raw = zr[ZC_V + hd * 64 + lane];
      if (!sample) p.out[O_CCV + crow_o * 256 + hd * 64 + lane] = bf2f(raw);
      vC[keyrow * 256 + hd * 64 + lane] = raw;
    }
  }
}

template <bool ISC>
DI void attn_item(const Params& p, int l, int tok0, int keyrow0, int nkeys, int head, char* smraw) {
  constexpr int NM = ISC ? 2 : 1;
  u16* Ks = (u16*)smraw;
  u16* Vs = Ks + 2 * 64 * 72;
  const u16* qbuf = (const u16*)(p.ws + (ISC ? WS_QC : WS_QA));
  const u16* kbuf = (const u16*)(p.ws + (ISC ? WS_KC : WS_KA));
  const u16* vbuf = (const u16*)(p.ws + (ISC ? WS_VC : WS_VA));
  const int kstride = ISC ? 256 : 128;
  const int koff = ISC ? head * 64 : (head >> 1) * 64;
  const float c2 = (ISC ? 0.17677669529663687f : 0.125f) * 1.4426950408889634f;
  const int t = tid_(), lane = t & 63, w = t >> 6, r = lane & 31, h = lane >> 5;
  const int i16 = lane & 15, tq = i16 >> 2, tp = i16 & 3, blk = (lane >> 4) & 1;
  bf16x8 qf[4];
  {
    const u16* qp = qbuf + (size_t)(tok0 + 32 * w + r) * 256 + head * 64 + 8 * h;
#pragma unroll
    for (int s = 0; s < 4; ++s) qf[s] = *(const bf16x8*)(qp + 16 * s);
  }
  f32x16 O[NM][2];
  float mrun[NM], lsum[NM];
#pragma unroll
  for (int m = 0; m < NM; ++m) {
    mrun[m] = -INFINITY; lsum[m] = 0.f;
#pragma unroll
    for (int d = 0; d < 2; ++d)
#pragma unroll
      for (int e = 0; e < 16; ++e) O[m][d][e] = 0.f;
  }
  const int lrow = t >> 3, lc8 = (t & 7) * 8;
  const u16* kg = kbuf + (size_t)(keyrow0 + lrow) * kstride + koff + lc8;
  const u16* vg = vbuf + (size_t)(keyrow0 + lrow) * kstride + koff + lc8;
  u32x4 rk[2], rv[2];
#pragma unroll
  for (int i = 0; i < 2; ++i) { rk[i] = *(const u32x4*)(kg + (size_t)(32 * i) * kstride); rv[i] = *(const u32x4*)(vg + (size_t)(32 * i) * kstride); }
#pragma unroll
  for (int i = 0; i < 2; ++i) {
    *(u32x4*)(Ks + (lrow + 32 * i) * 72 + lc8) = rk[i];
    *(u32x4*)(Vs + (lrow + 32 * i) * 72 + lc8) = rv[i];
  }
  __syncthreads();
  const int NT = nkeys >> 6;
  for (int kt = 0; kt < NT; ++kt) {
    const int buf = kt & 1;
    if (kt + 1 < NT) {
#pragma unroll
      for (int i = 0; i < 2; ++i) {
        rk[i] = *(const u32x4*)(kg + (size_t)((kt + 1) * 64 + 32 * i) * kstride);
        rv[i] = *(const u32x4*)(vg + (size_t)((kt + 1) * 64 + 32 * i) * kstride);
      }
    }
    const u16* kb_ = Ks + buf * 64 * 72;
    const u16* vb_ = Vs + buf * 64 * 72;
#pragma unroll
    for (int kb = 0; kb < 2; ++kb) {
      f32x16 S[NM];
#pragma unroll
      for (int m = 0; m < NM; ++m)
#pragma unroll
        for (int e = 0; e < 16; ++e) S[m][e] = 0.f;
#pragma unroll
      for (int s = 0; s < 4; ++s) {
        const int m = ISC ? (s >> 1) : 0;
        const bf16x8 kf = *(const bf16x8*)(kb_ + (kb * 32 + r) * 72 + 16 * s + 8 * h);
        S[m] = MFMA(kf, qf[s], S[m]);
      }
#pragma unroll
      for (int m = 0; m < NM; ++m) {
        float mx = S[m][0];
#pragma unroll
        for (int e = 1; e < 16; ++e) mx = fmaxf(mx, S[m][e]);
        mx = fmaxf(mx, __shfl_xor(mx, 32));
        const float mnew = fmaxf(mrun[m], mx);
        const float alpha = exp2f((mrun[m] - mnew) * c2);
        mrun[m] = mnew;
        const float mc = mnew * c2;
        float ps = 0.f;
#pragma unroll
        for (int e = 0; e < 16; ++e) { const float pe = exp2f(S[m][e] * c2 - mc); S[m][e] = pe; ps += pe; }
        lsum[m] = lsum[m] * alpha + ps;
        if (__any(alpha != 1.f)) {
#pragma unroll
          for (int d = 0; d < 2; ++d)
#pragma unroll
            for (int e = 0; e < 16; ++e) O[m][d][e] *= alpha;
        }
      }
#pragma unroll
      for (int st = 0; st < 2; ++st) {
        bf16x8 pf[NM];
#pragma unroll
        for (int m = 0; m < NM; ++m) pf[m] = pack8(S[m], st);
#pragma unroll
        for (int d = 0; d < 2; ++d) {
          const u16* vp = vb_ + (kb * 32 + 16 * st + 4 * h + tq) * 72 + d * 32 + 16 * blk + 4 * tp;
          const bf16x8 vf = trpair(vp, vp + 8 * 72);
#pragma unroll
          for (int m = 0; m < NM; ++m) O[m][d] = MFMA(vf, pf[m], O[m][d]);
        }
      }
    }
    if (kt + 1 < NT) {
      const int nb = (buf ^ 1) * 64 * 72;
#pragma unroll
      for (int i = 0; i < 2; ++i) {
        *(u32x4*)(Ks + nb + (lrow + 32 * i) * 72 + lc8) = rk[i];
        *(u32x4*)(Vs + nb + (lrow + 32 * i) * 72 + lc8) = rv[i];
      }
    }
    __syncthreads();
  }
  float inv[NM];
#pragma unroll
  for (int m = 0; m < NM; ++m) { const float lt = lsum[m] + __shfl_xor(lsum[m], 32); inv[m] = 1.f / lt; }
  const int tok = tok0 + 32 * w + r;
  u16* yc = (u16*)(p.ws + WS_YCAT) + (size_t)tok * 1024;
  if (!ISC) {
#pragma unroll
    for (int d = 0; d < 2; ++d)
#pragma unroll
      for (int g = 0; g < 4; ++g) {
        u32x2 q;
        q[0] = pack2(O[0][d][4 * g] * inv[0], O[0][d][4 * g + 1] * inv[0]);
        q[1] = pack2(O[0][d][4 * g + 2] * inv[0], O[0][d][4 * g + 3] * inv[0]);
        *(u32x2*)(yc + head * 64 + d * 32 + 8 * g + 4 * h) = q;
      }
  } else {
    const float* cl = p.c_lambda + l * 128;
    float d1 = 0.f, d2 = 0.f;
    for (int i = 0; i < 32; ++i) { d1 += cl[i] * cl[32 + i]; d2 += cl[64 + i] * cl[96 + i]; }
    const float lam_init = 0.8f - 0.6f * __expf(-0.3f * (float)l);
    const float lam = __expf(d1) - __expf(d2) + lam_init;
    float ss = 0.f;
#pragma unroll
    for (int d = 0; d < 2; ++d)
#pragma unroll
      for (int e = 0; e < 16; ++e) {
        const float dv = O[0][d][e] * inv[0] - lam * (O[NM - 1][d][e] * inv[NM - 1]);
        O[0][d][e] = dv; ss += dv * dv;
      }
    ss += __shfl_xor(ss, 32);
    const float sc = rsqrtf(ss * (1.f / 64.f) + EPSN) * (1.f - lam_init);
    const float* sg = p.c_subln_g + l * 64;
#pragma unroll
    for (int d = 0; d < 2; ++d)
#pragma unroll
      for (int g = 0; g < 4; ++g) {
        const int dv0 = d * 32 + 8 * g + 4 * h;
        u32x2 q;
        q[0] = pack2(O[0][d][4 * g] * sc * sg[dv0], O[0][d][4 * g + 1] * sc * sg[dv0 + 1]);
        q[1] = pack2(O[0][d][4 * g + 2] * sc * sg[dv0 + 2], O[0][d][4 * g + 3] * sc * sg[dv0 + 3]);
        *(u32x2*)(yc + 512 + head * 64 + dv0) = q;
      }
  }
}
DI void attn_dispatch(const Params& p, int l, int item, char* sm) {
  if (item < 128) {
    const int j = item & 63, b = j >> 5, qb = (j >> 2) & 7, head = j & 3;
    const int tok0 = NCTX + b * 1024 + qb * 128, kr0 = 4096 + b * 1536;
    if (item < 64) attn_item<true>(p, l, tok0, kr0, 1536, head, sm);
    else attn_item<false>(p, l, tok0, kr0, 1536, head, sm);
  } else {
    const int j = (item - 128) & 127, s = j >> 3, qb = (j >> 2) & 1, head = j & 3;
    const int tok0 = s * 256 + qb * 128, kr0 = s * 256;
    if (item < 256) attn_item<true>(p, l, tok0, kr0, 256, head, sm);
    else attn_item<false>(p, l, tok0, kr0, 256, head, sm);
  }
}

template <bool GLA>
struct ScanCtx { float wa[16]; float ba, lbm, oml; int ldir; };
template <bool GLA>
DI void scan_init(const Params& p, int l, int head, int dirh, int lane, ScanCtx<GLA>& cx) {
  const int ldir = GLA ? (lane >> 5) : dirh;
  cx.ldir = ldir;
  if (GLA) {
    const int kc = lane & 31;
#pragma unroll
    for (int j = 0; j < 16; ++j) cx.wa[j] = p.d_alpha_w[((size_t)(l * 2 + ldir) * 16 + j) * 128 + head * 32 + kc];
    cx.ba = p.d_alpha_b[(l * 2 + ldir) * 128 + head * 32 + kc];
  } else {
    float lb = 0.f;
    if (l > 0) {
      const float x0 = p.b_lb_logits[(ldir * 2 + 0) * 256 + head * 64 + lane], x1 = p.b_lb_logits[(ldir * 2 + 1) * 256 + head * 64 + lane];
      lb = 1.f / (1.f + __expf(x0 - x1));
    }
    cx.lbm = fmaxf(lb, 1e-30f); cx.oml = 1.f - lb;
  }
}
template <bool GLA>
DI float scan_la(const Params& p, const ScanCtx<GLA>& cx, int tok, int head, int lane, float& kk) {
  const u16* zr = (const u16*)(p.ws + WS_Z) + (size_t)tok * INW;
  if (GLA) {
    const u32x4 r0 = *(const u32x4*)(zr + ZD_RF + cx.ldir * 16), r1 = *(const u32x4*)(zr + ZD_RF + cx.ldir * 16 + 8);
    float v = cx.ba;
#pragma unroll
    for (int q = 0; q < 4; ++q) {
      v += cx.wa[2 * q] * lo_bf(r0[q]) + cx.wa[2 * q + 1] * hi_bf(r0[q]);
      v += cx.wa[8 + 2 * q] * lo_bf(r1[q]) + cx.wa[8 + 2 * q + 1] * hi_bf(r1[q]);
    }
    kk = bf2f(zr[ZD_K + head * 32 + (lane & 31)]);
    return (fminf(v, 0.f) - __logf(1.f + __expf(-fabsf(v)))) * (1.f / 16.f);
  } else {
    const float zz = bf2f(zr[(cx.ldir ? ZB_FB : ZB_FF) + head * 64 + lane]);
    const float sig = 1.f / (1.f + __expf(-zz));
    kk = cx.oml / (1.f + __expf(zz));
    return __logf(cx.lbm + cx.oml * sig);
  }
}
DI int tile_id(bool gla, int chunk, int head, int dir) { return gla ? 1536 + chunk * 4 + head : (chunk * 4 + head) * 2 + dir; }

template <bool GLA>
DI void scan_s1(const Params& p, int l, int chunk, int head, int dir, bool valid, u16* smw) {
  const int lane = tid_() & 63, r = lane & 31, h = lane >> 5;
  const int i16 = lane & 15, tq = i16 >> 2, tp = i16 & 3, blk = (lane >> 4) & 1;
  u16* ko = smw;
  u16* vt = smw + 32 * 72;
  const int start = chunk * 32;
  const u16* z = (const u16*)(p.ws + WS_Z);
  {
    ScanCtx<GLA> cx;
    scan_init<GLA>(p, l, head, dir, lane, cx);
    const int ldir = cx.ldir;
    float cl = 0.f, kk;
#pragma unroll 4
    for (int i = 0; i < 32; ++i) cl += scan_la<GLA>(p, cx, start + (ldir ? 31 - i : i), head, lane, kk);
    float cum = 0.f;
#pragma unroll 4
    for (int i = 0; i < 32; ++i) {
      const int pp = ldir ? 31 - i : i;
      cum += scan_la<GLA>(p, cx, start + pp, head, lane, kk);
      ko[pp * 72 + lane] = f2bf(kk * __expf(cl - cum));
    }
    if (valid) ((float*)(p.ws + WS_CL))[tile_id(GLA, chunk, head, dir) * 64 + lane] = cl;
  }
  {
    const int vcol = (GLA ? ZD_V : ZB_I) + head * 64;
#pragma unroll
    for (int i = 0; i < 4; ++i) {
      const int row = (lane >> 3) + 8 * i, c8 = (lane & 7) * 8;
      *(u32x4*)(vt + row * 72 + c8) = *(const u32x4*)(z + (size_t)(start + row) * INW + vcol + c8);
    }
  }
  __syncthreads();
  f32x16 acc[2][2];
  zero_acc<2>(acc);
#pragma unroll
  for (int st = 0; st < 2; ++st) {
    bf16x8 a[2], b[2];
#pragma unroll
    for (int x = 0; x < 2; ++x) {
      const u16* ap = vt + (16 * st + 8 * h + tq) * 72 + x * 32 + 16 * blk + 4 * tp;
      a[x] = trpair(ap, ap + 4 * 72);
      const u16* bp = ko + (16 * st + 8 * h + tq) * 72 + x * 32 + 16 * blk + 4 * tp;
      b[x] = trpair(bp, bp + 4 * 72);
    }
#pragma unroll
    for (int x = 0; x < 2; ++x)
#pragma unroll
      for (int y = 0; y < 2; ++y) acc[x][y] = MFMA(a[x], b[y], acc[x][y]);
  }
  if (valid) {
    float* U = (float*)(p.ws + WS_U) + (size_t)tile_id(GLA, chunk, head, dir) * 4096;
#pragma unroll
    for (int x = 0; x < 2; ++x)
#pragma unroll
      for (int y = 0; y < 2; ++y)
#pragma unroll
        for (int e = 0; e < 16; ++e) U[(x * 32 + crow(e, h)) * 64 + y * 32 + r] = acc[x][y][e];
  }
  __syncthreads();
}
DI void scan_s1_block(const Params& p, int l, int bitem, char* sm) {
  const int w = tid_() >> 6;
  int wi = bitem * 4 + w;
  u16* smw = (u16*)sm + w * (2 * 32 * 72);
  if (bitem < 384) scan_s1<false>(p, l, wi >> 3, (wi >> 1) & 3, wi & 1, true, smw);
  else { wi -= 1536; scan_s1<true>(p, l, wi >> 2, wi & 3, 0, true, smw); }
}

DI void scan_s2_item(const Params& p, int l, int item) {
  const int t = tid_();
  const int unit = item >> 2, vq = item & 3;
  const bool gla = unit >= 144;
  int seq, head, dir;
  if (!gla) { seq = unit >> 3; head = (unit >> 1) & 3; dir = unit & 1; }
  else { const int g = unit - 144; seq = g >> 2; head = g & 3; dir = 0; }
  const int c = t & 63;
  const int dc = gla ? (c >> 5) : dir;
  int N, chunk0;
  if (seq < 16) { N = 8; chunk0 = seq * 8; } else { N = 32; chunk0 = 128 + (seq - 16) * 32; }
  float S[4];
  int vv[4];
#pragma unroll
  for (int i = 0; i < 4; ++i) {
    vv[i] = vq * 16 + (t >> 6) + 4 * i;
    if (seq < 16) S[i] = 0.f;
    else {
      const int b = seq - 16;
      S[i] = gla ? p.state_gla[(size_t)(((b * 2 + l) * 2 + dc) * 4 + head) * 2048 + (c & 31) * 64 + vv[i]]
                 : p.state_hgrn[(size_t)(((b * 2 + l) * 2 + dc) * 4 + head) * 4096 + c * 64 + vv[i]];
    }
  }
  const float* __restrict__ U = (const float*)(p.ws + WS_U);
  const float* __restrict__ CL = (const float*)(p.ws + WS_CL);
  float* __restrict__ SS = (float*)(p.ws + WS_S);
  for (int m0 = 0; m0 < N; m0 += 4) {
    float tmp[4][4], a[4];
    int ids[4];
#pragma unroll
    for (int mm = 0; mm < 4; ++mm) {
      const int m = m0 + mm;
      ids[mm] = tile_id(gla, chunk0 + (dc ? N - 1 - m : m), head, dir);
      a[mm] = CL[ids[mm] * 64 + c];
#pragma unroll
      for (int i = 0; i < 4; ++i) tmp[mm][i] = U[(size_t)ids[mm] * 4096 + vv[i] * 64 + c];
    }
#pragma unroll
    for (int mm = 0; mm < 4; ++mm) {
      const float ea = __expf(a[mm]);
#pragma unroll
      for (int i = 0; i < 4; ++i) {
        SS[(size_t)ids[mm] * 4096 + vv[i] * 64 + c] = S[i];
        S[i] = ea * S[i] + tmp[mm][i];
      }
    }
  }
  if (seq < 16) {
#pragma unroll
    for (int i = 0; i < 4; ++i) {
      if (gla) p.out[O_SG + (size_t)(((seq * 2 + l) * 2 + dc) * 4 + head) * 2048 + (c & 31) * 64 + vv[i]] = S[i];
      else p.out[O_SH + (size_t)(((seq * 2 + l) * 2 + dc) * 4 + head) * 4096 + c * 64 + vv[i]] = S[i];
    }
  }
}

template <bool GLA>
DI void scan_s3(const Params& p, int l, int chunk, int head, u16* smw) {
  const int lane = tid_() & 63, r = lane & 31, h = lane >> 5;
  const int i16 = lane & 15, tq = i16 >> 2, tp = i16 & 3, blk = (lane >> 4) & 1;
  u16* qt = smw;
  u16* kt = smw + 32 * 72;
  u16* vt = smw + 2 * 32 * 72;
  float* sref = (float*)(smw + 3 * 32 * 72);
  const int start = chunk * 32;
  const u16* z = (const u16*)(p.ws + WS_Z);
  {
    const int vcol = (GLA ? ZD_V : ZB_I) + head * 64;
#pragma unroll
    for (int i = 0; i < 4; ++i) {
      const int row = (lane >> 3) + 8 * i, c8 = (lane & 7) * 8;
      *(u32x4*)(vt + row * 72 + c8) = *(const u32x4*)(z + (size_t)(start + row) * INW + vcol + c8);
    }
  }
  f32x16 o[2];
#pragma unroll
  for (int x = 0; x < 2; ++x)
#pragma unroll
    for (int e = 0; e < 16; ++e) o[x][e] = 0.f;
  constexpr int NPASS = GLA ? 1 : 2;
#pragma unroll 1
  for (int pass = 0; pass < NPASS; ++pass) {
    {
      ScanCtx<GLA> cx;
      scan_init<GLA>(p, l, head, pass, lane, cx);
      const int ldir = cx.ldir;
      float ref = 0.f, kk, cum = 0.f;
#pragma unroll 4
      for (int i = 0; i < 16; ++i) ref += scan_la<GLA>(p, cx, start + (ldir ? 31 - i : i), head, lane, kk);
      sref[lane] = __expf(ref);
#pragma unroll 4
      for (int i = 0; i < 32; ++i) {
        const int pp = ldir ? 31 - i : i;
        const int tok = start + pp;
        cum += scan_la<GLA>(p, cx, tok, head, lane, kk);
        float qv;
        if (GLA) qv = bf2f(z[(size_t)tok * INW + ZD_Q + head * 32 + (lane & 31)]) * 0.17677669529663687f;
        else { const float zq = bf2f(z[(size_t)tok * INW + ZB_Q + head * 64 + lane]); qv = zq * sigmoidf_(zq); }
        qt[pp * 72 + lane] = f2bf(qv * __expf(cum - ref));
        kt[pp * 72 + lane] = f2bf(kk * __expf(ref - cum));
      }
    }
    __syncthreads();
    constexpr int NS = GLA ? 2 : 1;
    f32x16 sc[NS];
#pragma unroll
    for (int m = 0; m < NS; ++m)
#pragma unroll
      for (int e = 0; e < 16; ++e) sc[m][e] = 0.f;
    bf16x8 qfr[4];
#pragma unroll
    for (int st = 0; st < 4; ++st) {
      qfr[st] = *(const bf16x8*)(qt + r * 72 + 16 * st + 8 * h);
      const bf16x8 kf = *(const bf16x8*)(kt + r * 72 + 16 * st + 8 * h);
      const int m = GLA ? (st >> 1) : 0;
      sc[m] = MFMA(kf, qfr[st], sc[m]);
    }
#pragma unroll
    for (int m = 0; m < NS; ++m) {
      const int d = GLA ? m : pass;
#pragma unroll
      for (int e = 0; e < 16; ++e) {
        const int s = crow(e, h);
        const bool keep = d ? (s >= r) : (s <= r);
        sc[m][e] = keep ? sc[m][e] : 0.f;
      }
#pragma unroll
      for (int st = 0; st < 2; ++st) {
        const bf16x8 pf = pack8(sc[m], st);
#pragma unroll
        for (int x = 0; x < 2; ++x) {
          const u16* vp = vt + (16 * st + 4 * h + tq) * 72 + x * 32 + 16 * blk + 4 * tp;
          const bf16x8 vf = trpair(vp, vp + 8 * 72);
          o[x] = MFMA(vf, pf, o[x]);
        }
      }
    }
    const float* Sg = (const float*)(p.ws + WS_S) + (size_t)tile_id(GLA, chunk, head, pass) * 4096;
#pragma unroll
    for (int x = 0; x < 2; ++x)
#pragma unroll
      for (int st = 0; st < 4; ++st) {
        const float* sp = Sg + (x * 32 + r) * 64 + 16 * st + 8 * h;
        const float4 s0 = *(const float4*)sp, s1 = *(const float4*)(sp + 4);
        const float4 e0 = *(const float4*)(sref + 16 * st + 8 * h), e1 = *(const float4*)(sref + 16 * st + 8 * h + 4);
        u32x4 q;
        q[0] = pack2(s0.x * e0.x, s0.y * e0.y); q[1] = pack2(s0.z * e0.z, s0.w * e0.w);
        q[2] = pack2(s1.x * e1.x, s1.y * e1.y); q[3] = pack2(s1.z * e1.z, s1.w * e1.w);
        o[x] = MFMA(__builtin_bit_cast(bf16x8, q), qfr[st], o[x]);
      }
    __syncthreads();
  }
  float ss = 0.f;
#pragma unroll
  for (int x = 0; x < 2; ++x)
#pragma unroll
    for (int e = 0; e < 16; ++e) ss += o[x][e] * o[x][e];
  ss += __shfl_xor(ss, 32);
  const float rstd = rsqrtf(ss * (1.f / 64.f) + EPSN);
  const int tok = start + r;
  const float* gn = (GLA ? p.d_norm_g : p.b_norm_g) + l * 64;
  const u16* gz = z + (size_t)tok * INW + (GLA ? ZD_G : ZB_G) + head * 64;
  u16* yc = (u16*)(p.ws + WS_YCAT) + (size_t)tok * 1024 + (GLA ? 768 : 256) + head * 64;
#pragma unroll
  for (int x = 0; x < 2; ++x)
#pragma unroll
    for (int g = 0; g < 4; ++g) {
      const int v0 = x * 32 + 8 * g + 4 * h;
      const u32x2 gr = *(const u32x2*)(gz + v0);
      const float g0 = lo_bf(gr[0]), g1 = hi_bf(gr[0]), g2 = lo_bf(gr[1]), g3 = hi_bf(gr[1]);
      u32x2 q;
      q[0] = pack2(o[x][4 * g] * rstd * gn[v0] * g0 * sigmoidf_(g0), o[x][4 * g + 1] * rstd * gn[v0 + 1] * g1 * sigmoidf_(g1));
      q[1] = pack2(o[x][4 * g + 2] * rstd * gn[v0 + 2] * g2 * sigmoidf_(g2), o[x][4 * g + 3] * rstd * gn[v0 + 3] * g3 * sigmoidf_(g3));
      *(u32x2*)(yc + v0) = q;
    }
}
DI void scan_s3_block(const Params& p, int l, int bitem, char* sm) {
  const int w = tid_() >> 6;
  u16* smw = (u16*)sm + w * (3 * 32 * 72 + 128);
  int wi = bitem * 4 + w;
  if (bitem < 192) scan_s3<false>(p, l, wi >> 2, wi & 3, smw);
  else { wi -= 768; scan_s3<true>(p, l, wi >> 2, wi & 3, smw); }
}

DI void run_phase(const Params& p, int ph, char* sm) {
  const int bid = blockIdx.x, nb = gridDim.x;
#ifdef PHASE_ONLY
  if (ph != 0 && (ph - 1) % 11 != PHASE_ONLY - 1) return;
  if (ph == 0 && PHASE_ONLY != 0) return;
#endif
  if (ph == 0) {
    for (int it = bid; it < 192 + CONVW_ITEMS; it += nb) {
      if (it < 192) mod_item(p, it, sm); else convw_item(p, 0, it - 192, sm);
    }
    return;
  }
  const int l = (ph - 1) / 11, s = (ph - 1) % 11;
  switch (s) {
    case 0: {
      const int w = tid_() >> 6;
      for (int tk = bid * 4 + w; tk < NTOK; tk += nb * 4) norm_tok(p, l, 0, tk);
      if (l > 0) for (int it = bid; it < CONVW_ITEMS; it += nb) convw_item(p, l, it, sm);
    } break;
    case 1: for (int it = bid; it < 48 * 59; it += nb) gemm_in_item(p, it, sm); break;
    case 2:
      for (int it = bid; it < 576 + 7168; it += nb) {
        if (it < 576) scan_s1_block(p, l, it, sm); else prep_item(p, l, it - 576);
      }
      break;
    case 3:
      for (int it = bid; it < 384 + 864; it += nb) {
        if (it < 128) attn_dispatch(p, l, it, sm);
        else if (it < 128 + 864) scan_s2_item(p, l, it - 128);
        else attn_dispatch(p, l, it - 864, sm);
      }
      break;
    case 4: for (int it = bid; it < 384; it += nb) scan_s3_block(p, l, it, sm); break;
    case 5: for (int it = bid; it < 768; it += nb) gemm_branch_item(p, it, sm); break;
    case 6: for (int it = bid; it < 384; it += nb) gemm_out_item(p, l, it, sm); break;
    case 7: {
      const int w = tid_() >> 6;
      for (int tk = bid * 4 + w; tk < NTOK; tk += nb * 4) norm_tok(p, l, 1, tk);
    } break;
    case 8: for (int it = bid; it < 48 * 44; it += nb) gemm_up_item(p, it, sm); break;
    case 9: conv_act(p, l, bid * 256 + tid_(), nb * 256); break;
    case 10: for (int it = bid; it < 384; it += nb) gemm_down_item(p, l, it, sm); break;
  }
}

__global__ void __launch_bounds__(256, 2) fwd_mega(Params p) {
  __shared__ __attribute__((aligned(16))) char sm[SMEM_BYTES];
  __shared__ uint4 xb_words;
  cg::grid_group grid = cg::this_grid();
  if (p.coop == 2) grid.sync();
  if (__builtin_amdgcn_workitem_id_x() == 0) xb_words = make_uint4(0u, 0u, 0u, 0u);
  __syncthreads();
  XcdBarrier xb;
  if (p.coop) xb = xcd_barrier_post((unsigned*)(p.ws + WS_BAR), (volatile LAS unsigned*)&xb_words);
  for (int ph = p.phase_begin; ph < p.phase_end; ++ph) {
    if (ph > p.phase_begin && p.coop) xcd_barrier(xb);
    run_phase(p, ph, sm);
  }
}

extern "C" void kernel_launch(void* const* d_in, const int* in_sizes, int n_in, void* d_out, int out_size, void* d_ws,
                              size_t ws_size, hipStream_t stream) {
  static int grid_blocks = 0;
  if (!grid_blocks) {
    int dev = 0, cus = 0, per_cu = 0;
    hipGetDevice(&dev);
    hipDeviceGetAttribute(&cus, hipDeviceAttributeMultiprocessorCount, dev);
    hipOccupancyMaxActiveBlocksPerMultiprocessor(&per_cu, fwd_mega, 256, 0);
    if (per_cu > 2) per_cu = 2;
    if (per_cu < 1) per_cu = 1;
    grid_blocks = cus * per_cu;
  }
  Params p{};
  const float** pp = (const float**)&p;
  for (int i = 0; i < 32; ++i) pp[i] = (const float*)d_in[i];
  p.out = (float*)d_out;
  p.ws = (char*)d_ws;
  if (ws_size < WS_END) { fprintf(stderr, "workspace too small: %zu < %zu\n", ws_size, (size_t)WS_END); return; }
#if MULTI
  for (int ph = 0; ph < NPHASE; ++ph) {
    p.phase_begin = ph; p.phase_end = ph + 1; p.coop = 0; p.pad = 0;
    hipLaunchKernelGGL(fwd_mega, dim3(grid_blocks), dim3(256), 0, stream, p);
  }
#else
  p.phase_begin = 0; p.phase_end = NPHASE; p.coop = 1; p.pad = 0;
  hipMemsetAsync((char*)d_ws + WS_BAR, 0, 16384, stream);
  void* args[] = {&p};
  hipError_t e = hipLaunchCooperativeKernel((void*)fwd_mega, dim3(grid_blocks), dim3(256), args, 0, stream);
  if (e != hipSuccess) fprintf(stderr, "cooperative launch failed: %s (grid %d)\n", hipGetErrorString(e), grid_blocks);
#endif
}
```

```cpp
#include <hip/hip_runtime.h>
#include <hip/hip_bf16.h>
#include <hip/hip_cooperative_groups.h>
#include <cstdio>
namespace cg = cooperative_groups;

#ifndef MULTI
#define MULTI 0
#endif
#ifndef PROBE_STEP
#define PROBE_STEP -1
#endif

#define DI __device__ __forceinline__
typedef unsigned short u16;
using bf16x8 = __attribute__((ext_vector_type(8))) short;
using s16x4  = __attribute__((ext_vector_type(4))) short;
using f32x16 = __attribute__((ext_vector_type(16))) float;
using u32x4  = __attribute__((ext_vector_type(4))) unsigned;
using u32x2  = __attribute__((ext_vector_type(2))) unsigned;
#define MFMA(a, b, c) __builtin_amdgcn_mfma_f32_32x32x16_bf16((a), (b), (c), 0, 0, 0)

constexpr int NTOK = 6144, NCTX = 4096, DM = 1024, INW = 7456, DFF = 2816, DFF2 = 5632;
constexpr int ZA_Q = 0, ZA_K = 256, ZA_V = 384, ZC_Q = 512, ZC_K = 768, ZC_V = 1024, ZB_Q = 1280, ZB_I = 1536, ZB_FF = 1792,
              ZB_FB = 2048, ZB_G = 2304, ZD_Q = 2560, ZD_K = 2688, ZD_V = 2816, ZD_G = 3072, ZD_RF = 3328, Z_ML = 3360;
constexpr float EPSN = 1e-6f;
constexpr size_t O_CAK = 6291456, O_CAV = 7340032, O_CCK = 8388608, O_CCV = 10485760, O_SH = 12582912, O_SG = 13631488;
constexpr size_t WS_WIN = 0;
constexpr size_t WS_WBR = WS_WIN + (size_t)INW * 1024 * 2;
constexpr size_t WS_WOUT = WS_WBR + (size_t)4 * 1024 * 256 * 2;
constexpr size_t WS_WUP = WS_WOUT + (size_t)1024 * 1024 * 2;
constexpr size_t WS_WDN = WS_WUP + (size_t)DFF2 * 1024 * 2;
constexpr size_t WS_MOD = WS_WDN + (size_t)1024 * DFF * 2;
constexpr size_t WS_H = WS_MOD + (size_t)2 * 3 * 6144 * 4;
constexpr size_t WS_Z = WS_H + (size_t)NTOK * 1024 * 2;
constexpr size_t WS_QA = WS_Z + (size_t)NTOK * INW * 2;
constexpr size_t WS_QC = WS_QA + (size_t)NTOK * 256 * 2;
constexpr size_t WS_KA = WS_QC + (size_t)NTOK * 256 * 2;
constexpr size_t WS_VA = WS_KA + (size_t)7168 * 128 * 2;
constexpr size_t WS_KC = WS_VA + (size_t)7168 * 128 * 2;
constexpr size_t WS_VC = WS_KC + (size_t)7168 * 256 * 2;
constexpr size_t WS_YCAT = WS_VC + (size_t)7168 * 256 * 2;
constexpr size_t WS_ACT = WS_YCAT + (size_t)NTOK * 1024 * 2;
constexpr size_t WS_MIX = WS_ACT + (size_t)NTOK * DFF * 2;
constexpr size_t WS_CL = WS_MIX + (size_t)NTOK * 1024 * 2;
constexpr size_t WS_U = WS_ACT;
constexpr size_t WS_S = WS_CL + (size_t)2304 * 64 * 4;
constexpr size_t WS_BAR = WS_S + (size_t)2304 * 4096 * 4;
constexpr size_t WS_END = WS_BAR + 16384;
static_assert((size_t)2304 * 4096 * 4 <= (size_t)NTOK * DFF * 2 + (size_t)NTOK * 1024 * 2, "U alias");
static_assert(WS_END <= (size_t)256 * 1024 * 1024, "ws budget");
constexpr int SMEM_BYTES = 73728;
constexpr int NPHASE = 23;

struct Params {
  const float *x_prompt, *x_sample, *cache_a_k, *cache_a_v, *cache_c_k, *cache_c_v, *state_hgrn, *state_gla, *c, *c_ctx,
      *w_ada, *b_ada, *norm1_g, *norm2_g, *w_in, *a_qn_g, *a_kn_g, *c_qn_g, *c_kn_g, *c_lambda, *c_subln_g, *b_lb_logits,
      *b_norm_g, *d_alpha_w, *d_alpha_b, *d_norm_g, *w_branch, *w_out, *w_up, *conv_w, *conv_b, *w_down;
  float* out;
  char* ws;
  int phase_begin, phase_end, coop, pad;
};

DI int tid_() { int t = __builtin_amdgcn_workitem_id_x(); asm volatile("" : "+v"(t)); return t; }
DI float bf2f(u16 u) { return __uint_as_float(((unsigned)u) << 16); }
DI u16 f2bf(float a) { __hip_bfloat16 b = __float2bfloat16(a); return *(u16*)&b; }
DI unsigned pack2(float a, float b) { __hip_bfloat162 q = __float22bfloat162_rn(make_float2(a, b)); return *(unsigned*)&q; }
DI float lo_bf(unsigned u) { return __uint_as_float(u << 16); }
DI float hi_bf(unsigned u) { return __uint_as_float(u & 0xffff0000u); }
DI float sigmoidf_(float x) { return 1.f / (1.f + __expf(-x)); }
DI int crow(int e, int h) { return (e & 3) + 8 * (e >> 2) + 4 * h; }
DI bf16x8 pack8(const f32x16& x, int s) {
  u32x4 q;
  q[0] = pack2(x[8 * s + 0], x[8 * s + 1]); q[1] = pack2(x[8 * s + 2], x[8 * s + 3]);
  q[2] = pack2(x[8 * s + 4], x[8 * s + 5]); q[3] = pack2(x[8 * s + 6], x[8 * s + 7]);
  return __builtin_bit_cast(bf16x8, q);
}
DI s16x4 trread(const u16* pl) {
  return __builtin_amdgcn_ds_read_tr16_b64_v4i16((__attribute__((address_space(3))) s16x4*)pl);
}
DI bf16x8 trpair(const u16* p0, const u16* p1) {
  s16x4 a = trread(p0), b = trread(p1);
  return __builtin_shufflevector(a, b, 0, 1, 2, 3, 4, 5, 6, 7);
}
DI float wave_sum(float v) {
#pragma unroll
  for (int o = 32; o >= 1; o >>= 1) v += __shfl_xor(v, o);
  return v;
}
DI int tok_cond(int t) { return t < NCTX ? 0 : 1 + ((t - NCTX) >> 10); }
DI const float* xin_row(const Params& p, int l, int tok) {
  if (l > 0) return p.out + (size_t)tok * DM;
  return tok < NCTX ? p.x_prompt + (size_t)tok * DM : p.x_sample + (size_t)(tok - NCTX) * DM;
}


#define XB_TMO      128
#define XB_XCNT(j)  (256  + 64 * (j))
#define XB_XSUB(j)  (1280 + 64 * (j))
#define XB_XGEN(j)  (2304 + 64 * (j))
#define XB_TOP      3328
#define XB_TOPGEN   3392
#define XCD_BAR_WORDS 3456
#define XB_SPIN_CAP (1u << 22)
#define LAS __attribute__((address_space(3)))
DI unsigned xb_ld(unsigned* p) { return __hip_atomic_load(p, __ATOMIC_RELAXED, __HIP_MEMORY_SCOPE_AGENT); }
DI unsigned xb_add(unsigned* p, unsigned v) { return __hip_atomic_fetch_add(p, v, __ATOMIC_RELAXED, __HIP_MEMORY_SCOPE_AGENT); }
DI unsigned xb_xcc_id() { return (unsigned)__builtin_amdgcn_s_getreg((3 << 11) | 20) & 0xFu; }
#define XB_SPIN(cond, bar) do { unsigned _sp = 0; while (cond) { __builtin_amdgcn_s_sleep(1); \
    if ((++_sp & 255u) == 0u) { if (xb_ld(&(bar)[XB_TMO])) break; if (_sp > XB_SPIN_CAP) { atomicAdd(&(bar)[XB_TMO], 1u); break; } } } } while (0)
struct XcdBarrier { unsigned* bar; unsigned x; volatile LAS unsigned* st; };
DI XcdBarrier xcd_barrier_post(unsigned* bar, volatile LAS unsigned* st) {
  XcdBarrier b; b.bar = bar; b.x = xb_xcc_id(); b.st = st;
  if (__builtin_amdgcn_workitem_id_x() == 0) (void)xb_add(&bar[XB_XCNT(b.x)], 1u);
  return b;
}
DI void xcd_barrier_complete(unsigned* bar, unsigned x, unsigned& nloc, unsigned& nx) {
  const unsigned G = gridDim.x * gridDim.y * gridDim.z;
  unsigned sum, cnt, mine, sp = 0u;
  for (;;) {
    sum = 0u; cnt = 0u; mine = 0u;
#pragma unroll
    for (unsigned j = 0; j < 16; ++j) { const unsigned c = xb_ld(&bar[XB_XCNT(j)]); sum += c; cnt += (c > 0u) ? 1u : 0u; mine = (j == x) ? c : mine; }
    if (sum == G) break;
    __builtin_amdgcn_s_sleep(1);
    if ((++sp & 255u) == 0u) { if (xb_ld(&bar[XB_TMO])) break; if (sp > XB_SPIN_CAP) { atomicAdd(&bar[XB_TMO], 1u); break; } }
  }
  nloc = mine > 0u ? mine : 1u; nx = cnt > 0u ? cnt : 1u;
}
DI void xcd_barrier(const XcdBarrier& b) {
  asm volatile("s_waitcnt vmcnt(0)" ::: "memory");
  __syncthreads();
  if (__builtin_amdgcn_workitem_id_x() == 0) {
    unsigned* bar = b.bar;
    __builtin_amdgcn_s_waitcnt(0);
    unsigned nloc = b.st[0], nx = b.st[1];
    if (nloc == 0u) { xcd_barrier_complete(bar, b.x, nloc, nx); b.st[0] = nloc; b.st[1] = nx; }
    const unsigned old = xb_add(&bar[XB_XSUB(b.x)], 1u);
    const unsigned gen = old / nloc;
    if (old + 1u == (gen + 1u) * nloc) {
      __builtin_amdgcn_fence(__ATOMIC_RELEASE, "agent");
      asm volatile("s_waitcnt vmcnt(0)" ::: "memory");
      const unsigned og = xb_add(&bar[XB_TOP], 1u);
      const unsigned tg = og / nx;
      if (og + 1u == (tg + 1u) * nx) xb_add(&bar[XB_TOPGEN], 1u);
      else XB_SPIN(xb_ld(&bar[XB_TOPGEN]) == tg, bar);
      __builtin_amdgcn_fence(__ATOMIC_ACQUIRE, "agent");
      xb_add(&bar[XB_XGEN(b.x)], 1u);
      asm volatile("s_waitcnt vmcnt(0)" ::: "memory");
    } else {
      XB_SPIN(xb_ld(&bar[XB_XGEN(b.x)]) == gen, bar);
      __builtin_amdgcn_fence(__ATOMIC_ACQUIRE, "agent");
      asm volatile("s_waitcnt vmcnt(0)" ::: "memory");
    }
  }
  __syncthreads();
}

DI void convw_tile(const float* __restrict__ src, u16* __restrict__ dst, int K, int N, int item, float* T) {
  const int t = tid_();
  const int ntn = N >> 5;
  const int n0 = (item % ntn) * 32, k0 = (item / ntn) * 64;
#pragma unroll
  for (int i = 0; i < 2; ++i) {
    const int kl = (t >> 3) + 32 * i, n4 = t & 7;
    const float4 v = *(const float4*)(src + (size_t)(k0 + kl) * N + n0 + 4 * n4);
    T[(4 * n4 + 0) * 65 + kl] = v.x; T[(4 * n4 + 1) * 65 + kl] = v.y;
    T[(4 * n4 + 2) * 65 + kl] = v.z; T[(4 * n4 + 3) * 65 + kl] = v.w;
  }
  __syncthreads();
  {
    const int n = t >> 3, k8 = (t & 7) * 8;
    const float* tr = T + n * 65 + k8;
    u32x4 q;
    q[0] = pack2(tr[0], tr[1]); q[1] = pack2(tr[2], tr[3]); q[2] = pack2(tr[4], tr[5]); q[3] = pack2(tr[6], tr[7]);
    *(u32x4*)(dst + (size_t)(n0 + n) * K + k0 + k8) = q;
  }
  __syncthreads();
}
constexpr int CONVW_ITEMS = 8976;
DI void convw_item(const Params& p, int l, int item, char* sm) {
  float* T = (float*)sm;
  char* ws = p.ws;
  if (item < 3728) convw_tile(p.w_in + (size_t)l * 1024 * INW, (u16*)(ws + WS_WIN), 1024, INW, item, T);
  else if (item < 4240) convw_tile(p.w_branch + (size_t)l * 1024 * 1024, (u16*)(ws + WS_WBR), 1024, 1024, item - 3728, T);
  else if (item < 4752) convw_tile(p.w_out + (size_t)l * 1024 * 1024, (u16*)(ws + WS_WOUT), 1024, 1024, item - 4240, T);
  else if (item < 7568) convw_tile(p.w_up + (size_t)l * 1024 * DFF2, (u16*)(ws + WS_WUP), 1024, DFF2, item - 4752, T);
  else convw_tile(p.w_down + (size_t)l * DFF * 1024, (u16*)(ws + WS_WDN), DFF, 1024, item - 7568, T);
}

DI void mod_item(const Params& p, int item, char* sm) {
  float* sc = (float*)sm;
  float* red = sc + 3072;
  const int t = tid_();
  const int l = item / 96, j0 = (item % 96) * 64;
  for (int i = t; i < 3072; i += 256) {
    const int cnd = i >> 10, k = i & 1023;
    const float v = cnd == 0 ? p.c_ctx[k] : p.c[(cnd - 1) * 1024 + k];
    sc[i] = v * sigmoidf_(v);
  }
  __syncthreads();
  const int cq = t & 15, ks = t >> 4;
  float a0[4] = {0, 0, 0, 0}, a1[4] = {0, 0, 0, 0}, a2[4] = {0, 0, 0, 0};
  const float* wp = p.w_ada + (size_t)l * 1024 * 6144 + j0 + 4 * cq;
#pragma unroll 4
  for (int rr = 0; rr < 64; ++rr) {
    const int row = ks * 64 + rr;
    const float4 w4 = *(const float4*)(wp + (size_t)row * 6144);
    const float s0 = sc[row], s1 = sc[1024 + row], s2 = sc[2048 + row];
    a0[0] += s0 * w4.x; a0[1] += s0 * w4.y; a0[2] += s0 * w4.z; a0[3] += s0 * w4.w;
    a1[0] += s1 * w4.x; a1[1] += s1 * w4.y; a1[2] += s1 * w4.z; a1[3] += s1 * w4.w;
    a2[0] += s2 * w4.x; a2[1] += s2 * w4.y; a2[2] += s2 * w4.z; a2[3] += s2 * w4.w;
  }
#pragma unroll
  for (int q = 0; q < 4; ++q) {
    red[(ks * 3 + 0) * 64 + 4 * cq + q] = a0[q];
    red[(ks * 3 + 1) * 64 + 4 * cq + q] = a1[q];
    red[(ks * 3 + 2) * 64 + 4 * cq + q] = a2[q];
  }
  __syncthreads();
  if (t < 192) {
    const int cnd = t >> 6, col = t & 63;
    float s = p.b_ada[l * 6144 + j0 + col];
    for (int k = 0; k < 16; ++k) s += red[(k * 3 + cnd) * 64 + col];
    ((float*)(p.ws + WS_MOD))[(l * 3 + cnd) * 6144 + j0 + col] = s;
  }
  __syncthreads();
}

DI void norm_tok(const Params& p, int l, int which, int tok) {
  const int lane = tid_() & 63;
  const float* xr = which == 0 ? xin_row(p, l, tok) : p.out + (size_t)tok * DM;
  const float* g = (which == 0 ? p.norm1_g : p.norm2_g) + l * 1024;
  const float* mod = (const float*)(p.ws + WS_MOD) + (l * 3 + tok_cond(tok)) * 6144 + which * 3072;
  float4 v[4];
  float ss = 0.f;
#pragma unroll
  for (int i = 0; i < 4; ++i) {
    v[i] = *(const float4*)(xr + 4 * lane + 256 * i);
    ss += v[i].x * v[i].x + v[i].y * v[i].y + v[i].z * v[i].z + v[i].w * v[i].w;
  }
  ss = wave_sum(ss);
  const float rstd = rsqrtf(ss * (1.f / 1024.f) + EPSN);
  u16* hr = (u16*)(p.ws + WS_H) + (size_t)tok * DM;
#pragma unroll
  for (int i = 0; i < 4; ++i) {
    const int c0 = 4 * lane + 256 * i;
    const float4 gg = *(const float4*)(g + c0);
    const float4 sh = *(const float4*)(mod + c0);
    const float4 scv = *(const float4*)(mod + 1024 + c0);
    u32x2 q;
    q[0] = pack2(v[i].x * rstd * gg.x * (1.f + scv.x) + sh.x, v[i].y * rstd * gg.y * (1.f + scv.y) + sh.y);
    q[1] = pack2(v[i].z * rstd * gg.z * (1.f + scv.z) + sh.z, v[i].w * rstd * gg.w * (1.f + scv.w) + sh.w);
    *(u32x2*)(hr + c0) = q;
  }
}

template <int NJ, bool GATED>
DI void gemm_core(const u16* __restrict__ A, int lda, const u16* __restrict__ Bt, int ldb, int K, int m0, int n0, int N,
                  f32x16 (&acc)[2][NJ], u16* sm, const u16* __restrict__ gz = nullptr, f32x16 (*tot)[NJ] = nullptr) {
  const int t = tid_(), lane = t & 63, w = t >> 6, r = lane & 31, h = lane >> 5;
  const int wm = w & 1, wn = w >> 1;
  u16* As = sm;
  u16* Bs = sm + 2 * 128 * 72;
  const int lrow = t >> 3, lc8 = (t & 7) * 8;
  int aoff[4], boff[2 * NJ];
#pragma unroll
  for (int i = 0; i < 4; ++i) aoff[i] = (m0 + lrow + 32 * i) * lda + lc8;
#pragma unroll
  for (int i = 0; i < 2 * NJ; ++i) {
    int bn = n0 + lrow + 32 * i;
    bn = bn < N ? bn : N - 1;
    boff[i] = bn * ldb + lc8;
  }
  u32x4 ra[2][4], rb[2][2 * NJ];
  const int KT = K >> 6;
  auto gload = [&](int set, int kt) {
    const int k0 = kt * 64;
#pragma unroll
    for (int i = 0; i < 4; ++i) ra[set][i] = *(const u32x4*)(A + aoff[i] + k0);
#pragma unroll
    for (int i = 0; i < 2 * NJ; ++i) rb[set][i] = *(const u32x4*)(Bt + boff[i] + k0);
  };
  auto sstore = [&](int set, int buf) {
    const int nb = buf * 128 * 72;
#pragma unroll
    for (int i = 0; i < 4; ++i) *(u32x4*)(As + nb + (lrow + 32 * i) * 72 + lc8) = ra[set][i];
#pragma unroll
    for (int i = 0; i < 2 * NJ; ++i) *(u32x4*)(Bs + nb + (lrow + 32 * i) * 72 + lc8) = rb[set][i];
  };
  auto compute = [&](int buf) {
    const u16* as = As + buf * 128 * 72 + (wm * 64 + r) * 72 + 8 * h;
    const u16* bs = Bs + buf * 128 * 72 + (wn * 32 * NJ + r) * 72 + 8 * h;
#pragma unroll
    for (int ks = 0; ks < 4; ++ks) {
      const bf16x8 a0 = *(const bf16x8*)(as + ks * 16), a1 = *(const bf16x8*)(as + 32 * 72 + ks * 16);
#pragma unroll
      for (int j = 0; j < NJ; ++j) {
        const bf16x8 b0 = *(const bf16x8*)(bs + j * 32 * 72 + ks * 16);
        acc[0][j] = MFMA(a0, b0, acc[0][j]);
        acc[1][j] = MFMA(a1, b0, acc[1][j]);
      }
    }
  };
  gload(0, 0);
  gload(1, 1);
  sstore(0, 0);
  __syncthreads();
  for (int kt = 0; kt < KT; kt += 2) {
    if (kt + 2 < KT) gload(0, kt + 2);
    compute(0);
    sstore(1, 1);
    __syncthreads();
    if (kt + 3 < KT) gload(1, kt + 3);
    u16 graw[GATED ? 32 * NJ : 1];
    if (GATED && (kt & 3) == 2) {
      const int n = kt >> 2;
#pragma unroll
      for (int i = 0; i < 2; ++i)
#pragma unroll
        for (int j = 0; j < NJ; ++j)
#pragma unroll
          for (int e = 0; e < 16; ++e)
            graw[(i * NJ + j) * 16 + e] = gz[(size_t)(m0 + wm * 64 + i * 32 + crow(e, h)) * INW + n * 1024 + n0 + wn * 32 * NJ + j * 32 + r];
    }
    compute(1);
    if (kt + 2 < KT) sstore(0, 0);
    __syncthreads();
    if (GATED && (kt & 3) == 2) {
#pragma unroll
      for (int i = 0; i < 2; ++i)
#pragma unroll
        for (int j = 0; j < NJ; ++j)
#pragma unroll
          for (int e = 0; e < 16; ++e) {
            tot[i][j][e] += sigmoidf_(bf2f(graw[(i * NJ + j) * 16 + e])) * acc[i][j][e];
            acc[i][j][e] = 0.f;
          }
    }
  }
}
template <int NJ>
DI void zero_acc(f32x16 (&acc)[2][NJ]) {
#pragma unroll
  for (int i = 0; i < 2; ++i)
#pragma unroll
    for (int j = 0; j < NJ; ++j)
#pragma unroll
      for (int e = 0; e < 16; ++e) acc[i][j][e] = 0.f;
}
#define EPI_LOOP_N(NJ_, body)                                                       \
  {                                                                                 \
    const int lane_ = tid_() & 63, w_ = tid_() >> 6, r_ = lane_ & 31, h_ = lane_ >> 5; \
    _Pragma("unroll") for (int i_ = 0; i_ < 2; ++i_)                                 \
    _Pragma("unroll") for (int j_ = 0; j_ < NJ_; ++j_)                               \
    _Pragma("unroll") for (int e_ = 0; e_ < 16; ++e_) {                              \
      const int row = m0 + (w_ & 1) * 64 + i_ * 32 + crow(e_, h_);                  \
      const int col = n0 + (w_ >> 1) * 32 * NJ_ + j_ * 32 + r_;                     \
      body                                                                          \
    }                                                                               \
  }
#define EPI_LOOP(body) EPI_LOOP_N(2, body)

DI void gemm_in_item(const Params& p, int item, char* sm) {
  const int m0 = (item % 48) * 128, n0 = (item / 48) * 128;
  f32x16 acc[2][2];
  zero_acc<2>(acc);
  gemm_core<2, false>((const u16*)(p.ws + WS_H), 1024, (const u16*)(p.ws + WS_WIN), 1024, 1024, m0, n0, INW, acc, (u16*)sm);
  u16* z = (u16*)(p.ws + WS_Z);
  EPI_LOOP(if (col < INW) z[(size_t)row * INW + col] = f2bf(acc[i_][j_][e_]);)
}
DI void gemm_branch_item(const Params& p, int item, char* sm) {
  const int m0 = (item % 48) * 128, n0 = (item / 48) * 64;
  f32x16 tot[2][1], acc[2][1];
  zero_acc<1>(tot);
  zero_acc<1>(acc);
  gemm_core<1, true>((const u16*)(p.ws + WS_YCAT), 1024, (const u16*)(p.ws + WS_WBR), 1024, 1024, m0, n0, 1024, acc, (u16*)sm,
                     (const u16*)(p.ws + WS_Z) + Z_ML, tot);
  u16* mix = (u16*)(p.ws + WS_MIX);
  EPI_LOOP_N(1, mix[(size_t)row * 1024 + col] = f2bf(tot[i_][j_][e_]);)
}
DI void gemm_out_item(const Params& p, int l, int item, char* sm, bool dry) {
  const int m0 = (item % 48) * 128, n0 = (item / 48) * 128;
  f32x16 acc[2][2];
  zero_acc<2>(acc);
  gemm_core<2, false>((const u16*)(p.ws + WS_MIX), 1024, (const u16*)(p.ws + WS_WOUT), 1024, 1024, m0, n0, 1024, acc, (u16*)sm);
  const float* g1 = (const float*)(p.ws + WS_MOD) + (l * 3 + tok_cond(m0)) * 6144 + 2048;
  EPI_LOOP(const float xo = xin_row(p, l, row)[col]; const float xn = xo + g1[col] * acc[i_][j_][e_]; if (!dry) p.out[(size_t)row * DM + col] = xn;)
}
DI void gemm_up_item(const Params& p, int item, char* sm) {
  const int m0 = (item % 48) * 128, n0 = (item / 48) * 128;
  f32x16 acc[2][2];
  zero_acc<2>(acc);
  gemm_core<2, false>((const u16*)(p.ws + WS_H), 1024, (const u16*)(p.ws + WS_WUP), 1024, 1024, m0, n0, DFF2, acc, (u16*)sm);
  u16* u = (u16*)(p.ws + WS_Z);
  EPI_LOOP(u[(size_t)row * DFF2 + col] = f2bf(acc[i_][j_][e_]);)
}
DI void gemm_down_item(const Params& p, int l, int item, char* sm, bool dry) {
  const int m0 = (item % 48) * 128, n0 = (item / 48) * 128;
  f32x16 acc[2][2];
  zero_acc<2>(acc);
  gemm_core<2, false>((const u16*)(p.ws + WS_ACT), DFF, (const u16*)(p.ws + WS_WDN), DFF, DFF, m0, n0, 1024, acc, (u16*)sm);
  const float* g2 = (const float*)(p.ws + WS_MOD) + (l * 3 + tok_cond(m0)) * 6144 + 5120;
  EPI_LOOP(float* xp = p.out + (size_t)row * DM + col; const float xn = *xp + g2[col] * acc[i_][j_][e_]; if (!dry) *xp = xn;)
}

DI void conv_act(const Params& p, int l, int gid, int gstride) {
  const u16* u = (const u16*)(p.ws + WS_Z);
  u16* act = (u16*)(p.ws + WS_ACT);
  const float* cw = p.conv_w + (size_t)l * 3 * DFF2;
  const float* cb = p.conv_b + (size_t)l * DFF2;
  for (int idx = gid; idx < NTOK * 352; idx += gstride) {
    const int tok = idx / 352, c0 = (idx % 352) * 8;
    int pos, L;
    if (tok < NCTX) { pos = tok & 255; L = 256; } else { pos = (tok - NCTX) & 1023; L = 1024; }
    float av[8], gv[8];
#pragma unroll
    for (int j = 0; j < 8; ++j) { av[j] = cb[c0 + j]; gv[j] = cb[DFF + c0 + j]; }
#pragma unroll
    for (int d = 0; d < 3; ++d) {
      const int pp = pos + d - 1;
      if (pp < 0 || pp >= L) continue;
      const u16* ur = u + (size_t)(tok + d - 1) * DFF2;
      const u32x4 ua = *(const u32x4*)(ur + c0), ug = *(const u32x4*)(ur + DFF + c0);
      const float* wa = cw + d * DFF2 + c0;
      const float* wg = wa + DFF;
#pragma unroll
      for (int q = 0; q < 4; ++q) {
        av[2 * q] += wa[2 * q] * lo_bf(ua[q]); av[2 * q + 1] += wa[2 * q + 1] * hi_bf(ua[q]);
        gv[2 * q] += wg[2 * q] * lo_bf(ug[q]); gv[2 * q + 1] += wg[2 * q + 1] * hi_bf(ug[q]);
      }
    }
    u32x4 o;
#pragma unroll
    for (int q = 0; q < 4; ++q)
      o[q] = pack2(gv[2 * q] * sigmoidf_(gv[2 * q]) * av[2 * q], gv[2 * q + 1] * sigmoidf_(gv[2 * q + 1]) * av[2 * q + 1]);
    *(u32x4*)(act + (size_t)tok * DFF + c0) = o;
  }
}

DI void prep_item(const Params& p, int l, int item) {
  const int lane = tid_() & 63, w = tid_() >> 6;
  char* ws = p.ws;
  u16* qA = (u16*)(ws + WS_QA); u16* qC = (u16*)(ws + WS_QC);
  u16* kA = (u16*)(ws + WS_KA); u16* vA = (u16*)(ws + WS_VA);
  u16* kC = (u16*)(ws + WS_KC); u16* vC = (u16*)(ws + WS_VC);
  if (item >= NTOK) {
    const int cr = item - NTOK, b = cr >> 9, key = cr & 511;
    const size_t keyrow = 4096 + b * 1536 + key;
    const size_t srow = (size_t)(b * 2 + l) * 512 + key;
    for (int u = w; u < 12; u += 4) {
      if (u < 2) kA[keyrow * 128 + u * 64 + lane] = f2bf(p.cache_a_k[srow * 128 + u * 64 + lane]);
      else if (u < 4) vA[keyrow * 128 + (u - 2) * 64 + lane] = f2bf(p.cache_a_v[srow * 128 + (u - 2) * 64 + lane]);
      else if (u < 8) kC[keyrow * 256 + (u - 4) * 64 + lane] = f2bf(p.cache_c_k[srow * 256 + (u - 4) * 64 + lane]);
      else vC[keyrow * 256 + (u - 8) * 64 + lane] = f2bf(p.cache_c_v[srow * 256 + (u - 8) * 64 + lane]);
    }
    return;
  }
  const int tok = item;
  const bool sample = tok >= NCTX;
  int b, pos;
  size_t keyrow;
  if (!sample) { b = tok >> 8; pos = tok & 255; keyrow = tok; }
  else { b = (tok - NCTX) >> 10; pos = (tok - NCTX) & 1023; keyrow = 4096 + b * 1536 + 512 + pos; }
  const size_t crow_o = (size_t)(b * 2 + l) * 256 + pos;
  const u16* zr = (const u16*)(ws + WS_Z) + (size_t)tok * INW;
  const float rowp = (float)(pos >> 6), colp = (float)(pos & 63);
  for (int u = w; u < 20; u += 4) {
    if (u < 6) {
      const bool isq = u < 4;
      const int hd = isq ? u : u - 4;
      const float x = bf2f(zr[(isq ? ZA_Q : ZA_K) + hd * 64 + lane]);
      const float ss = wave_sum(x * x);
      float y = x * rsqrtf(ss * (1.f / 64.f) + EPSN) * (isq ? p.a_qn_g : p.a_kn_g)[l * 64 + lane];
      if (!sample && !isq) p.out[O_CAK + crow_o * 128 + hd * 64 + lane] = y;
      if (sample) {
        const int a = lane >> 5, pb = (lane >> 4) & 1, i = lane & 15;
        const float freq = exp2f(-(float)i * (0.0625f * 13.287712379549449f));
        const float ang = (a ? colp : rowp) * freq;
        const float pr = __shfl_xor(y, 16);
        y = y * __cosf(ang) + (pb ? pr : -pr) * __sinf(ang);
      }
      if (isq) qA[(size_t)tok * 256 + hd * 64 + lane] = f2bf(y);
      else kA[keyrow * 128 + hd * 64 + lane] = f2bf(y);
    } else if (u < 8) {
      const int hd = u - 6;
      const u16 raw = zr[ZA_V + hd * 64 + lane];
      if (!sample) p.out[O_CAV + crow_o * 128 + hd * 64 + lane] = bf2f(raw);
      vA[keyrow * 128 + hd * 64 + lane] = raw;
    } else if (u < 16) {
      const bool isq = u < 12;
      const int pr2 = isq ? u - 8 : u - 12;
      const float x = bf2f(zr[(isq ? ZC_Q : ZC_K) + pr2 * 64 + lane]);
      float ss = x * x;
#pragma unroll
      for (int o = 16; o >= 1; o >>= 1) ss += __shfl_xor(ss, o);
      float y = x * rsqrtf(ss * (1.f / 32.f) + EPSN) * (isq ? p.c_qn_g : p.c_kn_g)[l * 32 + (lane & 31)];
      if (!sample && !isq) p.out[O_CCK + crow_o * 256 + pr2 * 64 + lane] = y;
      if (sample) {
        const int dd = lane & 31, a = dd >> 4, pb = (dd >> 3) & 1, i = dd & 7;
        const float freq = exp2f(-(float)i * (0.125f * 13.287712379549449f));
        const float ang = (a ? colp : rowp) * freq;
        const float pr = __shfl_xor(y, 8);
        y = y * __cosf(ang) + (pb ? pr : -pr) * __sinf(ang);
      }
      if (isq) qC[(size_t)tok * 256 + pr2 * 64 + lane] = f2bf(y);
      else kC[keyrow * 256 + pr2 * 64 + lane] = f2bf(y);
    } else {
      const int hd = u - 16;
      const u16 raw = zr[ZC_V + hd * 64 + lane];
      if (!sample) p.out[O_CCV + crow_o * 256 + hd * 64 + lane] = bf2f(raw);
      vC[keyrow * 256 + hd * 64 + lane] = raw;
    }
  }
}

template <bool ISC>
DI void attn_item(const Params& p, int l, int tok0, int keyrow0, int nkeys, int head, char* smraw) {
  constexpr int NM = ISC ? 2 : 1;
  u16* Ks = (u16*)smraw;
  u16* Vs = Ks + 2 * 64 * 72;
  const u16* qbuf = (const u16*)(p.ws + (ISC ? WS_QC : WS_QA));
  const u16* kbuf = (const u16*)(p.ws + (ISC ? WS_KC : WS_KA));
  const u16* vbuf = (const u16*)(p.ws + (ISC ? WS_VC : WS_VA));
  const int kstride = ISC ? 256 : 128;
  const int koff = ISC ? head * 64 : (head >> 1) * 64;
  const float c2 = (ISC ? 0.17677669529663687f : 0.125f) * 1.4426950408889634f;
  const int t = tid_(), lane = t & 63, w = t >> 6, r = lane & 31, h = lane >> 5;
  const int i16 = lane & 15, tq = i16 >> 2, tp = i16 & 3, blk = (lane >> 4) & 1;
  bf16x8 qf[4];
  {
    const u16* qp = qbuf + (size_t)(tok0 + 32 * w + r) * 256 + head * 64 + 8 * h;
#pragma unroll
    for (int s = 0; s < 4; ++s) qf[s] = *(const bf16x8*)(qp + 16 * s);
  }
  f32x16 O[NM][2];
  float mrun[NM], lsum[NM];
#pragma unroll
  for (int m = 0; m < NM; ++m) {
    mrun[m] = -INFINITY; lsum[m] = 0.f;
#pragma unroll
    for (int d = 0; d < 2; ++d)
#pragma unroll
      for (int e = 0; e < 16; ++e) O[m][d][e] = 0.f;
  }
  const int lrow = t >> 3, lc8 = (t & 7) * 8;
  const u16* kg = kbuf + (size_t)(keyrow0 + lrow) * kstride + koff + lc8;
  const u16* vg = vbuf + (size_t)(keyrow0 + lrow) * kstride + koff + lc8;
  u32x4 rk[2], rv[2];
#pragma unroll
  for (int i = 0; i < 2; ++i) { rk[i] = *(const u32x4*)(kg + (size_t)(32 * i) * kstride); rv[i] = *(const u32x4*)(vg + (size_t)(32 * i) * kstride); }
#pragma unroll
  for (int i = 0; i < 2; ++i) {
    *(u32x4*)(Ks + (lrow + 32 * i) * 72 + lc8) = rk[i];
    *(u32x4*)(Vs + (lrow + 32 * i) * 72 + lc8) = rv[i];
  }
  __syncthreads();
  const int NT = nkeys >> 6;
  for (int kt = 0; kt < NT; ++kt) {
    const int buf = kt & 1;
    if (kt + 1 < NT) {
#pragma unroll
      for (int i = 0; i < 2; ++i) {
        rk[i] = *(const u32x4*)(kg + (size_t)((kt + 1) * 64 + 32 * i) * kstride);
        rv[i] = *(const u32x4*)(vg + (size_t)((kt + 1) * 64 + 32 * i) * kstride);
      }
    }
    const u16* kb_ = Ks + buf * 64 * 72;
    const u16* vb_ = Vs + buf * 64 * 72;
#pragma unroll
    for (int kb = 0; kb < 2; ++kb) {
      f32x16 S[NM];
#pragma unroll
      for (int m = 0; m < NM; ++m)
#pragma unroll
        for (int e = 0; e < 16; ++e) S[m][e] = 0.f;
#pragma unroll
      for (int s = 0; s < 4; ++s) {
        const int m = ISC ? (s >> 1) : 0;
        const bf16x8 kf = *(const bf16x8*)(kb_ + (kb * 32 + r) * 72 + 16 * s + 8 * h);
        S[m] = MFMA(kf, qf[s], S[m]);
      }
#pragma unroll
      for (int m = 0; m < NM; ++m) {
        float mx = S[m][0];
#pragma unroll
        for (int e = 1; e < 16; ++e) mx = fmaxf(mx, S[m][e]);
        mx = fmaxf(mx, __shfl_xor(mx, 32));
        const float mnew = fmaxf(mrun[m], mx);
        const float alpha = exp2f((mrun[m] - mnew) * c2);
        mrun[m] = mnew;
        const float mc = mnew * c2;
        float ps = 0.f;
#pragma unroll
        for (int e = 0; e < 16; ++e) { const float pe = exp2f(S[m][e] * c2 - mc); S[m][e] = pe; ps += pe; }
        lsum[m] = lsum[m] * alpha + ps;
        if (__any(alpha != 1.f)) {
#pragma unroll
          for (int d = 0; d < 2; ++d)
#pragma unroll
            for (int e = 0; e < 16; ++e) O[m][d][e] *= alpha;
        }
      }
#pragma unroll
      for (int st = 0; st < 2; ++st) {
        bf16x8 pf[NM];
#pragma unroll
        for (int m = 0; m < NM; ++m) pf[m] = pack8(S[m], st);
#pragma unroll
        for (int d = 0; d < 2; ++d) {
          const u16* vp = vb_ + (kb * 32 + 16 * st + 4 * h + tq) * 72 + d * 32 + 16 * blk + 4 * tp;
          const bf16x8 vf = trpair(vp, vp + 8 * 72);
#pragma unroll
          for (int m = 0; m < NM; ++m) O[m][d] = MFMA(vf, pf[m], O[m][d]);
        }
      }
    }
    if (kt + 1 < NT) {
      const int nb = (buf ^ 1) * 64 * 72;
#pragma unroll
      for (int i = 0; i < 2; ++i) {
        *(u32x4*)(Ks + nb + (lrow + 32 * i) * 72 + lc8) = rk[i];
        *(u32x4*)(Vs + nb + (lrow + 32 * i) * 72 + lc8) = rv[i];
      }
    }
    __syncthreads();
  }
  float inv[NM];
#pragma unroll
  for (int m = 0; m < NM; ++m) { const float lt = lsum[m] + __shfl_xor(lsum[m], 32); inv[m] = 1.f / lt; }
  const int tok = tok0 + 32 * w + r;
  u16* yc = (u16*)(p.ws + WS_YCAT) + (size_t)tok * 1024;
  if (!ISC) {
#pragma unroll
    for (int d = 0; d < 2; ++d)
#pragma unroll
      for (int g = 0; g < 4; ++g) {
        u32x2 q;
        q[0] = pack2(O[0][d][4 * g] * inv[0], O[0][d][4 * g + 1] * inv[0]);
        q[1] = pack2(O[0][d][4 * g + 2] * inv[0], O[0][d][4 * g + 3] * inv[0]);
        *(u32x2*)(yc + head * 64 + d * 32 + 8 * g + 4 * h) = q;
      }
  } else {
    const float* cl = p.c_lambda + l * 128;
    float d1 = 0.f, d2 = 0.f;
    for (int i = 0; i < 32; ++i) { d1 += cl[i] * cl[32 + i]; d2 += cl[64 + i] * cl[96 + i]; }
    const float lam_init = 0.8f - 0.6f * __expf(-0.3f * (float)l);
    const float lam = __expf(d1) - __expf(d2) + lam_init;
    float ss = 0.f;
#pragma unroll
    for (int d = 0; d < 2; ++d)
#pragma unroll
      for (int e = 0; e < 16; ++e) {
        const float dv = O[0][d][e] * inv[0] - lam * (O[NM - 1][d][e] * inv[NM - 1]);
        O[0][d][e] = dv; ss += dv * dv;
      }
    ss += __shfl_xor(ss, 32);
    const float sc = rsqrtf(ss * (1.f / 64.f) + EPSN) * (1.f - lam_init);
    const float* sg = p.c_subln_g + l * 64;
#pragma unroll
    for (int d = 0; d < 2; ++d)
#pragma unroll
      for (int g = 0; g < 4; ++g) {
        const int dv0 = d * 32 + 8 * g + 4 * h;
        u32x2 q;
        q[0] = pack2(O[0][d][4 * g] * sc * sg[dv0], O[0][d][4 * g + 1] * sc * sg[dv0 + 1]);
        q[1] = pack2(O[0][d][4 * g + 2] * sc * sg[dv0 + 2], O[0][d][4 * g + 3] * sc * sg[dv0 + 3]);
        *(u32x2*)(yc + 512 + head * 64 + dv0) = q;
      }
  }
}
DI void attn_dispatch(const Params& p, int l, int item, char* sm) {
  if (item < 128) {
    const int j = item & 63, b = j >> 5, qb = (j >> 2) & 7, head = j & 3;
    const int tok0 = NCTX + b * 1024 + qb * 128, kr0 = 4096 + b * 1536;
    if (item < 64) attn_item<true>(p, l, tok0, kr0, 1536, head, sm);
    else attn_item<false>(p, l, tok0, kr0, 1536, head, sm);
  } else {
    const int j = (item - 128) & 127, s = j >> 3, qb = (j >> 2) & 1, head = j & 3;
    const int tok0 = s * 256 + qb * 128, kr0 = s * 256;
    if (item < 256) attn_item<true>(p, l, tok0, kr0, 256, head, sm);
    else attn_item<false>(p, l, tok0, kr0, 256, head, sm);
  }
}

template <bool GLA>
struct ScanCtx { float wa[16]; float ba, lbm, oml; int ldir; };
template <bool GLA>
DI void scan_init(const Params& p, int l, int head, int dirh, int lane, ScanCtx<GLA>& cx) {
  const int ldir = GLA ? (lane >> 5) : dirh;
  cx.ldir = ldir;
  if (GLA) {
    const int kc = lane & 31;
#pragma unroll
    for (int j = 0; j < 16; ++j) cx.wa[j] = p.d_alpha_w[((size_t)(l * 2 + ldir) * 16 + j) * 128 + head * 32 + kc];
    cx.ba = p.d_alpha_b[(l * 2 + ldir) * 128 + head * 32 + kc];
  } else {
    float lb = 0.f;
    if (l > 0) {
      const float x0 = p.b_lb_logits[(ldir * 2 + 0) * 256 + head * 64 + lane], x1 = p.b_lb_logits[(ldir * 2 + 1) * 256 + head * 64 + lane];
      lb = 1.f / (1.f + __expf(x0 - x1));
    }
    cx.lbm = fmaxf(lb, 1e-30f); cx.oml = 1.f - lb;
  }
}
template <bool GLA>
DI float scan_la(const Params& p, const ScanCtx<GLA>& cx, int tok, int head, int lane, float& kk) {
  const u16* zr = (const u16*)(p.ws + WS_Z) + (size_t)tok * INW;
  if (GLA) {
    const u32x4 r0 = *(const u32x4*)(zr + ZD_RF + cx.ldir * 16), r1 = *(const u32x4*)(zr + ZD_RF + cx.ldir * 16 + 8);
    float v = cx.ba;
#pragma unroll
    for (int q = 0; q < 4; ++q) {
      v += cx.wa[2 * q] * lo_bf(r0[q]) + cx.wa[2 * q + 1] * hi_bf(r0[q]);
      v += cx.wa[8 + 2 * q] * lo_bf(r1[q]) + cx.wa[8 + 2 * q + 1] * hi_bf(r1[q]);
    }
    kk = bf2f(zr[ZD_K + head * 32 + (lane & 31)]);
    return (fminf(v, 0.f) - __logf(1.f + __expf(-fabsf(v)))) * (1.f / 16.f);
  } else {
    const float zz = bf2f(zr[(cx.ldir ? ZB_FB : ZB_FF) + head * 64 + lane]);
    const float sig = 1.f / (1.f + __expf(-zz));
    kk = cx.oml / (1.f + __expf(zz));
    return __logf(cx.lbm + cx.oml * sig);
  }
}
DI int tile_id(bool gla, int chunk, int head, int dir) { return gla ? 1536 + chunk * 4 + head : (chunk * 4 + head) * 2 + dir; }

template <bool GLA>
DI void scan_s1(const Params& p, int l, int chunk, int head, int dir, bool valid, u16* smw) {
  const int lane = tid_() & 63, r = lane & 31, h = lane >> 5;
  const int i16 = lane & 15, tq = i16 >> 2, tp = i16 & 3, blk = (lane >> 4) & 1;
  u16* ko = smw;
  u16* vt = smw + 32 * 72;
  const int start = chunk * 32;
  const u16* z = (const u16*)(p.ws + WS_Z);
  {
    ScanCtx<GLA> cx;
    scan_init<GLA>(p, l, head, dir, lane, cx);
    const int ldir = cx.ldir;
    float cl = 0.f, kk;
#pragma unroll 4
    for (int i = 0; i < 32; ++i) cl += scan_la<GLA>(p, cx, start + (ldir ? 31 - i : i), head, lane, kk);
    float cum = 0.f;
#pragma unroll 4
    for (int i = 0; i < 32; ++i) {
      const int pp = ldir ? 31 - i : i;
      cum += scan_la<GLA>(p, cx, start + pp, head, lane, kk);
      ko[pp * 72 + lane] = f2bf(kk * __expf(cl - cum));
    }
    if (valid) ((float*)(p.ws + WS_CL))[tile_id(GLA, chunk, head, dir) * 64 + lane] = cl;
  }
  {
    const int vcol = (GLA ? ZD_V : ZB_I) + head * 64;
#pragma unroll
    for (int i = 0; i < 4; ++i) {
      const int row = (lane >> 3) + 8 * i, c8 = (lane & 7) * 8;
      *(u32x4*)(vt + row * 72 + c8) = *(const u32x4*)(z + (size_t)(start + row) * INW + vcol + c8);
    }
  }
  __syncthreads();
  f32x16 acc[2][2];
  zero_acc<2>(acc);
#pragma unroll
  for (int st = 0; st < 2; ++st) {
    bf16x8 a[2], b[2];
#pragma unroll
    for (int x = 0; x < 2; ++x) {
      const u16* ap = vt + (16 * st + 8 * h + tq) * 72 + x * 32 + 16 * blk + 4 * tp;
      a[x] = trpair(ap, ap + 4 * 72);
      const u16* bp = ko + (16 * st + 8 * h + tq) * 72 + x * 32 + 16 * blk + 4 * tp;
      b[x] = trpair(bp, bp + 4 * 72);
    }
#pragma unroll
    for (int x = 0; x < 2; ++x)
#pragma unroll
      for (int y = 0; y < 2; ++y) acc[x][y] = MFMA(a[x], b[y], acc[x][y]);
  }
  if (valid) {
    float* U = (float*)(p.ws + WS_U) + (size_t)tile_id(GLA, chunk, head, dir) * 4096;
#pragma unroll
    for (int x = 0; x < 2; ++x)
#pragma unroll
      for (int y = 0; y < 2; ++y)
#pragma unroll
        for (int e = 0; e < 16; ++e) U[(x * 32 + crow(e, h)) * 64 + y * 32 + r] = acc[x][y][e];
  }
  __syncthreads();
}
DI void scan_s1_block(const Params& p, int l, int bitem, char* sm) {
  const int w = tid_() >> 6;
  int wi = bitem * 4 + w;
  u16* smw = (u16*)sm + w * (2 * 32 * 72);
  if (bitem < 384) scan_s1<false>(p, l, wi >> 3, (wi >> 1) & 3, wi & 1, true, smw);
  else { wi -= 1536; scan_s1<true>(p, l, wi >> 2, wi & 3, 0, true, smw); }
}

DI void scan_s2_item(const Params& p, int l, int item) {
  const int t = tid_();
  const int unit = item >> 2, vq = item & 3;
  const bool gla = unit >= 144;
  int seq, head, dir;
  if (!gla) { seq = unit >> 3; head = (unit >> 1) & 3; dir = unit & 1; }
  else { const int g = unit - 144; seq = g >> 2; head = g & 3; dir = 0; }
  const int c = t & 63;
  const int dc = gla ? (c >> 5) : dir;
  int N, chunk0;
  if (seq < 16) { N = 8; chunk0 = seq * 8; } else { N = 32; chunk0 = 128 + (seq - 16) * 32; }
  float S[4];
  int vv[4];
#pragma unroll
  for (int i = 0; i < 4; ++i) {
    vv[i] = vq * 16 + (t >> 6) + 4 * i;
    if (seq < 16) S[i] = 0.f;
    else {
      const int b = seq - 16;
      S[i] = gla ? p.state_gla[(size_t)(((b * 2 + l) * 2 + dc) * 4 + head) * 2048 + (c & 31) * 64 + vv[i]]
                 : p.state_hgrn[(size_t)(((b * 2 + l) * 2 + dc) * 4 + head) * 4096 + c * 64 + vv[i]];
    }
  }
  const float* __restrict__ U = (const float*)(p.ws + WS_U);
  const float* __restrict__ CL = (const float*)(p.ws + WS_CL);
  float* __restrict__ SS = (float*)(p.ws + WS_S);
  for (int m0 = 0; m0 < N; m0 += 4) {
    float tmp[4][4], a[4];
    int ids[4];
#pragma unroll
    for (int mm = 0; mm < 4; ++mm) {
      const int m = m0 + mm;
      ids[mm] = tile_id(gla, chunk0 + (dc ? N - 1 - m : m), head, dir);
      a[mm] = CL[ids[mm] * 64 + c];
#pragma unroll
      for (int i = 0; i < 4; ++i) tmp[mm][i] = U[(size_t)ids[mm] * 4096 + vv[i] * 64 + c];
    }
#pragma unroll
    for (int mm = 0; mm < 4; ++mm) {
      const float ea = __expf(a[mm]);
#pragma unroll
      for (int i = 0; i < 4; ++i) {
        SS[(size_t)ids[mm] * 4096 + vv[i] * 64 + c] = S[i];
        S[i] = ea * S[i] + tmp[mm][i];
      }
    }
  }
  if (seq < 16) {
#pragma unroll
    for (int i = 0; i < 4; ++i) {
      if (gla) p.out[O_SG + (size_t)(((seq * 2 + l) * 2 + dc) * 4 + head) * 2048 + (c & 31) * 64 + vv[i]] = S[i];
      else p.out[O_SH + (size_t)(((seq * 2 + l) * 2 + dc) * 4 + head) * 4096 + c * 64 + vv[i]] = S[i];
    }
  }
}

template <bool GLA>
DI void scan_s3(const Params& p, int l, int chunk, int head, u16* smw) {
  const int lane = tid_() & 63, r = lane & 31, h = lane >> 5;
  const int i16 = lane & 15, tq = i16 >> 2, tp = i16 & 3, blk = (lane >> 4) & 1;
  u16* qt = smw;
  u16* kt = smw + 32 * 72;
  u16* vt = smw + 2 * 32 * 72;
  float* sref = (float*)(smw + 3 * 32 * 72);
  const int start = chunk * 32;
  const u16* z = (const u16*)(p.ws + WS_Z);
  {
    const int vcol = (GLA ? ZD_V : ZB_I) + head * 64;
#pragma unroll
    for (int i = 0; i < 4; ++i) {
      const int row = (lane >> 3) + 8 * i, c8 = (lane & 7) * 8;
      *(u32x4*)(vt + row * 72 + c8) = *(const u32x4*)(z + (size_t)(start + row) * INW + vcol + c8);
    }
  }
  f32x16 o[2];
#pragma unroll
  for (int x = 0; x < 2; ++x)
#pragma unroll
    for (int e = 0; e < 16; ++e) o[x][e] = 0.f;
  constexpr int NPASS = GLA ? 1 : 2;
#pragma unroll 1
  for (int pass = 0; pass < NPASS; ++pass) {
    {
      ScanCtx<GLA> cx;
      scan_init<GLA>(p, l, head, pass, lane, cx);
      const int ldir = cx.ldir;
      float ref = 0.f, kk, cum = 0.f;
#pragma unroll 4
      for (int i = 0; i < 16; ++i) ref += scan_la<GLA>(p, cx, start + (ldir ? 31 - i : i), head, lane, kk);
      sref[lane] = __expf(ref);
#pragma unroll 4
      for (int i = 0; i < 32; ++i) {
        const int pp = ldir ? 31 - i : i;
        const int tok = start + pp;
        cum += scan_la<GLA>(p, cx, tok, head, lane, kk);
        float qv;
        if (GLA) qv = bf2f(z[(size_t)tok * INW + ZD_Q + head * 32 + (lane & 31)]) * 0.17677669529663687f;
        else { const float zq = bf2f(z[(size_t)tok * INW + ZB_Q + head * 64 + lane]); qv = zq * sigmoidf_(zq); }
        qt[pp * 72 + lane] = f2bf(qv * __expf(cum - ref));
        kt[pp * 72 + lane] = f2bf(kk * __expf(ref - cum));
      }
    }
    __syncthreads();
    constexpr int NS = GLA ? 2 : 1;
    f32x16 sc[NS];
#pragma unroll
    for (int m = 0; m < NS; ++m)
#pragma unroll
      for (int e = 0; e < 16; ++e) sc[m][e] = 0.f;
    bf16x8 qfr[4];
#pragma unroll
    for (int st = 0; st < 4; ++st) {
      qfr[st] = *(const bf16x8*)(qt + r * 72 + 16 * st + 8 * h);
      const bf16x8 kf = *(const bf16x8*)(kt + r * 72 + 16 * st + 8 * h);
      const int m = GLA ? (st >> 1) : 0;
      sc[m] = MFMA(kf, qfr[st], sc[m]);
    }
#pragma unroll
    for (int m = 0; m < NS; ++m) {
      const int d = GLA ? m : pass;
#pragma unroll
      for (int e = 0; e < 16; ++e) {
        const int s = crow(e, h);
        const bool keep = d ? (s >= r) : (s <= r);
        sc[m][e] = keep ? sc[m][e] : 0.f;
      }
#pragma unroll
      for (int st = 0; st < 2; ++st) {
        const bf16x8 pf = pack8(sc[m], st);
#pragma unroll
        for (int x = 0; x < 2; ++x) {
          const u16* vp = vt + (16 * st + 4 * h + tq) * 72 + x * 32 + 16 * blk + 4 * tp;
          const bf16x8 vf = trpair(vp, vp + 8 * 72);
          o[x] = MFMA(vf, pf, o[x]);
        }
      }
    }
    const float* Sg = (const float*)(p.ws + WS_S) + (size_t)tile_id(GLA, chunk, head, pass) * 4096;
#pragma unroll
    for (int x = 0; x < 2; ++x)
#pragma unroll
      for (int st = 0; st < 4; ++st) {
        const float* sp = Sg + (x * 32 + r) * 64 + 16 * st + 8 * h;
        const float4 s0 = *(const float4*)sp, s1 = *(const float4*)(sp + 4);
        const float4 e0 = *(const float4*)(sref + 16 * st + 8 * h), e1 = *(const float4*)(sref + 16 * st + 8 * h + 4);
        u32x4 q;
        q[0] = pack2(s0.x * e0.x, s0.y * e0.y); q[1] = pack2(s0.z * e0.z, s0.w * e0.w);
        q[2] = pack2(s1.x * e1.x, s1.y * e1.y); q[3] = pack2(s1.z * e1.z, s1.w * e1.w);
        o[x] = MFMA(__builtin_bit_cast(bf16x8, q), qfr[st], o[x]);
      }
    __syncthreads();
  }
  float ss = 0.f;
#pragma unroll
  for (int x = 0; x < 2; ++x)
#pragma unroll
    for (int e = 0; e < 16; ++e) ss += o[x][e] * o[x][e];
  ss += __shfl_xor(ss, 32);
  const float rstd = rsqrtf(ss * (1.f / 64.f) + EPSN);
  const int tok = start + r;
  const float* gn = (GLA ? p.d_norm_g : p.b_norm_g) + l * 64;
  const u16* gz = z + (size_t)tok * INW + (GLA ? ZD_G : ZB_G) + head * 64;
  u16* yc = (u16*)(p.ws + WS_YCAT) + (size_t)tok * 1024 + (GLA ? 768 : 256) + head * 64;
#pragma unroll
  for (int x = 0; x < 2; ++x)
#pragma unroll
    for (int g = 0; g < 4; ++g) {
      const int v0 = x * 32 + 8 * g + 4 * h;
      const u32x2 gr = *(const u32x2*)(gz + v0);
      const float g0 = lo_bf(gr[0]), g1 = hi_bf(gr[0]), g2 = lo_bf(gr[1]), g3 = hi_bf(gr[1]);
      u32x2 q;
      q[0] = pack2(o[x][4 * g] * rstd * gn[v0] * g0 * sigmoidf_(g0), o[x][4 * g + 1] * rstd * gn[v0 + 1] * g1 * sigmoidf_(g1));
      q[1] = pack2(o[x][4 * g + 2] * rstd * gn[v0 + 2] * g2 * sigmoidf_(g2), o[x][4 * g + 3] * rstd * gn[v0 + 3] * g3 * sigmoidf_(g3));
      *(u32x2*)(yc + v0) = q;
    }
}
DI void scan_s3_block(const Params& p, int l, int bitem, char* sm) {
  const int w = tid_() >> 6;
  u16* smw = (u16*)sm + w * (3 * 32 * 72 + 128);
  int wi = bitem * 4 + w;
  if (bitem < 192) scan_s3<false>(p, l, wi >> 2, wi & 3, smw);
  else { wi -= 768; scan_s3<true>(p, l, wi >> 2, wi & 3, smw); }
}

DI void run_phase(const Params& p, int ph, char* sm, bool dry) {
  const int bid = blockIdx.x, nb = gridDim.x;
#ifdef PHASE_ONLY
  if (ph != 0 && (ph - 1) % 11 != PHASE_ONLY - 1) return;
  if (ph == 0 && PHASE_ONLY != 0) return;
#endif
  if (ph == 0) {
    for (int it = bid; it < 192 + CONVW_ITEMS; it += nb) {
      if (it < 192) mod_item(p, it, sm); else convw_item(p, 0, it - 192, sm);
    }
    return;
  }
  const int l = (ph - 1) / 11, s = (ph - 1) % 11;
  switch (s) {
    case 0: {
      const int w = tid_() >> 6;
      for (int tk = bid * 4 + w; tk < NTOK; tk += nb * 4) norm_tok(p, l, 0, tk);
      if (l > 0) for (int it = bid; it < CONVW_ITEMS; it += nb) convw_item(p, l, it, sm);
    } break;
    case 1: for (int it = bid; it < 48 * 59; it += nb) gemm_in_item(p, it, sm); break;
    case 2:
      for (int it = bid; it < 576 + 7168; it += nb) {
        if (it < 576) scan_s1_block(p, l, it, sm); else prep_item(p, l, it - 576);
      }
      break;
    case 3:
      for (int it = bid; it < 384 + 864; it += nb) {
        if (it < 128) attn_dispatch(p, l, it, sm);
        else if (it < 128 + 864) scan_s2_item(p, l, it - 128);
        else attn_dispatch(p, l, it - 864, sm);
      }
      break;
    case 4: for (int it = bid; it < 384; it += nb) scan_s3_block(p, l, it, sm); break;
    case 5: for (int it = bid; it < 768; it += nb) gemm_branch_item(p, it, sm); break;
    case 6: for (int it = bid; it < 384; it += nb) gemm_out_item(p, l, it, sm, dry); break;
    case 7: {
      const int w = tid_() >> 6;
      for (int tk = bid * 4 + w; tk < NTOK; tk += nb * 4) norm_tok(p, l, 1, tk);
    } break;
    case 8: for (int it = bid; it < 48 * 44; it += nb) gemm_up_item(p, it, sm); break;
    case 9: conv_act(p, l, bid * 256 + tid_(), nb * 256); break;
    case 10: for (int it = bid; it < 384; it += nb) gemm_down_item(p, l, it, sm, dry); break;
  }
}

__global__ void __launch_bounds__(256, 2) fwd_mega(Params p) {
  __shared__ __attribute__((aligned(16))) char sm[SMEM_BYTES];
  __shared__ uint4 xb_words;
  cg::grid_group grid = cg::this_grid();
  if (p.coop == 2) grid.sync();
  if (__builtin_amdgcn_workitem_id_x() == 0) xb_words = make_uint4(0u, 0u, 0u, 0u);
  __syncthreads();
  XcdBarrier xb;
  if (p.coop) xb = xcd_barrier_post((unsigned*)(p.ws + WS_BAR), (volatile LAS unsigned*)&xb_words);
  for (int ph = p.phase_begin; ph < p.phase_end; ++ph) {
    if (ph > p.phase_begin && p.coop) xcd_barrier(xb);
    run_phase(p, ph, sm, false);
#if PROBE_STEP >= 0
    if ((PROBE_STEP == 11 && ph == 0) || (ph > 0 && (ph - 1) % 11 == PROBE_STEP)) {
      if (p.coop) xcd_barrier(xb);
      run_phase(p, ph, sm, true);
    }
#endif
  }
}

extern "C" void kernel_launch(void* const* d_in, const int* in_sizes, int n_in, void* d_out, int out_size, void* d_ws,
                              size_t ws_size, hipStream_t stream) {
  static int grid_blocks = 0;
  if (!grid_blocks) {
    int dev = 0, cus = 0, per_cu = 0;
    hipGetDevice(&dev);
    hipDeviceGetAttribute(&cus, hipDeviceAttributeMultiprocessorCount, dev);
    hipOccupancyMaxActiveBlocksPerMultiprocessor(&per_cu, fwd_mega, 256, 0);
    if (per_cu > 2) per_cu = 2;
    if (per_cu < 1) per_cu = 1;
    grid_blocks = cus * per_cu;
  }
  Params p{};
  const float** pp = (const float**)&p;
  for (int i = 0; i < 32; ++i) pp[i] = (const float*)d_in[i];
  p.out = (float*)d_out;
  p.ws = (char*)d_ws;
  if (ws_size < WS_END) { fprintf(stderr, "workspace too small: %zu < %zu\n", ws_size, (size_t)WS_END); return; }
#if MULTI
  for (int ph = 0; ph < NPHASE; ++ph) {
    p.phase_begin = ph; p.phase_end = ph + 1; p.coop = 0; p.pad = 0;
    hipLaunchKernelGGL(fwd_mega, dim3(grid_blocks), dim3(256), 0, stream, p);
  }
#else
  p.phase_begin = 0; p.phase_end = NPHASE; p.coop = 1; p.pad = 0;
  hipMemsetAsync((char*)d_ws + WS_BAR, 0, 16384, stream);
  void* args[] = {&p};
  hipError_t e = hipLaunchCooperativeKernel((void*)fwd_mega, dim3(grid_blocks), dim3(256), args, 0, stream);
  if (e != hipSuccess) fprintf(stderr, "cooperative launch failed: %s (grid %d)\n", hipGetErrorString(e), grid_blocks);
#endif
}
```

```cpp
#include <hip/hip_runtime.h>
#include <hip/hip_bf16.h>
#include <hip/hip_cooperative_groups.h>
#include <cstdio>
namespace cg = cooperative_groups;

#ifndef MULTI
#define MULTI 0
#endif
#ifndef PROBE_STEP
#define PROBE_STEP -1
#endif

#define DI __device__ __forceinline__
typedef unsigned short u16;
using bf16x8 = __attribute__((ext_vector_type(8))) short;
using s16x4  = __attribute__((ext_vector_type(4))) short;
using f32x16 = __attribute__((ext_vector_type(16))) float;
using u32x4  = __attribute__((ext_vector_type(4))) unsigned;
using u32x2  = __attribute__((ext_vector_type(2))) unsigned;
#define MFMA(a, b, c) __builtin_amdgcn_mfma_f32_32x32x16_bf16((a), (b), (c), 0, 0, 0)

constexpr int NTOK = 6144, NCTX = 4096, DM = 1024, INW = 7456, DFF = 2816, DFF2 = 5632;
constexpr int ZA_Q = 0, ZA_K = 256, ZA_V = 384, ZC_Q = 512, ZC_K = 768, ZC_V = 1024, ZB_Q = 1280, ZB_I = 1536, ZB_FF = 1792,
              ZB_FB = 2048, ZB_G = 2304, ZD_Q = 2560, ZD_K = 2688, ZD_V = 2816, ZD_G = 3072, ZD_RF = 3328, Z_ML = 3360;
constexpr float EPSN = 1e-6f;
constexpr size_t O_CAK = 6291456, O_CAV = 7340032, O_CCK = 8388608, O_CCV = 10485760, O_SH = 12582912, O_SG = 13631488;
constexpr size_t WS_WIN = 0;
constexpr size_t WS_WBR = WS_WIN + (size_t)INW * 1024 * 2;
constexpr size_t WS_WOUT = WS_WBR + (size_t)4 * 1024 * 256 * 2;
constexpr size_t WS_WUP = WS_WOUT + (size_t)1024 * 1024 * 2;
constexpr size_t WS_WDN = WS_WUP + (size_t)DFF2 * 1024 * 2;
constexpr size_t WS_MOD = WS_WDN + (size_t)1024 * DFF * 2;
constexpr size_t WS_H = WS_MOD + (size_t)2 * 3 * 6144 * 4;
constexpr size_t WS_Z = WS_H + (size_t)NTOK * 1024 * 2;
constexpr size_t WS_QA = WS_Z + (size_t)NTOK * INW * 2;
constexpr size_t WS_QC = WS_QA + (size_t)NTOK * 256 * 2;
constexpr size_t WS_KA = WS_QC + (size_t)NTOK * 256 * 2;
constexpr size_t WS_VA = WS_KA + (size_t)7168 * 128 * 2;
constexpr size_t WS_KC = WS_VA + (size_t)7168 * 128 * 2;
constexpr size_t WS_VC = WS_KC + (size_t)7168 * 256 * 2;
constexpr size_t WS_YCAT = WS_VC + (size_t)7168 * 256 * 2;
constexpr size_t WS_ACT = WS_YCAT + (size_t)NTOK * 1024 * 2;
constexpr size_t WS_MIX = WS_ACT + (size_t)NTOK * DFF * 2;
constexpr size_t WS_CL = WS_MIX + (size_t)NTOK * 1024 * 2;
constexpr size_t WS_U = WS_ACT;
constexpr size_t WS_S = WS_CL + (size_t)2304 * 64 * 4;
constexpr size_t WS_BAR = WS_S + (size_t)2304 * 4096 * 4;
constexpr size_t WS_END = WS_BAR + 16384;
static_assert((size_t)2304 * 4096 * 4 <= (size_t)NTOK * DFF * 2 + (size_t)NTOK * 1024 * 2, "U alias");
static_assert(WS_END <= (size_t)256 * 1024 * 1024, "ws budget");
constexpr int SMEM_BYTES = 73728;
constexpr int NPHASE = 23;

struct Params {
  const float *x_prompt, *x_sample, *cache_a_k, *cache_a_v, *cache_c_k, *cache_c_v, *state_hgrn, *state_gla, *c, *c_ctx,
      *w_ada, *b_ada, *norm1_g, *norm2_g, *w_in, *a_qn_g, *a_kn_g, *c_qn_g, *c_kn_g, *c_lambda, *c_subln_g, *b_lb_logits,
      *b_norm_g, *d_alpha_w, *d_alpha_b, *d_norm_g, *w_branch, *w_out, *w_up, *conv_w, *conv_b, *w_down;
  float* out;
  char* ws;
  int phase_begin, phase_end, coop, pad;
};

DI int tid_() { int t = __builtin_amdgcn_workitem_id_x(); asm volatile("" : "+v"(t)); return t; }
DI float bf2f(u16 u) { return __uint_as_float(((unsigned)u) << 16); }
DI u16 f2bf(float a) { __hip_bfloat16 b = __float2bfloat16(a); return *(u16*)&b; }
DI unsigned pack2(float a, float b) { __hip_bfloat162 q = __float22bfloat162_rn(make_float2(a, b)); return *(unsigned*)&q; }
DI float lo_bf(unsigned u) { return __uint_as_float(u << 16); }
DI float hi_bf(unsigned u) { return __uint_as_float(u & 0xffff0000u); }
DI float sigmoidf_(float x) { return 1.f / (1.f + __expf(-x)); }
DI int crow(int e, int h) { return (e & 3) + 8 * (e >> 2) + 4 * h; }
DI bf16x8 pack8(const f32x16& x, int s) {
  u32x4 q;
  q[0] = pack2(x[8 * s + 0], x[8 * s + 1]); q[1] = pack2(x[8 * s + 2], x[8 * s + 3]);
  q[2] = pack2(x[8 * s + 4], x[8 * s + 5]); q[3] = pack2(x[8 * s + 6], x[8 * s + 7]);
  return __builtin_bit_cast(bf16x8, q);
}
DI s16x4 trread(const u16* pl) {
  return __builtin_amdgcn_ds_read_tr16_b64_v4i16((__attribute__((address_space(3))) s16x4*)pl);
}
DI bf16x8 trpair(const u16* p0, const u16* p1) {
  s16x4 a = trread(p0), b = trread(p1);
  return __builtin_shufflevector(a, b, 0, 1, 2, 3, 4, 5, 6, 7);
}
DI float wave_sum(float v) {
#pragma unroll
  for (int o = 32; o >= 1; o >>= 1) v += __shfl_xor(v, o);
  return v;
}
DI int tok_cond(int t) { return t < NCTX ? 0 : 1 + ((t - NCTX) >> 10); }
DI const float* xin_row(const Params& p, int l, int tok) {
  if (l > 0) return p.out + (size_t)tok * DM;
  return tok < NCTX ? p.x_prompt + (size_t)tok * DM : p.x_sample + (size_t)(tok - NCTX) * DM;
}


#define XB_TMO      128
#define XB_XCNT(j)  (256  + 64 * (j))
#define XB_XSUB(j)  (1280 + 64 * (j))
#define XB_XGEN(j)  (2304 + 64 * (j))
#define XB_TOP      3328
#define XB_TOPGEN   3392
#define XCD_BAR_WORDS 3456
#define XB_SPIN_CAP (1u << 22)
#define LAS __attribute__((address_space(3)))
DI unsigned xb_ld(unsigned* p) { return __hip_atomic_load(p, __ATOMIC_RELAXED, __HIP_MEMORY_SCOPE_AGENT); }
DI unsigned xb_add(unsigned* p, unsigned v) { return __hip_atomic_fetch_add(p, v, __ATOMIC_RELAXED, __HIP_MEMORY_SCOPE_AGENT); }
DI unsigned xb_xcc_id() { return (unsigned)__builtin_amdgcn_s_getreg((3 << 11) | 20) & 0xFu; }
#define XB_SPIN(cond, bar) do { unsigned _sp = 0; while (cond) { __builtin_amdgcn_s_sleep(1); \
    if ((++_sp & 255u) == 0u) { if (xb_ld(&(bar)[XB_TMO])) break; if (_sp > XB_SPIN_CAP) { atomicAdd(&(bar)[XB_TMO], 1u); break; } } } } while (0)
struct XcdBarrier { unsigned* bar; unsigned x; volatile LAS unsigned* st; };
DI XcdBarrier xcd_barrier_post(unsigned* bar, volatile LAS unsigned* st) {
  XcdBarrier b; b.bar = bar; b.x = xb_xcc_id(); b.st = st;
  if (__builtin_amdgcn_workitem_id_x() == 0) (void)xb_add(&bar[XB_XCNT(b.x)], 1u);
  return b;
}
DI void xcd_barrier_complete(unsigned* bar, unsigned x, unsigned& nloc, unsigned& nx) {
  const unsigned G = gridDim.x * gridDim.y * gridDim.z;
  unsigned sum, cnt, mine, sp = 0u;
  for (;;) {
    sum = 0u; cnt = 0u; mine = 0u;
#pragma unroll
    for (unsigned j = 0; j < 16; ++j) { const unsigned c = xb_ld(&bar[XB_XCNT(j)]); sum += c; cnt += (c > 0u) ? 1u : 0u; mine = (j == x) ? c : mine; }
    if (sum == G) break;
    __builtin_amdgcn_s_sleep(1);
    if ((++sp & 255u) == 0u) { if (xb_ld(&bar[XB_TMO])) break; if (sp > XB_SPIN_CAP) { atomicAdd(&bar[XB_TMO], 1u); break; } }
  }
  nloc = mine > 0u ? mine : 1u; nx = cnt > 0u ? cnt : 1u;
}
DI void xcd_barrier(const XcdBarrier& b) {
  asm volatile("s_waitcnt vmcnt(0)" ::: "memory");
  __syncthreads();
  if (__builtin_amdgcn_workitem_id_x() == 0) {
    unsigned* bar = b.bar;
    __builtin_amdgcn_s_waitcnt(0);
    unsigned nloc = b.st[0], nx = b.st[1];
    if (nloc == 0u) { xcd_barrier_complete(bar, b.x, nloc, nx); b.st[0] = nloc; b.st[1] = nx; }
    const unsigned old = xb_add(&bar[XB_XSUB(b.x)], 1u);
    const unsigned gen = old / nloc;
    if (old + 1u == (gen + 1u) * nloc) {
      __builtin_amdgcn_fence(__ATOMIC_RELEASE, "agent");
      asm volatile("s_waitcnt vmcnt(0)" ::: "memory");
      const unsigned og = xb_add(&bar[XB_TOP], 1u);
      const unsigned tg = og / nx;
      if (og + 1u == (tg + 1u) * nx) xb_add(&bar[XB_TOPGEN], 1u);
      else XB_SPIN(xb_ld(&bar[XB_TOPGEN]) == tg, bar);
      __builtin_amdgcn_fence(__ATOMIC_ACQUIRE, "agent");
      xb_add(&bar[XB_XGEN(b.x)], 1u);
      asm volatile("s_waitcnt vmcnt(0)" ::: "memory");
    } else {
      XB_SPIN(xb_ld(&bar[XB_XGEN(b.x)]) == gen, bar);
      __builtin_amdgcn_fence(__ATOMIC_ACQUIRE, "agent");
      asm volatile("s_waitcnt vmcnt(0)" ::: "memory");
    }
  }
  __syncthreads();
}

DI void convw_tile(const float* __restrict__ src, u16* __restrict__ dst, int K, int N, int item, float* T) {
  const int t = tid_();
  const int ntn = (N + 63) >> 6;
  const int n0 = (item % ntn) * 64, k0 = (item / ntn) * 64;
  {
    const int n4 = (t & 15) * 4;
    float4 v[4];
#pragma unroll
    for (int i = 0; i < 4; ++i) {
      const int kl = (t >> 4) + 16 * i;
      v[i] = (n0 + n4 < N) ? *(const float4*)(src + (size_t)(k0 + kl) * N + n0 + n4) : make_float4(0.f, 0.f, 0.f, 0.f);
    }
#pragma unroll
    for (int i = 0; i < 4; ++i) {
      const int kl = (t >> 4) + 16 * i;
      T[(n4 + 0) * 65 + kl] = v[i].x; T[(n4 + 1) * 65 + kl] = v[i].y;
      T[(n4 + 2) * 65 + kl] = v[i].z; T[(n4 + 3) * 65 + kl] = v[i].w;
    }
  }
  __syncthreads();
  {
    const int n = t >> 2, k16 = (t & 3) * 16;
    const float* tr = T + n * 65 + k16;
    u32x4 q0, q1;
    q0[0] = pack2(tr[0], tr[1]); q0[1] = pack2(tr[2], tr[3]); q0[2] = pack2(tr[4], tr[5]); q0[3] = pack2(tr[6], tr[7]);
    q1[0] = pack2(tr[8], tr[9]); q1[1] = pack2(tr[10], tr[11]); q1[2] = pack2(tr[12], tr[13]); q1[3] = pack2(tr[14], tr[15]);
    if (n0 + n < N) {
      u16* dp = dst + (size_t)(n0 + n) * K + k0 + k16;
      *(u32x4*)dp = q0; *(u32x4*)(dp + 8) = q1;
    }
  }
  __syncthreads();
}
constexpr int CONVW_ITEMS = 1872 + 256 + 256 + 1408 + 704;
DI void convw_item(const Params& p, int l, int item, char* sm) {
  float* T = (float*)sm;
  char* ws = p.ws;
  if (item < 1872) convw_tile(p.w_in + (size_t)l * 1024 * INW, (u16*)(ws + WS_WIN), 1024, INW, item, T);
  else if (item < 2128) convw_tile(p.w_branch + (size_t)l * 1024 * 1024, (u16*)(ws + WS_WBR), 1024, 1024, item - 1872, T);
  else if (item < 2384) convw_tile(p.w_out + (size_t)l * 1024 * 1024, (u16*)(ws + WS_WOUT), 1024, 1024, item - 2128, T);
  else if (item < 3792) convw_tile(p.w_up + (size_t)l * 1024 * DFF2, (u16*)(ws + WS_WUP), 1024, DFF2, item - 2384, T);
  else convw_tile(p.w_down + (size_t)l * DFF * 1024, (u16*)(ws + WS_WDN), DFF, 1024, item - 3792, T);
}

constexpr int MOD_ITEMS = 384;
DI void mod_item(const Params& p, int item, char* sm) {
  float* sc = (float*)sm;
  float* red = sc + 3072;
  const int t = tid_();
  const int l = item / 192, j0 = (item % 192) * 32;
  for (int i = t; i < 3072; i += 256) {
    const int cnd = i >> 10, k = i & 1023;
    const float v = cnd == 0 ? p.c_ctx[k] : p.c[(cnd - 1) * 1024 + k];
    sc[i] = v * sigmoidf_(v);
  }
  __syncthreads();
  const int cq = t & 7, ks = t >> 3;
  float a0[4] = {0, 0, 0, 0}, a1[4] = {0, 0, 0, 0}, a2[4] = {0, 0, 0, 0};
  const float* wp = p.w_ada + (size_t)l * 1024 * 6144 + j0 + 4 * cq;
#pragma unroll 8
  for (int rr = 0; rr < 32; ++rr) {
    const int row = ks * 32 + rr;
    const float4 w4 = *(const float4*)(wp + (size_t)row * 6144);
    const float s0 = sc[row], s1 = sc[1024 + row], s2 = sc[2048 + row];
    a0[0] += s0 * w4.x; a0[1] += s0 * w4.y; a0[2] += s0 * w4.z; a0[3] += s0 * w4.w;
    a1[0] += s1 * w4.x; a1[1] += s1 * w4.y; a1[2] += s1 * w4.z; a1[3] += s1 * w4.w;
    a2[0] += s2 * w4.x; a2[1] += s2 * w4.y; a2[2] += s2 * w4.z; a2[3] += s2 * w4.w;
  }
#pragma unroll
  for (int q = 0; q < 4; ++q) {
    red[(ks * 3 + 0) * 32 + 4 * cq + q] = a0[q];
    red[(ks * 3 + 1) * 32 + 4 * cq + q] = a1[q];
    red[(ks * 3 + 2) * 32 + 4 * cq + q] = a2[q];
  }
  __syncthreads();
  if (t < 96) {
    const int cnd = t >> 5, col = t & 31;
    float sacc = p.b_ada[l * 6144 + j0 + col];
    for (int k = 0; k < 32; ++k) sacc += red[(k * 3 + cnd) * 32 + col];
    ((float*)(p.ws + WS_MOD))[(l * 3 + cnd) * 6144 + j0 + col] = sacc;
  }
  __syncthreads();
}

DI void norm_tok(const Params& p, int l, int which, int tok) {
  const int lane = tid_() & 63;
  const float* xr = which == 0 ? xin_row(p, l, tok) : p.out + (size_t)tok * DM;
  const float* g = (which == 0 ? p.norm1_g : p.norm2_g) + l * 1024;
  const float* mod = (const float*)(p.ws + WS_MOD) + (l * 3 + tok_cond(tok)) * 6144 + which * 3072;
  float4 v[4];
  float ss = 0.f;
#pragma unroll
  for (int i = 0; i < 4; ++i) {
    v[i] = *(const float4*)(xr + 4 * lane + 256 * i);
    ss += v[i].x * v[i].x + v[i].y * v[i].y + v[i].z * v[i].z + v[i].w * v[i].w;
  }
  ss = wave_sum(ss);
  const float rstd = rsqrtf(ss * (1.f / 1024.f) + EPSN);
  u16* hr = (u16*)(p.ws + WS_H) + (size_t)tok * DM;
#pragma unroll
  for (int i = 0; i < 4; ++i) {
    const int c0 = 4 * lane + 256 * i;
    const float4 gg = *(const float4*)(g + c0);
    const float4 sh = *(const float4*)(mod + c0);
    const float4 scv = *(const float4*)(mod + 1024 + c0);
    u32x2 q;
    q[0] = pack2(v[i].x * rstd * gg.x * (1.f + scv.x) + sh.x, v[i].y * rstd * gg.y * (1.f + scv.y) + sh.y);
    q[1] = pack2(v[i].z * rstd * gg.z * (1.f + scv.z) + sh.z, v[i].w * rstd * gg.w * (1.f + scv.w) + sh.w);
    *(u32x2*)(hr + c0) = q;
  }
}

template <int NJ, bool GATED>
DI void gemm_core(const u16* __restrict__ A, int lda, const u16* __restrict__ Bt, int ldb, int K, int m0, int n0, int N,
                  f32x16 (&acc)[2][NJ], u16* sm, const u16* __restrict__ gz = nullptr, f32x16 (*tot)[NJ] = nullptr) {
  const int t = tid_(), lane = t & 63, w = t >> 6, r = lane & 31, h = lane >> 5;
  const int wm = w & 1, wn = w >> 1;
  u16* As = sm;
  u16* Bs = sm + 2 * 128 * 72;
  const int lrow = t >> 3, lc8 = (t & 7) * 8;
  int aoff[4], boff[2 * NJ];
#pragma unroll
  for (int i = 0; i < 4; ++i) aoff[i] = (m0 + lrow + 32 * i) * lda + lc8;
#pragma unroll
  for (int i = 0; i < 2 * NJ; ++i) {
    int bn = n0 + lrow + 32 * i;
    bn = bn < N ? bn : N - 1;
    boff[i] = bn * ldb + lc8;
  }
  u32x4 ra[2][4], rb[2][2 * NJ];
  const int KT = K >> 6;
  auto gload = [&](int set, int kt) {
    const int k0 = kt * 64;
#pragma unroll
    for (int i = 0; i < 4; ++i) ra[set][i] = *(const u32x4*)(A + aoff[i] + k0);
#pragma unroll
    for (int i = 0; i < 2 * NJ; ++i) rb[set][i] = *(const u32x4*)(Bt + boff[i] + k0);
  };
  auto sstore = [&](int set, int buf) {
    const int nb = buf * 128 * 72;
#pragma unroll
    for (int i = 0; i < 4; ++i) *(u32x4*)(As + nb + (lrow + 32 * i) * 72 + lc8) = ra[set][i];
#pragma unroll
    for (int i = 0; i < 2 * NJ; ++i) *(u32x4*)(Bs + nb + (lrow + 32 * i) * 72 + lc8) = rb[set][i];
  };
  auto compute = [&](int buf) {
    const u16* as = As + buf * 128 * 72 + (wm * 64 + r) * 72 + 8 * h;
    const u16* bs = Bs + buf * 128 * 72 + (wn * 32 * NJ + r) * 72 + 8 * h;
#pragma unroll
    for (int ks = 0; ks < 4; ++ks) {
      const bf16x8 a0 = *(const bf16x8*)(as + ks * 16), a1 = *(const bf16x8*)(as + 32 * 72 + ks * 16);
#pragma unroll
      for (int j = 0; j < NJ; ++j) {
        const bf16x8 b0 = *(const bf16x8*)(bs + j * 32 * 72 + ks * 16);
        acc[0][j] = MFMA(a0, b0, acc[0][j]);
        acc[1][j] = MFMA(a1, b0, acc[1][j]);
      }
    }
  };
  gload(0, 0);
  gload(1, 1);
  sstore(0, 0);
  __syncthreads();
  for (int kt = 0; kt < KT; kt += 2) {
    if (kt + 2 < KT) gload(0, kt + 2);
    compute(0);
    sstore(1, 1);
    __syncthreads();
    if (kt + 3 < KT) gload(1, kt + 3);
    u16 graw[GATED ? 32 * NJ : 1];
    if (GATED && (kt & 3) == 2) {
      const int n = kt >> 2;
#pragma unroll
      for (int i = 0; i < 2; ++i)
#pragma unroll
        for (int j = 0; j < NJ; ++j)
#pragma unroll
          for (int e = 0; e < 16; ++e)
            graw[(i * NJ + j) * 16 + e] = gz[(size_t)(m0 + wm * 64 + i * 32 + crow(e, h)) * INW + n * 1024 + n0 + wn * 32 * NJ + j * 32 + r];
    }
    compute(1);
    if (kt + 2 < KT) sstore(0, 0);
    __syncthreads();
    if (GATED && (kt & 3) == 2) {
#pragma unroll
      for (int i = 0; i < 2; ++i)
#pragma unroll
        for (int j = 0; j < NJ; ++j)
#pragma unroll
          for (int e = 0; e < 16; ++e) {
            tot[i][j][e] += sigmoidf_(bf2f(graw[(i * NJ + j) * 16 + e])) * acc[i][j][e];
            acc[i][j][e] = 0.f;
          }
    }
  }
}
template <int NJ>
DI void zero_acc(f32x16 (&acc)[2][NJ]) {
#pragma unroll
  for (int i = 0; i < 2; ++i)
#pragma unroll
    for (int j = 0; j < NJ; ++j)
#pragma unroll
      for (int e = 0; e < 16; ++e) acc[i][j][e] = 0.f;
}
#define EPI_LOOP_N(NJ_, body)                                                       \
  {                                                                                 \
    const int lane_ = tid_() & 63, w_ = tid_() >> 6, r_ = lane_ & 31, h_ = lane_ >> 5; \
    _Pragma("unroll") for (int i_ = 0; i_ < 2; ++i_)                                 \
    _Pragma("unroll") for (int j_ = 0; j_ < NJ_; ++j_)                               \
    _Pragma("unroll") for (int e_ = 0; e_ < 16; ++e_) {                              \
      const int row = m0 + (w_ & 1) * 64 + i_ * 32 + crow(e_, h_);                  \
      const int col = n0 + (w_ >> 1) * 32 * NJ_ + j_ * 32 + r_;                     \
      body                                                                          \
    }                                                                               \
  }
#define EPI_LOOP(body) EPI_LOOP_N(2, body)

DI void gemm_in_item(const Params& p, int item, char* sm) {
  const int m0 = (item % 48) * 128, n0 = (item / 48) * 128;
  f32x16 acc[2][2];
  zero_acc<2>(acc);
  gemm_core<2, false>((const u16*)(p.ws + WS_H), 1024, (const u16*)(p.ws + WS_WIN), 1024, 1024, m0, n0, INW, acc, (u16*)sm);
  u16* z = (u16*)(p.ws + WS_Z);
  EPI_LOOP(if (col < INW) z[(size_t)row * INW + col] = f2bf(acc[i_][j_][e_]);)
}
DI void gemm_branch_item(const Params& p, int item, char* sm) {
  const int m0 = (item % 48) * 128, n0 = (item / 48) * 64;
  f32x16 tot[2][1], acc[2][1];
  zero_acc<1>(tot);
  zero_acc<1>(acc);
  gemm_core<1, true>((const u16*)(p.ws + WS_YCAT), 1024, (const u16*)(p.ws + WS_WBR), 1024, 1024, m0, n0, 1024, acc, (u16*)sm,
                     (const u16*)(p.ws + WS_Z) + Z_ML, tot);
  u16* mix = (u16*)(p.ws + WS_MIX);
  EPI_LOOP_N(1, mix[(size_t)row * 1024 + col] = f2bf(tot[i_][j_][e_]);)
}
DI void gemm_out_item(const Params& p, int l, int item, char* sm, bool dry) {
  const int m0 = (item % 48) * 128, n0 = (item / 48) * 128;
  f32x16 acc[2][2];
  zero_acc<2>(acc);
  gemm_core<2, false>((const u16*)(p.ws + WS_MIX), 1024, (const u16*)(p.ws + WS_WOUT), 1024, 1024, m0, n0, 1024, acc, (u16*)sm);
  const float* g1 = (const float*)(p.ws + WS_MOD) + (l * 3 + tok_cond(m0)) * 6144 + 2048;
  EPI_LOOP(const float xo = xin_row(p, l, row)[col]; const float xn = xo + g1[col] * acc[i_][j_][e_]; if (!dry) p.out[(size_t)row * DM + col] = xn;)
}
DI void gemm_up_item(const Params& p, int item, char* sm) {
  const int m0 = (item % 48) * 128, n0 = (item / 48) * 128;
  f32x16 acc[2][2];
  zero_acc<2>(acc);
  gemm_core<2, false>((const u16*)(p.ws + WS_H), 1024, (const u16*)(p.ws + WS_WUP), 1024, 1024, m0, n0, DFF2, acc, (u16*)sm);
  u16* u = (u16*)(p.ws + WS_Z);
  EPI_LOOP(u[(size_t)row * DFF2 + col] = f2bf(acc[i_][j_][e_]);)
}
DI void gemm_down_item(const Params& p, int l, int item, char* sm, bool dry) {
  const int m0 = (item % 48) * 128, n0 = (item / 48) * 128;
  f32x16 acc[2][2];
  zero_acc<2>(acc);
  gemm_core<2, false>((const u16*)(p.ws + WS_ACT), DFF, (const u16*)(p.ws + WS_WDN), DFF, DFF, m0, n0, 1024, acc, (u16*)sm);
  const float* g2 = (const float*)(p.ws + WS_MOD) + (l * 3 + tok_cond(m0)) * 6144 + 5120;
  EPI_LOOP(float* xp = p.out + (size_t)row * DM + col; const float xn = *xp + g2[col] * acc[i_][j_][e_]; if (!dry) *xp = xn;)
}

DI void conv_act(const Params& p, int l, int gid, int gstride) {
  const u16* u = (const u16*)(p.ws + WS_Z);
  u16* act = (u16*)(p.ws + WS_ACT);
  const float* cw = p.conv_w + (size_t)l * 3 * DFF2;
  const float* cb = p.conv_b + (size_t)l * DFF2;
  for (int idx = gid; idx < (NTOK / 4) * 352; idx += gstride) {
    const int tok0 = (idx / 352) * 4, c0 = (idx % 352) * 8;
    int pos, L;
    if (tok0 < NCTX) { pos = tok0 & 255; L = 256; } else { pos = (tok0 - NCTX) & 1023; L = 1024; }
    u32x4 ua[6], ug[6];
#pragma unroll
    for (int d = 0; d < 6; ++d) {
      const int pp = pos + d - 1;
      if (pp >= 0 && pp < L) {
        const u16* ur = u + (size_t)(tok0 + d - 1) * DFF2;
        ua[d] = *(const u32x4*)(ur + c0); ug[d] = *(const u32x4*)(ur + DFF + c0);
      } else { ua[d] = u32x4{0u, 0u, 0u, 0u}; ug[d] = u32x4{0u, 0u, 0u, 0u}; }
    }
    float wa[3][8], wg[3][8], ba[8], bg[8];
#pragma unroll
    for (int d = 0; d < 3; ++d) {
      const float4 x0 = *(const float4*)(cw + d * DFF2 + c0), x1 = *(const float4*)(cw + d * DFF2 + c0 + 4);
      const float4 y0 = *(const float4*)(cw + d * DFF2 + DFF + c0), y1 = *(const float4*)(cw + d * DFF2 + DFF + c0 + 4);
      wa[d][0] = x0.x; wa[d][1] = x0.y; wa[d][2] = x0.z; wa[d][3] = x0.w; wa[d][4] = x1.x; wa[d][5] = x1.y; wa[d][6] = x1.z; wa[d][7] = x1.w;
      wg[d][0] = y0.x; wg[d][1] = y0.y; wg[d][2] = y0.z; wg[d][3] = y0.w; wg[d][4] = y1.x; wg[d][5] = y1.y; wg[d][6] = y1.z; wg[d][7] = y1.w;
    }
    {
      const float4 x0 = *(const float4*)(cb + c0), x1 = *(const float4*)(cb + c0 + 4);
      const float4 y0 = *(const float4*)(cb + DFF + c0), y1 = *(const float4*)(cb + DFF + c0 + 4);
      ba[0] = x0.x; ba[1] = x0.y; ba[2] = x0.z; ba[3] = x0.w; ba[4] = x1.x; ba[5] = x1.y; ba[6] = x1.z; ba[7] = x1.w;
      bg[0] = y0.x; bg[1] = y0.y; bg[2] = y0.z; bg[3] = y0.w; bg[4] = y1.x; bg[5] = y1.y; bg[6] = y1.z; bg[7] = y1.w;
    }
#pragma unroll
    for (int tt = 0; tt < 4; ++tt) {
      u32x4 o;
#pragma unroll
      for (int q = 0; q < 4; ++q) {
        float a0 = ba[2 * q], a1 = ba[2 * q + 1], g0 = bg[2 * q], g1 = bg[2 * q + 1];
#pragma unroll
        for (int d = 0; d < 3; ++d) {
          a0 += wa[d][2 * q] * lo_bf(ua[tt + d][q]); a1 += wa[d][2 * q + 1] * hi_bf(ua[tt + d][q]);
          g0 += wg[d][2 * q] * lo_bf(ug[tt + d][q]); g1 += wg[d][2 * q + 1] * hi_bf(ug[tt + d][q]);
        }
        o[q] = pack2(g0 * sigmoidf_(g0) * a0, g1 * sigmoidf_(g1) * a1);
      }
      *(u32x4*)(act + (size_t)(tok0 + tt) * DFF + c0) = o;
    }
  }
}

DI void prep_wave(const Params& p, int l, int item) {
  const int lane = tid_() & 63;
  char* ws = p.ws;
  u16* qA = (u16*)(ws + WS_QA); u16* qC = (u16*)(ws + WS_QC);
  u16* kA = (u16*)(ws + WS_KA); u16* vA = (u16*)(ws + WS_VA);
  u16* kC = (u16*)(ws + WS_KC); u16* vC = (u16*)(ws + WS_VC);
  if (item >= NTOK) {
    const int cr = item - NTOK, b = cr >> 9, key = cr & 511;
    const size_t keyrow = 4096 + b * 1536 + key;
    const size_t srow = (size_t)(b * 2 + l) * 512 + key;
    float v[12];
#pragma unroll
    for (int u = 0; u < 12; ++u) {
      if (u < 2) v[u] = p.cache_a_k[srow * 128 + u * 64 + lane];
      else if (u < 4) v[u] = p.cache_a_v[srow * 128 + (u - 2) * 64 + lane];
      else if (u < 8) v[u] = p.cache_c_k[srow * 256 + (u - 4) * 64 + lane];
      else v[u] = p.cache_c_v[srow * 256 + (u - 8) * 64 + lane];
    }
#pragma unroll
    for (int u = 0; u < 12; ++u) {
      if (u < 2) kA[keyrow * 128 + u * 64 + lane] = f2bf(v[u]);
      else if (u < 4) vA[keyrow * 128 + (u - 2) * 64 + lane] = f2bf(v[u]);
      else if (u < 8) kC[keyrow * 256 + (u - 4) * 64 + lane] = f2bf(v[u]);
      else vC[keyrow * 256 + (u - 8) * 64 + lane] = f2bf(v[u]);
    }
    return;
  }
  const int tok = item;
  const bool sample = tok >= NCTX;
  int b, pos;
  size_t keyrow;
  if (!sample) { b = tok >> 8; pos = tok & 255; keyrow = tok; }
  else { b = (tok - NCTX) >> 10; pos = (tok - NCTX) & 1023; keyrow = 4096 + b * 1536 + 512 + pos; }
  const size_t crow_o = (size_t)(b * 2 + l) * 256 + pos;
  const u16* zr = (const u16*)(ws + WS_Z) + (size_t)tok * INW;
  const float rowp = (float)(pos >> 6), colp = (float)(pos & 63);
  u16 raw[20];
#pragma unroll
  for (int u = 0; u < 20; ++u) raw[u] = zr[u * 64 + lane];
  float cosA = 1.f, sinA = 0.f, cosC = 1.f, sinC = 0.f;
  if (sample) {
    {
      const int a = lane >> 5, i = lane & 15;
      const float ang = (a ? colp : rowp) * exp2f(-(float)i * (0.0625f * 13.287712379549449f));
      cosA = __cosf(ang); sinA = __sinf(ang);
      if (!((lane >> 4) & 1)) sinA = -sinA;
    }
    {
      const int dd = lane & 31, a = dd >> 4, i = dd & 7;
      const float ang = (a ? colp : rowp) * exp2f(-(float)i * (0.125f * 13.287712379549449f));
      cosC = __cosf(ang); sinC = __sinf(ang);
      if (!((dd >> 3) & 1)) sinC = -sinC;
    }
  }
  const float gaq = p.a_qn_g[l * 64 + lane], gak = p.a_kn_g[l * 64 + lane];
  const float gcq = p.c_qn_g[l * 32 + (lane & 31)], gck = p.c_kn_g[l * 32 + (lane & 31)];
#pragma unroll
  for (int u = 0; u < 20; ++u) {
    const float x = bf2f(raw[u]);
    if (u < 6) {
      const bool isq = u < 4;
      const int hd = isq ? u : u - 4;
      const float ss = wave_sum(x * x);
      float y = x * rsqrtf(ss * (1.f / 64.f) + EPSN) * (isq ? gaq : gak);
      if (!sample && !isq) p.out[O_CAK + crow_o * 128 + hd * 64 + lane] = y;
      if (sample) { const float pr = __shfl_xor(y, 16); y = y * cosA + pr * sinA; }
      if (isq) qA[(size_t)tok * 256 + hd * 64 + lane] = f2bf(y);
      else kA[keyrow * 128 + hd * 64 + lane] = f2bf(y);
    } else if (u < 8) {
      const int hd = u - 6;
      if (!sample) p.out[O_CAV + crow_o * 128 + hd * 64 + lane] = x;
      vA[keyrow * 128 + hd * 64 + lane] = raw[u];
    } else if (u < 16) {
      const bool isq = u < 12;
      const int pr2 = isq ? u - 8 : u - 12;
      float ss = x * x;
#pragma unroll
      for (int o = 16; o >= 1; o >>= 1) ss += __shfl_xor(ss, o);
      float y = x * rsqrtf(ss * (1.f / 32.f) + EPSN) * (isq ? gcq : gck);
      if (!sample && !isq) p.out[O_CCK + crow_o * 256 + pr2 * 64 + lane] = y;
      if (sample) { const float pr = __shfl_xor(y, 8); y = y * cosC + pr * sinC; }
      if (isq) qC[(size_t)tok * 256 + pr2 * 64 + lane] = f2bf(y);
      else kC[keyrow * 256 + pr2 * 64 + lane] = f2bf(y);
    } else {
      const int hd = u - 16;
      if (!sample) p.out[O_CCV + crow_o * 256 + hd * 64 + lane] = x;
      vC[keyrow * 256 + hd * 64 + lane] = raw[u];
    }
  }
}

template <bool ISC>
DI void attn_item(const Params& p, int l, int tok0, int keyrow0, int nkeys, int head, char* smraw) {
  constexpr int NM = ISC ? 2 : 1;
  u16* Ks = (u16*)smraw;
  u16* Vs = Ks + 2 * 64 * 72;
  const u16* qbuf = (const u16*)(p.ws + (ISC ? WS_QC : WS_QA));
  const u16* kbuf = (const u16*)(p.ws + (ISC ? WS_KC : WS_KA));
  const u16* vbuf = (const u16*)(p.ws + (ISC ? WS_VC : WS_VA));
  const int kstride = ISC ? 256 : 128;
  const int koff = ISC ? head * 64 : (head >> 1) * 64;
  const float c2 = (ISC ? 0.17677669529663687f : 0.125f) * 1.4426950408889634f;
  const int t = tid_(), lane = t & 63, w = t >> 6, r = lane & 31, h = lane >> 5;
  const int i16 = lane & 15, tq = i16 >> 2, tp = i16 & 3, blk = (lane >> 4) & 1;
  bf16x8 qf[4];
  {
    const u16* qp = qbuf + (size_t)(tok0 + 32 * w + r) * 256 + head * 64 + 8 * h;
#pragma unroll
    for (int s = 0; s < 4; ++s) qf[s] = *(const bf16x8*)(qp + 16 * s);
  }
  f32x16 O[NM][2];
  float mrun[NM], lsum[NM];
#pragma unroll
  for (int m = 0; m < NM; ++m) {
    mrun[m] = -INFINITY; lsum[m] = 0.f;
#pragma unroll
    for (int d = 0; d < 2; ++d)
#pragma unroll
      for (int e = 0; e < 16; ++e) O[m][d][e] = 0.f;
  }
  const int lrow = t >> 3, lc8 = (t & 7) * 8;
  const u16* kg = kbuf + (size_t)(keyrow0 + lrow) * kstride + koff + lc8;
  const u16* vg = vbuf + (size_t)(keyrow0 + lrow) * kstride + koff + lc8;
  u32x4 rk[2], rv[2];
#pragma unroll
  for (int i = 0; i < 2; ++i) { rk[i] = *(const u32x4*)(kg + (size_t)(32 * i) * kstride); rv[i] = *(const u32x4*)(vg + (size_t)(32 * i) * kstride); }
#pragma unroll
  for (int i = 0; i < 2; ++i) {
    *(u32x4*)(Ks + (lrow + 32 * i) * 72 + lc8) = rk[i];
    *(u32x4*)(Vs + (lrow + 32 * i) * 72 + lc8) = rv[i];
  }
  __syncthreads();
  const int NT = nkeys >> 6;
  for (int kt = 0; kt < NT; ++kt) {
    const int buf = kt & 1;
    if (kt + 1 < NT) {
#pragma unroll
      for (int i = 0; i < 2; ++i) {
        rk[i] = *(const u32x4*)(kg + (size_t)((kt + 1) * 64 + 32 * i) * kstride);
        rv[i] = *(const u32x4*)(vg + (size_t)((kt + 1) * 64 + 32 * i) * kstride);
      }
    }
    const u16* kb_ = Ks + buf * 64 * 72;
    const u16* vb_ = Vs + buf * 64 * 72;
#pragma unroll
    for (int kb = 0; kb < 2; ++kb) {
      f32x16 S[NM];
#pragma unroll
      for (int m = 0; m < NM; ++m)
#pragma unroll
        for (int e = 0; e < 16; ++e) S[m][e] = 0.f;
#pragma unroll
      for (int s = 0; s < 4; ++s) {
        const int m = ISC ? (s >> 1) : 0;
        const bf16x8 kf = *(const bf16x8*)(kb_ + (kb * 32 + r) * 72 + 16 * s + 8 * h);
        S[m] = MFMA(kf, qf[s], S[m]);
      }
#pragma unroll
      for (int m = 0; m < NM; ++m) {
        float mx = S[m][0];
#pragma unroll
        for (int e = 1; e < 16; ++e) mx = fmaxf(mx, S[m][e]);
        mx = fmaxf(mx, __shfl_xor(mx, 32));
        const float mnew = fmaxf(mrun[m], mx);
        const float alpha = exp2f((mrun[m] - mnew) * c2);
        mrun[m] = mnew;
        const float mc = mnew * c2;
        float ps = 0.f;
#pragma unroll
        for (int e = 0; e < 16; ++e) { const float pe = exp2f(S[m][e] * c2 - mc); S[m][e] = pe; ps += pe; }
        lsum[m] = lsum[m] * alpha + ps;
        if (__any(alpha != 1.f)) {
#pragma unroll
          for (int d = 0; d < 2; ++d)
#pragma unroll
            for (int e = 0; e < 16; ++e) O[m][d][e] *= alpha;
        }
      }
#pragma unroll
      for (int st = 0; st < 2; ++st) {
        bf16x8 pf[NM];
#pragma unroll
        for (int m = 0; m < NM; ++m) pf[m] = pack8(S[m], st);
#pragma unroll
        for (int d = 0; d < 2; ++d) {
          const u16* vp = vb_ + (kb * 32 + 16 * st + 4 * h + tq) * 72 + d * 32 + 16 * blk + 4 * tp;
          const bf16x8 vf = trpair(vp, vp + 8 * 72);
#pragma unroll
          for (int m = 0; m < NM; ++m) O[m][d] = MFMA(vf, pf[m], O[m][d]);
        }
      }
    }
    if (kt + 1 < NT) {
      const int nb = (buf ^ 1) * 64 * 72;
#pragma unroll
      for (int i = 0; i < 2; ++i) {
        *(u32x4*)(Ks + nb + (lrow + 32 * i) * 72 + lc8) = rk[i];
        *(u32x4*)(Vs + nb + (lrow + 32 * i) * 72 + lc8) = rv[i];
      }
    }
    __syncthreads();
  }
  float inv[NM];
#pragma unroll
  for (int m = 0; m < NM; ++m) { const float lt = lsum[m] + __shfl_xor(lsum[m], 32); inv[m] = 1.f / lt; }
  const int tok = tok0 + 32 * w + r;
  u16* yc = (u16*)(p.ws + WS_YCAT) + (size_t)tok * 1024;
  if (!ISC) {
#pragma unroll
    for (int d = 0; d < 2; ++d)
#pragma unroll
      for (int g = 0; g < 4; ++g) {
        u32x2 q;
        q[0] = pack2(O[0][d][4 * g] * inv[0], O[0][d][4 * g + 1] * inv[0]);
        q[1] = pack2(O[0][d][4 * g + 2] * inv[0], O[0][d][4 * g + 3] * inv[0]);
        *(u32x2*)(yc + head * 64 + d * 32 + 8 * g + 4 * h) = q;
      }
  } else {
    const float* cl = p.c_lambda + l * 128;
    float d1 = 0.f, d2 = 0.f;
    for (int i = 0; i < 32; ++i) { d1 += cl[i] * cl[32 + i]; d2 += cl[64 + i] * cl[96 + i]; }
    const float lam_init = 0.8f - 0.6f * __expf(-0.3f * (float)l);
    const float lam = __expf(d1) - __expf(d2) + lam_init;
    float ss = 0.f;
#pragma unroll
    for (int d = 0; d < 2; ++d)
#pragma unroll
      for (int e = 0; e < 16; ++e) {
        const float dv = O[0][d][e] * inv[0] - lam * (O[NM - 1][d][e] * inv[NM - 1]);
        O[0][d][e] = dv; ss += dv * dv;
      }
    ss += __shfl_xor(ss, 32);
    const float sc = rsqrtf(ss * (1.f / 64.f) + EPSN) * (1.f - lam_init);
    const float* sg = p.c_subln_g + l * 64;
#pragma unroll
    for (int d = 0; d < 2; ++d)
#pragma unroll
      for (int g = 0; g < 4; ++g) {
        const int dv0 = d * 32 + 8 * g + 4 * h;
        u32x2 q;
        q[0] = pack2(O[0][d][4 * g] * sc * sg[dv0], O[0][d][4 * g + 1] * sc * sg[dv0 + 1]);
        q[1] = pack2(O[0][d][4 * g + 2] * sc * sg[dv0 + 2], O[0][d][4 * g + 3] * sc * sg[dv0 + 3]);
        *(u32x2*)(yc + 512 + head * 64 + dv0) = q;
      }
  }
}
DI void attn_dispatch(const Params& p, int l, int item, char* sm) {
  if (item < 128) {
    const int j = item & 63, b = j >> 5, qb = (j >> 2) & 7, head = j & 3;
    const int tok0 = NCTX + b * 1024 + qb * 128, kr0 = 4096 + b * 1536;
    if (item < 64) attn_item<true>(p, l, tok0, kr0, 1536, head, sm);
    else attn_item<false>(p, l, tok0, kr0, 1536, head, sm);
  } else {
    const int j = (item - 128) & 127, s = j >> 3, qb = (j >> 2) & 1, head = j & 3;
    const int tok0 = s * 256 + qb * 128, kr0 = s * 256;
    if (item < 256) attn_item<true>(p, l, tok0, kr0, 256, head, sm);
    else attn_item<false>(p, l, tok0, kr0, 256, head, sm);
  }
}

template <bool GLA>
struct ScanCtx { float wa[16]; float ba, lbm, oml; int ldir; };
template <bool GLA>
DI void scan_init(const Params& p, int l, int head, int dirh, int lane, ScanCtx<GLA>& cx) {
  const int ldir = GLA ? (lane >> 5) : dirh;
  cx.ldir = ldir;
  if (GLA) {
    const int kc = lane & 31;
#pragma unroll
    for (int j = 0; j < 16; ++j) cx.wa[j] = p.d_alpha_w[((size_t)(l * 2 + ldir) * 16 + j) * 128 + head * 32 + kc];
    cx.ba = p.d_alpha_b[(l * 2 + ldir) * 128 + head * 32 + kc];
  } else {
    float lb = 0.f;
    if (l > 0) {
      const float x0 = p.b_lb_logits[(ldir * 2 + 0) * 256 + head * 64 + lane], x1 = p.b_lb_logits[(ldir * 2 + 1) * 256 + head * 64 + lane];
      lb = 1.f / (1.f + __expf(x0 - x1));
    }
    cx.lbm = fmaxf(lb, 1e-30f); cx.oml = 1.f - lb;
  }
}
template <bool GLA>
DI float scan_la(const ScanCtx<GLA>& cx, const u16* kraw, const u16* rt, int pp, int lane, float& kk) {
  if (GLA) {
    const u32x4 r0 = *(const u32x4*)(rt + pp * 32 + cx.ldir * 16), r1 = *(const u32x4*)(rt + pp * 32 + cx.ldir * 16 + 8);
    float v = cx.ba;
#pragma unroll
    for (int q = 0; q < 4; ++q) {
      v += cx.wa[2 * q] * lo_bf(r0[q]) + cx.wa[2 * q + 1] * hi_bf(r0[q]);
      v += cx.wa[8 + 2 * q] * lo_bf(r1[q]) + cx.wa[8 + 2 * q + 1] * hi_bf(r1[q]);
    }
    kk = bf2f(kraw[pp * 72 + lane]);
    return (fminf(v, 0.f) - __logf(1.f + __expf(-fabsf(v)))) * (1.f / 16.f);
  } else {
    const float zz = bf2f(kraw[pp * 72 + lane]);
    const float sig = 1.f / (1.f + __expf(-zz));
    kk = cx.oml / (1.f + __expf(zz));
    return __logf(cx.lbm + cx.oml * sig);
  }
}
DI void stage64(u16* dst, const u16* z, int start, int col, int lane) {
  u32x4 v[4];
#pragma unroll
  for (int i = 0; i < 4; ++i) v[i] = *(const u32x4*)(z + (size_t)(start + (lane >> 3) + 8 * i) * INW + col + (lane & 7) * 8);
#pragma unroll
  for (int i = 0; i < 4; ++i) *(u32x4*)(dst + ((lane >> 3) + 8 * i) * 72 + (lane & 7) * 8) = v[i];
}
DI void stage32dup(u16* dst, const u16* z, int start, int col, int lane) {
  const int row = lane >> 1, c16 = (lane & 1) * 16;
  const u16* sp = z + (size_t)(start + row) * INW + col + c16;
  const u32x4 v0 = *(const u32x4*)sp, v1 = *(const u32x4*)(sp + 8);
  *(u32x4*)(dst + row * 72 + c16) = v0; *(u32x4*)(dst + row * 72 + c16 + 8) = v1;
  *(u32x4*)(dst + row * 72 + 32 + c16) = v0; *(u32x4*)(dst + row * 72 + 32 + c16 + 8) = v1;
}
DI void stage_r(u16* rt, const u16* z, int start, int lane) {
  const int row = lane >> 1, c16 = (lane & 1) * 16;
  const u16* sp = z + (size_t)(start + row) * INW + ZD_RF + c16;
  const u32x4 v0 = *(const u32x4*)sp, v1 = *(const u32x4*)(sp + 8);
  *(u32x4*)(rt + row * 32 + c16) = v0; *(u32x4*)(rt + row * 32 + c16 + 8) = v1;
}
DI int tile_id(bool gla, int chunk, int head, int dir) { return gla ? 1536 + chunk * 4 + head : (chunk * 4 + head) * 2 + dir; }

constexpr int S1_WAVE_U16 = 2 * 32 * 72 + 32 * 32;
template <bool GLA>
DI void scan_s1(const Params& p, int l, int chunk, int head, int dir, u16* smw) {
  const int lane = tid_() & 63, r = lane & 31, h = lane >> 5;
  const int i16 = lane & 15, tq = i16 >> 2, tp = i16 & 3, blk = (lane >> 4) & 1;
  u16* ko = smw;
  u16* vt = smw + 32 * 72;
  u16* rt = smw + 2 * 32 * 72;
  const int start = chunk * 32;
  const u16* z = (const u16*)(p.ws + WS_Z);
  stage64(vt, z, start, (GLA ? ZD_V : ZB_I) + head * 64, lane);
  if (GLA) { stage32dup(ko, z, start, ZD_K + head * 32, lane); stage_r(rt, z, start, lane); }
  else stage64(ko, z, start, (dir ? ZB_FB : ZB_FF) + head * 64, lane);
  ScanCtx<GLA> cx;
  scan_init<GLA>(p, l, head, dir, lane, cx);
  __syncthreads();
  {
    const int ldir = cx.ldir;
    float cl = 0.f, kk;
#pragma unroll 8
    for (int i = 0; i < 32; ++i) cl += scan_la<GLA>(cx, ko, rt, ldir ? 31 - i : i, lane, kk);
    float cum = 0.f;
#pragma unroll 8
    for (int i = 0; i < 32; ++i) {
      const int pp = ldir ? 31 - i : i;
      cum += scan_la<GLA>(cx, ko, rt, pp, lane, kk);
      ko[pp * 72 + lane] = f2bf(kk * __expf(cl - cum));
    }
    ((float*)(p.ws + WS_CL))[tile_id(GLA, chunk, head, dir) * 64 + lane] = cl;
  }
  __syncthreads();
  f32x16 acc[2][2];
  zero_acc<2>(acc);
#pragma unroll
  for (int st = 0; st < 2; ++st) {
    bf16x8 a[2], b[2];
#pragma unroll
    for (int x = 0; x < 2; ++x) {
      const u16* ap = vt + (16 * st + 8 * h + tq) * 72 + x * 32 + 16 * blk + 4 * tp;
      a[x] = trpair(ap, ap + 4 * 72);
      const u16* bp = ko + (16 * st + 8 * h + tq) * 72 + x * 32 + 16 * blk + 4 * tp;
      b[x] = trpair(bp, bp + 4 * 72);
    }
#pragma unroll
    for (int x = 0; x < 2; ++x)
#pragma unroll
      for (int y = 0; y < 2; ++y) acc[x][y] = MFMA(a[x], b[y], acc[x][y]);
  }
  {
    float* U = (float*)(p.ws + WS_U) + (size_t)tile_id(GLA, chunk, head, dir) * 4096;
#pragma unroll
    for (int x = 0; x < 2; ++x)
#pragma unroll
      for (int y = 0; y < 2; ++y)
#pragma unroll
        for (int e = 0; e < 16; ++e) U[(x * 32 + crow(e, h)) * 64 + y * 32 + r] = acc[x][y][e];
  }
  __syncthreads();
}
DI void scan_s1_block(const Params& p, int l, int bitem, char* sm) {
  const int w = tid_() >> 6;
  int wi = bitem * 4 + w;
  u16* smw = (u16*)sm + w * S1_WAVE_U16;
  if (bitem < 384) scan_s1<false>(p, l, wi >> 3, (wi >> 1) & 3, wi & 1, smw);
  else { wi -= 1536; scan_s1<true>(p, l, wi >> 2, wi & 3, 0, smw); }
}

DI void scan_s2_item(const Params& p, int l, int item) {
  const int t = tid_();
  const int unit = item >> 2, vq = item & 3;
  const bool gla = unit >= 144;
  int seq, head, dir;
  if (!gla) { seq = unit >> 3; head = (unit >> 1) & 3; dir = unit & 1; }
  else { const int g = unit - 144; seq = g >> 2; head = g & 3; dir = 0; }
  const int c = t & 63;
  const int dc = gla ? (c >> 5) : dir;
  int N, chunk0;
  if (seq < 16) { N = 8; chunk0 = seq * 8; } else { N = 32; chunk0 = 128 + (seq - 16) * 32; }
  float S[4];
  int vv[4];
#pragma unroll
  for (int i = 0; i < 4; ++i) {
    vv[i] = vq * 16 + (t >> 6) + 4 * i;
    if (seq < 16) S[i] = 0.f;
    else {
      const int b = seq - 16;
      S[i] = gla ? p.state_gla[(size_t)(((b * 2 + l) * 2 + dc) * 4 + head) * 2048 + (c & 31) * 64 + vv[i]]
                 : p.state_hgrn[(size_t)(((b * 2 + l) * 2 + dc) * 4 + head) * 4096 + c * 64 + vv[i]];
    }
  }
  const float* __restrict__ U = (const float*)(p.ws + WS_U);
  const float* __restrict__ CL = (const float*)(p.ws + WS_CL);
  float* __restrict__ SS = (float*)(p.ws + WS_S);
  for (int m0 = 0; m0 < N; m0 += 4) {
    float tmp[4][4], a[4];
    int ids[4];
#pragma unroll
    for (int mm = 0; mm < 4; ++mm) {
      const int m = m0 + mm;
      ids[mm] = tile_id(gla, chunk0 + (dc ? N - 1 - m : m), head, dir);
      a[mm] = CL[ids[mm] * 64 + c];
#pragma unroll
      for (int i = 0; i < 4; ++i) tmp[mm][i] = U[(size_t)ids[mm] * 4096 + vv[i] * 64 + c];
    }
#pragma unroll
    for (int mm = 0; mm < 4; ++mm) {
      const float ea = __expf(a[mm]);
#pragma unroll
      for (int i = 0; i < 4; ++i) {
        SS[(size_t)ids[mm] * 4096 + vv[i] * 64 + c] = S[i];
        S[i] = ea * S[i] + tmp[mm][i];
      }
    }
  }
  if (seq < 16) {
#pragma unroll
    for (int i = 0; i < 4; ++i) {
      if (gla) p.out[O_SG + (size_t)(((seq * 2 + l) * 2 + dc) * 4 + head) * 2048 + (c & 31) * 64 + vv[i]] = S[i];
      else p.out[O_SH + (size_t)(((seq * 2 + l) * 2 + dc) * 4 + head) * 4096 + c * 64 + vv[i]] = S[i];
    }
  }
}

constexpr int S3_WAVE_U16 = 3 * 32 * 72 + 128 + 32 * 32;
template <bool GLA>
DI void scan_s3(const Params& p, int l, int chunk, int head, u16* smw) {
  const int lane = tid_() & 63, r = lane & 31, h = lane >> 5;
  const int i16 = lane & 15, tq = i16 >> 2, tp = i16 & 3, blk = (lane >> 4) & 1;
  u16* qt = smw;
  u16* kt = smw + 32 * 72;
  u16* vt = smw + 2 * 32 * 72;
  float* sref = (float*)(smw + 3 * 32 * 72);
  u16* rt = smw + 3 * 32 * 72 + 128;
  const int start = chunk * 32;
  const u16* z = (const u16*)(p.ws + WS_Z);
  stage64(vt, z, start, (GLA ? ZD_V : ZB_I) + head * 64, lane);
  if (GLA) stage_r(rt, z, start, lane);
  f32x16 o[2];
#pragma unroll
  for (int x = 0; x < 2; ++x)
#pragma unroll
    for (int e = 0; e < 16; ++e) o[x][e] = 0.f;
  constexpr int NPASS = GLA ? 1 : 2;
#pragma unroll 1
  for (int pass = 0; pass < NPASS; ++pass) {
    if (GLA) { stage32dup(qt, z, start, ZD_Q + head * 32, lane); stage32dup(kt, z, start, ZD_K + head * 32, lane); }
    else { stage64(qt, z, start, ZB_Q + head * 64, lane); stage64(kt, z, start, (pass ? ZB_FB : ZB_FF) + head * 64, lane); }
    const float* Sg = (const float*)(p.ws + WS_S) + (size_t)tile_id(GLA, chunk, head, pass) * 4096;
    ScanCtx<GLA> cx;
    scan_init<GLA>(p, l, head, pass, lane, cx);
    __syncthreads();
    {
      const int ldir = cx.ldir;
      float ref = 0.f, kk, cum = 0.f;
#pragma unroll 8
      for (int i = 0; i < 16; ++i) ref += scan_la<GLA>(cx, kt, rt, ldir ? 31 - i : i, lane, kk);
      sref[lane] = __expf(ref);
#pragma unroll 8
      for (int i = 0; i < 32; ++i) {
        const int pp = ldir ? 31 - i : i;
        cum += scan_la<GLA>(cx, kt, rt, pp, lane, kk);
        const float zq = bf2f(qt[pp * 72 + lane]);
        const float qv = GLA ? zq * 0.17677669529663687f : zq * sigmoidf_(zq);
        qt[pp * 72 + lane] = f2bf(qv * __expf(cum - ref));
        kt[pp * 72 + lane] = f2bf(kk * __expf(ref - cum));
      }
    }
    __syncthreads();
    constexpr int NS = GLA ? 2 : 1;
    f32x16 sc[NS];
#pragma unroll
    for (int m = 0; m < NS; ++m)
#pragma unroll
      for (int e = 0; e < 16; ++e) sc[m][e] = 0.f;
    bf16x8 qfr[4];
#pragma unroll
    for (int st = 0; st < 4; ++st) {
      qfr[st] = *(const bf16x8*)(qt + r * 72 + 16 * st + 8 * h);
      const bf16x8 kf = *(const bf16x8*)(kt + r * 72 + 16 * st + 8 * h);
      const int m = GLA ? (st >> 1) : 0;
      sc[m] = MFMA(kf, qfr[st], sc[m]);
    }
#pragma unroll
    for (int m = 0; m < NS; ++m) {
      const int d = GLA ? m : pass;
#pragma unroll
      for (int e = 0; e < 16; ++e) {
        const int srow = crow(e, h);
        const bool keep = d ? (srow >= r) : (srow <= r);
        sc[m][e] = keep ? sc[m][e] : 0.f;
      }
#pragma unroll
      for (int st = 0; st < 2; ++st) {
        const bf16x8 pf = pack8(sc[m], st);
#pragma unroll
        for (int x = 0; x < 2; ++x) {
          const u16* vp = vt + (16 * st + 4 * h + tq) * 72 + x * 32 + 16 * blk + 4 * tp;
          const bf16x8 vf = trpair(vp, vp + 8 * 72);
          o[x] = MFMA(vf, pf, o[x]);
        }
      }
    }
#pragma unroll
    for (int x = 0; x < 2; ++x) {
      float4 s0[4], s1[4];
#pragma unroll
      for (int st = 0; st < 4; ++st) {
        const float* sp = Sg + (x * 32 + r) * 64 + 16 * st + 8 * h;
        s0[st] = *(const float4*)sp; s1[st] = *(const float4*)(sp + 4);
      }
#pragma unroll
      for (int st = 0; st < 4; ++st) {
        const float4 e0 = *(const float4*)(sref + 16 * st + 8 * h), e1 = *(const float4*)(sref + 16 * st + 8 * h + 4);
        u32x4 q;
        q[0] = pack2(s0[st].x * e0.x, s0[st].y * e0.y); q[1] = pack2(s0[st].z * e0.z, s0[st].w * e0.w);
        q[2] = pack2(s1[st].x * e1.x, s1[st].y * e1.y); q[3] = pack2(s1[st].z * e1.z, s1[st].w * e1.w);
        o[x] = MFMA(__builtin_bit_cast(bf16x8, q), qfr[st], o[x]);
      }
    }
    __syncthreads();
  }
  float ss = 0.f;
#pragma unroll
  for (int x = 0; x < 2; ++x)
#pragma unroll
    for (int e = 0; e < 16; ++e) ss += o[x][e] * o[x][e];
  ss += __shfl_xor(ss, 32);
  const float rstd = rsqrtf(ss * (1.f / 64.f) + EPSN);
  const int tok = start + r;
  const float* gn = (GLA ? p.d_norm_g : p.b_norm_g) + l * 64;
  const u16* gz = z + (size_t)tok * INW + (GLA ? ZD_G : ZB_G) + head * 64;
  u16* yc = (u16*)(p.ws + WS_YCAT) + (size_t)tok * 1024 + (GLA ? 768 : 256) + head * 64;
#pragma unroll
  for (int x = 0; x < 2; ++x)
#pragma unroll
    for (int g = 0; g < 4; ++g) {
      const int v0 = x * 32 + 8 * g + 4 * h;
      const u32x2 gr = *(const u32x2*)(gz + v0);
      const float g0 = lo_bf(gr[0]), g1 = hi_bf(gr[0]), g2 = lo_bf(gr[1]), g3 = hi_bf(gr[1]);
      u32x2 q;
      q[0] = pack2(o[x][4 * g] * rstd * gn[v0] * g0 * sigmoidf_(g0), o[x][4 * g + 1] * rstd * gn[v0 + 1] * g1 * sigmoidf_(g1));
      q[1] = pack2(o[x][4 * g + 2] * rstd * gn[v0 + 2] * g2 * sigmoidf_(g2), o[x][4 * g + 3] * rstd * gn[v0 + 3] * g3 * sigmoidf_(g3));
      *(u32x2*)(yc + v0) = q;
    }
}
DI void scan_s3_block(const Params& p, int l, int bitem, char* sm) {
  const int w = tid_() >> 6;
  u16* smw = (u16*)sm + w * S3_WAVE_U16;
  int wi = bitem * 4 + w;
  if (bitem < 192) scan_s3<false>(p, l, wi >> 2, wi & 3, smw);
  else { wi -= 768; scan_s3<true>(p, l, wi >> 2, wi & 3, smw); }
}

DI void run_phase(const Params& p, int ph, char* sm, bool dry) {
  const int bid = blockIdx.x, nb = gridDim.x;
#ifdef PHASE_ONLY
  if (ph != 0 && (ph - 1) % 11 != PHASE_ONLY - 1) return;
  if (ph == 0 && PHASE_ONLY != 0) return;
#endif
  if (ph == 0) {
    for (int it = bid; it < MOD_ITEMS + CONVW_ITEMS; it += nb) {
      if (it < MOD_ITEMS) mod_item(p, it, sm); else convw_item(p, 0, it - MOD_ITEMS, sm);
    }
    return;
  }
  const int l = (ph - 1) / 11, s = (ph - 1) % 11;
  switch (s) {
    case 0: {
      const int w = tid_() >> 6;
      for (int tk = bid * 4 + w; tk < NTOK; tk += nb * 4) norm_tok(p, l, 0, tk);
      if (l > 0) for (int it = bid; it < CONVW_ITEMS; it += nb) convw_item(p, l, it, sm);
    } break;
    case 1: for (int it = bid; it < 48 * 59; it += nb) gemm_in_item(p, it, sm); break;
    case 2:
      for (int it = bid; it < 576 + 1792; it += nb) {
        if (it < 576) scan_s1_block(p, l, it, sm); else prep_wave(p, l, (it - 576) * 4 + (tid_() >> 6));
      }
      break;
    case 3:
      for (int it = bid; it < 384 + 864; it += nb) {
        if (it < 128) attn_dispatch(p, l, it, sm);
        else if (it < 128 + 864) scan_s2_item(p, l, it - 128);
        else attn_dispatch(p, l, it - 864, sm);
      }
      break;
    case 4: for (int it = bid; it < 384; it += nb) scan_s3_block(p, l, it, sm); break;
    case 5: for (int it = bid; it < 768; it += nb) gemm_branch_item(p, it, sm); break;
    case 6: for (int it = bid; it < 384; it += nb) gemm_out_item(p, l, it, sm, dry); break;
    case 7: {
      const int w = tid_() >> 6;
      for (int tk = bid * 4 + w; tk < NTOK; tk += nb * 4) norm_tok(p, l, 1, tk);
    } break;
    case 8: for (int it = bid; it < 48 * 44; it += nb) gemm_up_item(p, it, sm); break;
    case 9: conv_act(p, l, bid * 256 + tid_(), nb * 256); break;
    case 10: for (int it = bid; it < 384; it += nb) gemm_down_item(p, l, it, sm, dry); break;
  }
}

__global__ void __launch_bounds__(256, 2) fwd_mega(Params p) {
  __shared__ __attribute__((aligned(16))) char sm[SMEM_BYTES];
  __shared__ uint4 xb_words;
  cg::grid_group grid = cg::this_grid();
  if (p.coop == 2) grid.sync();
  if (__builtin_amdgcn_workitem_id_x() == 0) xb_words = make_uint4(0u, 0u, 0u, 0u);
  __syncthreads();
  XcdBarrier xb;
  if (p.coop) xb = xcd_barrier_post((unsigned*)(p.ws + WS_BAR), (volatile LAS unsigned*)&xb_words);
  for (int ph = p.phase_begin; ph < p.phase_end; ++ph) {
    if (ph > p.phase_begin && p.coop) xcd_barrier(xb);
    const int stepid = ph == 0 ? 11 : (ph - 1) % 11;
    const int reps = (stepid == p.pad - 1) ? 2 : 1;
    for (int rep = 0; rep < reps; ++rep) {
      if (rep && p.coop) xcd_barrier(xb);
      run_phase(p, ph, sm, false);
    }
  }
}

extern "C" void kernel_launch(void* const* d_in, const int* in_sizes, int n_in, void* d_out, int out_size, void* d_ws,
                              size_t ws_size, hipStream_t stream) {
  static int grid_blocks = 0;
  if (!grid_blocks) {
    int dev = 0, cus = 0, per_cu = 0;
    hipGetDevice(&dev);
    hipDeviceGetAttribute(&cus, hipDeviceAttributeMultiprocessorCount, dev);
    hipOccupancyMaxActiveBlocksPerMultiprocessor(&per_cu, fwd_mega, 256, 0);
    if (per_cu > 2) per_cu = 2;
    if (per_cu < 1) per_cu = 1;
    grid_blocks = cus * per_cu;
  }
  Params p{};
  const float** pp = (const float**)&p;
  for (int i = 0; i < 32; ++i) pp[i] = (const float*)d_in[i];
  p.out = (float*)d_out;
  p.ws = (char*)d_ws;
  if (ws_size < WS_END) { fprintf(stderr, "workspace too small: %zu < %zu\n", ws_size, (size_t)WS_END); return; }
#if MULTI
  for (int ph = 0; ph < NPHASE; ++ph) {
    p.phase_begin = ph; p.phase_end = ph + 1; p.coop = 0; p.pad = 0;
    hipLaunchKernelGGL(fwd_mega, dim3(grid_blocks), dim3(256), 0, stream, p);
  }
#else
  p.phase_begin = 0; p.phase_end = NPHASE; p.coop = 1; p.pad = PROBE_STEP + 1;
  hipMemsetAsync((char*)d_ws + WS_BAR, 0, 16384, stream);
  void* args[] = {&p};
  hipError_t e = hipLaunchCooperativeKernel((void*)fwd_mega, dim3(grid_blocks), dim3(256), args, 0, stream);
  if (e != hipSuccess) fprintf(stderr, "cooperative launch failed: %s (grid %d)\n", hipGetErrorString(e), grid_blocks);
#endif
}
```

```cpp
#include <hip/hip_runtime.h>
#include <hip/hip_bf16.h>
#include <hip/hip_cooperative_groups.h>
#include <cstdio>
namespace cg = cooperative_groups;

#ifndef MULTI
#define MULTI 0
#endif
#ifndef PROBE_STEP
#define PROBE_STEP -1
#endif

#define DI __device__ __forceinline__
typedef unsigned short u16;
using bf16x8 = __attribute__((ext_vector_type(8))) short;
using s16x4  = __attribute__((ext_vector_type(4))) short;
using f32x16 = __attribute__((ext_vector_type(16))) float;
using u32x4  = __attribute__((ext_vector_type(4))) unsigned;
using u32x2  = __attribute__((ext_vector_type(2))) unsigned;
#define MFMA(a, b, c) __builtin_amdgcn_mfma_f32_32x32x16_bf16((a), (b), (c), 0, 0, 0)

constexpr int NTOK = 6144, NCTX = 4096, DM = 1024, INW = 7456, DFF = 2816, DFF2 = 5632;
constexpr int ZA_Q = 0, ZA_K = 256, ZA_V = 384, ZC_Q = 512, ZC_K = 768, ZC_V = 1024, ZB_Q = 1280, ZB_I = 1536, ZB_FF = 1792,
              ZB_FB = 2048, ZB_G = 2304, ZD_Q = 2560, ZD_K = 2688, ZD_V = 2816, ZD_G = 3072, ZD_RF = 3328, Z_ML = 3360;
constexpr float EPSN = 1e-6f;
constexpr size_t O_CAK = 6291456, O_CAV = 7340032, O_CCK = 8388608, O_CCV = 10485760, O_SH = 12582912, O_SG = 13631488;
constexpr size_t WS_WIN = 0;
constexpr size_t WS_WBR = WS_WIN + (size_t)INW * 1024 * 2;
constexpr size_t WS_WOUT = WS_WBR + (size_t)4 * 1024 * 256 * 2;
constexpr size_t WS_WUP = WS_WOUT + (size_t)1024 * 1024 * 2;
constexpr size_t WS_WDN = WS_WUP + (size_t)DFF2 * 1024 * 2;
constexpr size_t WS_MOD = WS_WDN + (size_t)1024 * DFF * 2;
constexpr size_t WS_H = WS_MOD + (size_t)2 * 3 * 6144 * 4;
constexpr size_t WS_Z = WS_H + (size_t)NTOK * 1024 * 2;
constexpr size_t WS_QA = WS_Z + (size_t)NTOK * INW * 2;
constexpr size_t WS_QC = WS_QA + (size_t)NTOK * 256 * 2;
constexpr size_t WS_KA = WS_QC + (size_t)NTOK * 256 * 2;
constexpr size_t WS_VA = WS_KA + (size_t)7168 * 128 * 2;
constexpr size_t WS_KC = WS_VA + (size_t)7168 * 128 * 2;
constexpr size_t WS_VC = WS_KC + (size_t)7168 * 256 * 2;
constexpr size_t WS_YCAT = WS_VC + (size_t)7168 * 256 * 2;
constexpr size_t WS_ACT = WS_YCAT + (size_t)NTOK * 1024 * 2;
constexpr size_t WS_MIX = WS_ACT + (size_t)NTOK * DFF * 2;
constexpr size_t WS_CL = WS_MIX + (size_t)NTOK * 1024 * 2;
constexpr size_t WS_U = WS_ACT;
constexpr size_t WS_S = WS_CL + (size_t)2304 * 64 * 4;
constexpr size_t WS_BAR = WS_S + (size_t)2304 * 4096 * 4;
constexpr size_t WS_PA = WS_BAR + 16384;
constexpr size_t WS_PML = WS_PA + (size_t)3 * 2048 * 4 * 64 * 4;
constexpr size_t WS_END = WS_PML + (size_t)3 * 2048 * 8 * 2 * 2 * 4;
constexpr size_t WS_PC = WS_H;
static_assert((size_t)2304 * 4096 * 4 <= (size_t)NTOK * DFF * 2 + (size_t)NTOK * 1024 * 2, "U alias");
static_assert(WS_END <= (size_t)256 * 1024 * 1024, "ws budget");
constexpr int SMEM_BYTES = 73728;
constexpr int NPHASE = 23;

struct Params {
  const float *x_prompt, *x_sample, *cache_a_k, *cache_a_v, *cache_c_k, *cache_c_v, *state_hgrn, *state_gla, *c, *c_ctx,
      *w_ada, *b_ada, *norm1_g, *norm2_g, *w_in, *a_qn_g, *a_kn_g, *c_qn_g, *c_kn_g, *c_lambda, *c_subln_g, *b_lb_logits,
      *b_norm_g, *d_alpha_w, *d_alpha_b, *d_norm_g, *w_branch, *w_out, *w_up, *conv_w, *conv_b, *w_down;
  float* out;
  char* ws;
  int phase_begin, phase_end, coop, pad;
};

DI int tid_() { int t = __builtin_amdgcn_workitem_id_x(); asm volatile("" : "+v"(t)); return t; }
DI float bf2f(u16 u) { return __uint_as_float(((unsigned)u) << 16); }
DI u16 f2bf(float a) { __hip_bfloat16 b = __float2bfloat16(a); return *(u16*)&b; }
DI unsigned pack2(float a, float b) { __hip_bfloat162 q = __float22bfloat162_rn(make_float2(a, b)); return *(unsigned*)&q; }
DI float lo_bf(unsigned u) { return __uint_as_float(u << 16); }
DI float hi_bf(unsigned u) { return __uint_as_float(u & 0xffff0000u); }
DI float sigmoidf_(float x) { return 1.f / (1.f + __expf(-x)); }
DI int crow(int e, int h) { return (e & 3) + 8 * (e >> 2) + 4 * h; }
DI bf16x8 pack8(const f32x16& x, int s) {
  u32x4 q;
  q[0] = pack2(x[8 * s + 0], x[8 * s + 1]); q[1] = pack2(x[8 * s + 2], x[8 * s + 3]);
  q[2] = pack2(x[8 * s + 4], x[8 * s + 5]); q[3] = pack2(x[8 * s + 6], x[8 * s + 7]);
  return __builtin_bit_cast(bf16x8, q);
}
DI s16x4 trread(const u16* pl) {
  return __builtin_amdgcn_ds_read_tr16_b64_v4i16((__attribute__((address_space(3))) s16x4*)pl);
}
DI bf16x8 trpair(const u16* p0, const u16* p1) {
  s16x4 a = trread(p0), b = trread(p1);
  return __builtin_shufflevector(a, b, 0, 1, 2, 3, 4, 5, 6, 7);
}
DI float wave_sum(float v) {
#pragma unroll
  for (int o = 32; o >= 1; o >>= 1) v += __shfl_xor(v, o);
  return v;
}
DI int tok_cond(int t) { return t < NCTX ? 0 : 1 + ((t - NCTX) >> 10); }
DI const float* xin_row(const Params& p, int l, int tok) {
  if (l > 0) return p.out + (size_t)tok * DM;
  return tok < NCTX ? p.x_prompt + (size_t)tok * DM : p.x_sample + (size_t)(tok - NCTX) * DM;
}


#define XB_TMO      128
#define XB_XCNT(j)  (256  + 64 * (j))
#define XB_XSUB(j)  (1280 + 64 * (j))
#define XB_XGEN(j)  (2304 + 64 * (j))
#define XB_TOP      3328
#define XB_TOPGEN   3392
#define XCD_BAR_WORDS 3456
#define XB_SPIN_CAP (1u << 22)
#define LAS __attribute__((address_space(3)))
DI unsigned xb_ld(unsigned* p) { return __hip_atomic_load(p, __ATOMIC_RELAXED, __HIP_MEMORY_SCOPE_AGENT); }
DI unsigned xb_add(unsigned* p, unsigned v) { return __hip_atomic_fetch_add(p, v, __ATOMIC_RELAXED, __HIP_MEMORY_SCOPE_AGENT); }
DI unsigned xb_xcc_id() { return (unsigned)__builtin_amdgcn_s_getreg((3 << 11) | 20) & 0xFu; }
#define XB_SPIN(cond, bar) do { unsigned _sp = 0; while (cond) { __builtin_amdgcn_s_sleep(1); \
    if ((++_sp & 255u) == 0u) { if (xb_ld(&(bar)[XB_TMO])) break; if (_sp > XB_SPIN_CAP) { atomicAdd(&(bar)[XB_TMO], 1u); break; } } } } while (0)
struct XcdBarrier { unsigned* bar; unsigned x; volatile LAS unsigned* st; };
DI XcdBarrier xcd_barrier_post(unsigned* bar, volatile LAS unsigned* st) {
  XcdBarrier b; b.bar = bar; b.x = xb_xcc_id(); b.st = st;
  if (__builtin_amdgcn_workitem_id_x() == 0) (void)xb_add(&bar[XB_XCNT(b.x)], 1u);
  return b;
}
DI void xcd_barrier_complete(unsigned* bar, unsigned x, unsigned& nloc, unsigned& nx) {
  const unsigned G = gridDim.x * gridDim.y * gridDim.z;
  unsigned sum, cnt, mine, sp = 0u;
  for (;;) {
    sum = 0u; cnt = 0u; mine = 0u;
#pragma unroll
    for (unsigned j = 0; j < 16; ++j) { const unsigned c = xb_ld(&bar[XB_XCNT(j)]); sum += c; cnt += (c > 0u) ? 1u : 0u; mine = (j == x) ? c : mine; }
    if (sum == G) break;
    __builtin_amdgcn_s_sleep(1);
    if ((++sp & 255u) == 0u) { if (xb_ld(&bar[XB_TMO])) break; if (sp > XB_SPIN_CAP) { atomicAdd(&bar[XB_TMO], 1u); break; } }
  }
  nloc = mine > 0u ? mine : 1u; nx = cnt > 0u ? cnt : 1u;
}
DI void xcd_barrier(const XcdBarrier& b) {
  asm volatile("s_waitcnt vmcnt(0)" ::: "memory");
  __syncthreads();
  if (__builtin_amdgcn_workitem_id_x() == 0) {
    unsigned* bar = b.bar;
    __builtin_amdgcn_s_waitcnt(0);
    unsigned nloc = b.st[0], nx = b.st[1];
    if (nloc == 0u) { xcd_barrier_complete(bar, b.x, nloc, nx); b.st[0] = nloc; b.st[1] = nx; }
    const unsigned old = xb_add(&bar[XB_XSUB(b.x)], 1u);
    const unsigned gen = old / nloc;
    if (old + 1u == (gen + 1u) * nloc) {
      __builtin_amdgcn_fence(__ATOMIC_RELEASE, "agent");
      asm volatile("s_waitcnt vmcnt(0)" ::: "memory");
      const unsigned og = xb_add(&bar[XB_TOP], 1u);
      const unsigned tg = og / nx;
      if (og + 1u == (tg + 1u) * nx) xb_add(&bar[XB_TOPGEN], 1u);
      else XB_SPIN(xb_ld(&bar[XB_TOPGEN]) == tg, bar);
      __builtin_amdgcn_fence(__ATOMIC_ACQUIRE, "agent");
      xb_add(&bar[XB_XGEN(b.x)], 1u);
      asm volatile("s_waitcnt vmcnt(0)" ::: "memory");
    } else {
      XB_SPIN(xb_ld(&bar[XB_XGEN(b.x)]) == gen, bar);
      __builtin_amdgcn_fence(__ATOMIC_ACQUIRE, "agent");
      asm volatile("s_waitcnt vmcnt(0)" ::: "memory");
    }
  }
  __syncthreads();
}

DI void convw_tile(const float* __restrict__ src, u16* __restrict__ dst, int K, int N, int item, float* T) {
  const int t = tid_();
  const int ntn = (N + 63) >> 6;
  const int n0 = (item % ntn) * 64, k0 = (item / ntn) * 64;
  {
    const int n4 = (t & 15) * 4;
    float4 v[4];
#pragma unroll
    for (int i = 0; i < 4; ++i) {
      const int kl = (t >> 4) + 16 * i;
      v[i] = (n0 + n4 < N) ? *(const float4*)(src + (size_t)(k0 + kl) * N + n0 + n4) : make_float4(0.f, 0.f, 0.f, 0.f);
    }
#pragma unroll
    for (int i = 0; i < 4; ++i) {
      const int kl = (t >> 4) + 16 * i;
      T[(n4 + 0) * 65 + kl] = v[i].x; T[(n4 + 1) * 65 + kl] = v[i].y;
      T[(n4 + 2) * 65 + kl] = v[i].z; T[(n4 + 3) * 65 + kl] = v[i].w;
    }
  }
  __syncthreads();
  {
    const int n = t >> 2, k16 = (t & 3) * 16;
    const float* tr = T + n * 65 + k16;
    u32x4 q0, q1;
    q0[0] = pack2(tr[0], tr[1]); q0[1] = pack2(tr[2], tr[3]); q0[2] = pack2(tr[4], tr[5]); q0[3] = pack2(tr[6], tr[7]);
    q1[0] = pack2(tr[8], tr[9]); q1[1] = pack2(tr[10], tr[11]); q1[2] = pack2(tr[12], tr[13]); q1[3] = pack2(tr[14], tr[15]);
    if (n0 + n < N) {
      u16* dp = dst + (size_t)(n0 + n) * K + k0 + k16;
      *(u32x4*)dp = q0; *(u32x4*)(dp + 8) = q1;
    }
  }
  __syncthreads();
}
constexpr int CONVW_ITEMS = 1872 + 256 + 256 + 1408 + 704;
DI void convw_item(const Params& p, int l, int item, char* sm) {
  float* T = (float*)sm;
  char* ws = p.ws;
  if (item < 1872) convw_tile(p.w_in + (size_t)l * 1024 * INW, (u16*)(ws + WS_WIN), 1024, INW, item, T);
  else if (item < 2128) convw_tile(p.w_branch + (size_t)l * 1024 * 1024, (u16*)(ws + WS_WBR), 1024, 1024, item - 1872, T);
  else if (item < 2384) convw_tile(p.w_out + (size_t)l * 1024 * 1024, (u16*)(ws + WS_WOUT), 1024, 1024, item - 2128, T);
  else if (item < 3792) convw_tile(p.w_up + (size_t)l * 1024 * DFF2, (u16*)(ws + WS_WUP), 1024, DFF2, item - 2384, T);
  else convw_tile(p.w_down + (size_t)l * DFF * 1024, (u16*)(ws + WS_WDN), DFF, 1024, item - 3792, T);
}

constexpr int MOD_ITEMS = 384;
DI void mod_item(const Params& p, int item, char* sm) {
  float* sc = (float*)sm;
  float* red = sc + 3072;
  const int t = tid_();
  const int l = item / 192, j0 = (item % 192) * 32;
  for (int i = t; i < 3072; i += 256) {
    const int cnd = i >> 10, k = i & 1023;
    const float v = cnd == 0 ? p.c_ctx[k] : p.c[(cnd - 1) * 1024 + k];
    sc[i] = v * sigmoidf_(v);
  }
  __syncthreads();
  const int cq = t & 7, ks = t >> 3;
  float a0[4] = {0, 0, 0, 0}, a1[4] = {0, 0, 0, 0}, a2[4] = {0, 0, 0, 0};
  const float* wp = p.w_ada + (size_t)l * 1024 * 6144 + j0 + 4 * cq;
#pragma unroll 8
  for (int rr = 0; rr < 32; ++rr) {
    const int row = ks * 32 + rr;
    const float4 w4 = *(const float4*)(wp + (size_t)row * 6144);
    const float s0 = sc[row], s1 = sc[1024 + row], s2 = sc[2048 + row];
    a0[0] += s0 * w4.x; a0[1] += s0 * w4.y; a0[2] += s0 * w4.z; a0[3] += s0 * w4.w;
    a1[0] += s1 * w4.x; a1[1] += s1 * w4.y; a1[2] += s1 * w4.z; a1[3] += s1 * w4.w;
    a2[0] += s2 * w4.x; a2[1] += s2 * w4.y; a2[2] += s2 * w4.z; a2[3] += s2 * w4.w;
  }
#pragma unroll
  for (int q = 0; q < 4; ++q) {
    red[(ks * 3 + 0) * 32 + 4 * cq + q] = a0[q];
    red[(ks * 3 + 1) * 32 + 4 * cq + q] = a1[q];
    red[(ks * 3 + 2) * 32 + 4 * cq + q] = a2[q];
  }
  __syncthreads();
  if (t < 96) {
    const int cnd = t >> 5, col = t & 31;
    float sacc = p.b_ada[l * 6144 + j0 + col];
    for (int k = 0; k < 32; ++k) sacc += red[(k * 3 + cnd) * 32 + col];
    ((float*)(p.ws + WS_MOD))[(l * 3 + cnd) * 6144 + j0 + col] = sacc;
  }
  __syncthreads();
}

DI void norm_tok(const Params& p, int l, int which, int tok) {
  const int lane = tid_() & 63;
  const float* xr = which == 0 ? xin_row(p, l, tok) : p.out + (size_t)tok * DM;
  const float* g = (which == 0 ? p.norm1_g : p.norm2_g) + l * 1024;
  const float* mod = (const float*)(p.ws + WS_MOD) + (l * 3 + tok_cond(tok)) * 6144 + which * 3072;
  float4 v[4];
  float ss = 0.f;
#pragma unroll
  for (int i = 0; i < 4; ++i) {
    v[i] = *(const float4*)(xr + 4 * lane + 256 * i);
    ss += v[i].x * v[i].x + v[i].y * v[i].y + v[i].z * v[i].z + v[i].w * v[i].w;
  }
  ss = wave_sum(ss);
  const float rstd = rsqrtf(ss * (1.f / 1024.f) + EPSN);
  u16* hr = (u16*)(p.ws + WS_H) + (size_t)tok * DM;
#pragma unroll
  for (int i = 0; i < 4; ++i) {
    const int c0 = 4 * lane + 256 * i;
    const float4 gg = *(const float4*)(g + c0);
    const float4 sh = *(const float4*)(mod + c0);
    const float4 scv = *(const float4*)(mod + 1024 + c0);
    u32x2 q;
    q[0] = pack2(v[i].x * rstd * gg.x * (1.f + scv.x) + sh.x, v[i].y * rstd * gg.y * (1.f + scv.y) + sh.y);
    q[1] = pack2(v[i].z * rstd * gg.z * (1.f + scv.z) + sh.z, v[i].w * rstd * gg.w * (1.f + scv.w) + sh.w);
    *(u32x2*)(hr + c0) = q;
  }
}

template <int NJ, bool GATED>
DI void gemm_core(const u16* __restrict__ A, int lda, const u16* __restrict__ Bt, int ldb, int K, int m0, int n0, int N,
                  f32x16 (&acc)[2][NJ], u16* sm, const u16* __restrict__ gz = nullptr, f32x16 (*tot)[NJ] = nullptr) {
  const int t = tid_(), lane = t & 63, w = t >> 6, r = lane & 31, h = lane >> 5;
  const int wm = w & 1, wn = w >> 1;
  u16* As = sm;
  u16* Bs = sm + 2 * 128 * 72;
  const int lrow = t >> 3, lc8 = (t & 7) * 8;
  int aoff[4], boff[2 * NJ];
#pragma unroll
  for (int i = 0; i < 4; ++i) aoff[i] = (m0 + lrow + 32 * i) * lda + lc8;
#pragma unroll
  for (int i = 0; i < 2 * NJ; ++i) {
    int bn = n0 + lrow + 32 * i;
    bn = bn < N ? bn : N - 1;
    boff[i] = bn * ldb + lc8;
  }
  u32x4 ra[2][4], rb[2][2 * NJ];
  const int KT = K >> 6;
  auto gload = [&](int set, int kt) {
    const int k0 = kt * 64;
#pragma unroll
    for (int i = 0; i < 4; ++i) ra[set][i] = *(const u32x4*)(A + aoff[i] + k0);
#pragma unroll
    for (int i = 0; i < 2 * NJ; ++i) rb[set][i] = *(const u32x4*)(Bt + boff[i] + k0);
  };
  auto sstore = [&](int set, int buf) {
    const int nb = buf * 128 * 72;
#pragma unroll
    for (int i = 0; i < 4; ++i) *(u32x4*)(As + nb + (lrow + 32 * i) * 72 + lc8) = ra[set][i];
#pragma unroll
    for (int i = 0; i < 2 * NJ; ++i) *(u32x4*)(Bs + nb + (lrow + 32 * i) * 72 + lc8) = rb[set][i];
  };
  auto compute = [&](int buf) {
    const u16* as = As + buf * 128 * 72 + (wm * 64 + r) * 72 + 8 * h;
    const u16* bs = Bs + buf * 128 * 72 + (wn * 32 * NJ + r) * 72 + 8 * h;
    __builtin_amdgcn_s_setprio(1);
#pragma unroll
    for (int ks = 0; ks < 4; ++ks) {
      const bf16x8 a0 = *(const bf16x8*)(as + ks * 16), a1 = *(const bf16x8*)(as + 32 * 72 + ks * 16);
#pragma unroll
      for (int j = 0; j < NJ; ++j) {
        const bf16x8 b0 = *(const bf16x8*)(bs + j * 32 * 72 + ks * 16);
        acc[0][j] = MFMA(a0, b0, acc[0][j]);
        acc[1][j] = MFMA(a1, b0, acc[1][j]);
      }
    }
    __builtin_amdgcn_s_setprio(0);
  };
  gload(0, 0);
  gload(1, 1);
  sstore(0, 0);
  __syncthreads();
  for (int kt = 0; kt < KT; kt += 2) {
    if (kt + 2 < KT) gload(0, kt + 2);
    compute(0);
    sstore(1, 1);
    __syncthreads();
    if (kt + 3 < KT) gload(1, kt + 3);
    u16 graw[GATED ? 32 * NJ : 1];
    if (GATED && (kt & 3) == 2) {
      const int n = kt >> 2;
#pragma unroll
      for (int i = 0; i < 2; ++i)
#pragma unroll
        for (int j = 0; j < NJ; ++j)
#pragma unroll
          for (int e = 0; e < 16; ++e)
            graw[(i * NJ + j) * 16 + e] = gz[(size_t)(m0 + wm * 64 + i * 32 + crow(e, h)) * INW + n * 1024 + n0 + wn * 32 * NJ + j * 32 + r];
    }
    compute(1);
    if (kt + 2 < KT) sstore(0, 0);
    __syncthreads();
    if (GATED && (kt & 3) == 2) {
#pragma unroll
      for (int i = 0; i < 2; ++i)
#pragma unroll
        for (int j = 0; j < NJ; ++j)
#pragma unroll
          for (int e = 0; e < 16; ++e) {
            tot[i][j][e] += sigmoidf_(bf2f(graw[(i * NJ + j) * 16 + e])) * acc[i][j][e];
            acc[i][j][e] = 0.f;
          }
    }
  }
}
template <int NJ>
DI void zero_acc(f32x16 (&acc)[2][NJ]) {
#pragma unroll
  for (int i = 0; i < 2; ++i)
#pragma unroll
    for (int j = 0; j < NJ; ++j)
#pragma unroll
      for (int e = 0; e < 16; ++e) acc[i][j][e] = 0.f;
}
#define EPI_LOOP_N(NJ_, body)                                                       \
  {                                                                                 \
    const int lane_ = tid_() & 63, w_ = tid_() >> 6, r_ = lane_ & 31, h_ = lane_ >> 5; \
    _Pragma("unroll") for (int i_ = 0; i_ < 2; ++i_)                                 \
    _Pragma("unroll") for (int j_ = 0; j_ < NJ_; ++j_)                               \
    _Pragma("unroll") for (int e_ = 0; e_ < 16; ++e_) {                              \
      const int row = m0 + (w_ & 1) * 64 + i_ * 32 + crow(e_, h_);                  \
      const int col = n0 + (w_ >> 1) * 32 * NJ_ + j_ * 32 + r_;                     \
      body                                                                          \
    }                                                                               \
  }
#define EPI_LOOP(body) EPI_LOOP_N(2, body)

DI void gemm_in_item(const Params& p, int item, char* sm) {
  const int m0 = (item % 48) * 128, n0 = (item / 48) * 128;
  f32x16 acc[2][2];
  zero_acc<2>(acc);
  gemm_core<2, false>((const u16*)(p.ws + WS_H), 1024, (const u16*)(p.ws + WS_WIN), 1024, 1024, m0, n0, INW, acc, (u16*)sm);
  u16* z = (u16*)(p.ws + WS_Z);
  EPI_LOOP(if (col < INW) z[(size_t)row * INW + col] = f2bf(acc[i_][j_][e_]);)
}
DI void gemm_branch_item(const Params& p, int item, char* sm) {
  const int m0 = (item % 48) * 128, n0 = (item / 48) * 64;
  f32x16 tot[2][1], acc[2][1];
  zero_acc<1>(tot);
  zero_acc<1>(acc);
  gemm_core<1, true>((const u16*)(p.ws + WS_YCAT), 1024, (const u16*)(p.ws + WS_WBR), 1024, 1024, m0, n0, 1024, acc, (u16*)sm,
                     (const u16*)(p.ws + WS_Z) + Z_ML, tot);
  u16* mix = (u16*)(p.ws + WS_MIX);
  EPI_LOOP_N(1, mix[(size_t)row * 1024 + col] = f2bf(tot[i_][j_][e_]);)
}
DI void gemm_out_item(const Params& p, int l, int item, char* sm, bool dry) {
  const int m0 = (item % 48) * 128, n0 = (item / 48) * 128;
  f32x16 acc[2][2];
  zero_acc<2>(acc);
  gemm_core<2, false>((const u16*)(p.ws + WS_MIX), 1024, (const u16*)(p.ws + WS_WOUT), 1024, 1024, m0, n0, 1024, acc, (u16*)sm);
  const float* g1 = (const float*)(p.ws + WS_MOD) + (l * 3 + tok_cond(m0)) * 6144 + 2048;
  EPI_LOOP(const float xo = xin_row(p, l, row)[col]; const float xn = xo + g1[col] * acc[i_][j_][e_]; if (!dry) p.out[(size_t)row * DM + col] = xn;)
}
DI void gemm_up_item(const Params& p, int item, char* sm) {
  const int m0 = (item % 48) * 128, n0 = (item / 48) * 128;
  f32x16 acc[2][2];
  zero_acc<2>(acc);
  gemm_core<2, false>((const u16*)(p.ws + WS_H), 1024, (const u16*)(p.ws + WS_WUP), 1024, 1024, m0, n0, DFF2, acc, (u16*)sm);
  u16* u = (u16*)(p.ws + WS_Z);
  EPI_LOOP(u[(size_t)row * DFF2 + col] = f2bf(acc[i_][j_][e_]);)
}
DI void gemm_down_item(const Params& p, int l, int item, char* sm, bool dry) {
  const int m0 = (item % 48) * 128, n0 = (item / 48) * 128;
  f32x16 acc[2][2];
  zero_acc<2>(acc);
  gemm_core<2, false>((const u16*)(p.ws + WS_ACT), DFF, (const u16*)(p.ws + WS_WDN), DFF, DFF, m0, n0, 1024, acc, (u16*)sm);
  const float* g2 = (const float*)(p.ws + WS_MOD) + (l * 3 + tok_cond(m0)) * 6144 + 5120;
  EPI_LOOP(float* xp = p.out + (size_t)row * DM + col; const float xn = *xp + g2[col] * acc[i_][j_][e_]; if (!dry) *xp = xn;)
}

DI void conv_act(const Params& p, int l, int gid, int gstride) {
  const u16* u = (const u16*)(p.ws + WS_Z);
  u16* act = (u16*)(p.ws + WS_ACT);
  const float* cw = p.conv_w + (size_t)l * 3 * DFF2;
  const float* cb = p.conv_b + (size_t)l * DFF2;
  for (int idx = gid; idx < (NTOK / 4) * 352; idx += gstride) {
    const int tok0 = (idx / 352) * 4, c0 = (idx % 352) * 8;
    int pos, L;
    if (tok0 < NCTX) { pos = tok0 & 255; L = 256; } else { pos = (tok0 - NCTX) & 1023; L = 1024; }
    u32x4 ua[6], ug[6];
#pragma unroll
    for (int d = 0; d < 6; ++d) {
      const int pp = pos + d - 1;
      if (pp >= 0 && pp < L) {
        const u16* ur = u + (size_t)(tok0 + d - 1) * DFF2;
        ua[d] = *(const u32x4*)(ur + c0); ug[d] = *(const u32x4*)(ur + DFF + c0);
      } else { ua[d] = u32x4{0u, 0u, 0u, 0u}; ug[d] = u32x4{0u, 0u, 0u, 0u}; }
    }
    float wa[3][8], wg[3][8], ba[8], bg[8];
#pragma unroll
    for (int d = 0; d < 3; ++d) {
      const float4 x0 = *(const float4*)(cw + d * DFF2 + c0), x1 = *(const float4*)(cw + d * DFF2 + c0 + 4);
      const float4 y0 = *(const float4*)(cw + d * DFF2 + DFF + c0), y1 = *(const float4*)(cw + d * DFF2 + DFF + c0 + 4);
      wa[d][0] = x0.x; wa[d][1] = x0.y; wa[d][2] = x0.z; wa[d][3] = x0.w; wa[d][4] = x1.x; wa[d][5] = x1.y; wa[d][6] = x1.z; wa[d][7] = x1.w;
      wg[d][0] = y0.x; wg[d][1] = y0.y; wg[d][2] = y0.z; wg[d][3] = y0.w; wg[d][4] = y1.x; wg[d][5] = y1.y; wg[d][6] = y1.z; wg[d][7] = y1.w;
    }
    {
      const float4 x0 = *(const float4*)(cb + c0), x1 = *(const float4*)(cb + c0 + 4);
      const float4 y0 = *(const float4*)(cb + DFF + c0), y1 = *(const float4*)(cb + DFF + c0 + 4);
      ba[0] = x0.x; ba[1] = x0.y; ba[2] = x0.z; ba[3] = x0.w; ba[4] = x1.x; ba[5] = x1.y; ba[6] = x1.z; ba[7] = x1.w;
      bg[0] = y0.x; bg[1] = y0.y; bg[2] = y0.z; bg[3] = y0.w; bg[4] = y1.x; bg[5] = y1.y; bg[6] = y1.z; bg[7] = y1.w;
    }
#pragma unroll
    for (int tt = 0; tt < 4; ++tt) {
      u32x4 o;
#pragma unroll
      for (int q = 0; q < 4; ++q) {
        float a0 = ba[2 * q], a1 = ba[2 * q + 1], g0 = bg[2 * q], g1 = bg[2 * q + 1];
#pragma unroll
        for (int d = 0; d < 3; ++d) {
          a0 += wa[d][2 * q] * lo_bf(ua[tt + d][q]); a1 += wa[d][2 * q + 1] * hi_bf(ua[tt + d][q]);
          g0 += wg[d][2 * q] * lo_bf(ug[tt + d][q]); g1 += wg[d][2 * q + 1] * hi_bf(ug[tt + d][q]);
        }
        o[q] = pack2(g0 * sigmoidf_(g0) * a0, g1 * sigmoidf_(g1) * a1);
      }
      *(u32x4*)(act + (size_t)(tok0 + tt) * DFF + c0) = o;
    }
  }
}

DI void prep_wave(const Params& p, int l, int item) {
  const int lane = tid_() & 63;
  char* ws = p.ws;
  u16* qA = (u16*)(ws + WS_QA); u16* qC = (u16*)(ws + WS_QC);
  u16* kA = (u16*)(ws + WS_KA); u16* vA = (u16*)(ws + WS_VA);
  u16* kC = (u16*)(ws + WS_KC); u16* vC = (u16*)(ws + WS_VC);
  if (item >= NTOK) {
    const int cr = item - NTOK, b = cr >> 9, key = cr & 511;
    const size_t keyrow = 4096 + b * 1536 + key;
    const size_t srow = (size_t)(b * 2 + l) * 512 + key;
    float v[12];
#pragma unroll
    for (int u = 0; u < 12; ++u) {
      if (u < 2) v[u] = p.cache_a_k[srow * 128 + u * 64 + lane];
      else if (u < 4) v[u] = p.cache_a_v[srow * 128 + (u - 2) * 64 + lane];
      else if (u < 8) v[u] = p.cache_c_k[srow * 256 + (u - 4) * 64 + lane];
      else v[u] = p.cache_c_v[srow * 256 + (u - 8) * 64 + lane];
    }
#pragma unroll
    for (int u = 0; u < 12; ++u) {
      if (u < 2) kA[keyrow * 128 + u * 64 + lane] = f2bf(v[u]);
      else if (u < 4) vA[keyrow * 128 + (u - 2) * 64 + lane] = f2bf(v[u]);
      else if (u < 8) kC[keyrow * 256 + (u - 4) * 64 + lane] = f2bf(v[u]);
      else vC[keyrow * 256 + (u - 8) * 64 + lane] = f2bf(v[u]);
    }
    return;
  }
  const int tok = item;
  const bool sample = tok >= NCTX;
  int b, pos;
  size_t keyrow;
  if (!sample) { b = tok >> 8; pos = tok & 255; keyrow = tok; }
  else { b = (tok - NCTX) >> 10; pos = (tok - NCTX) & 1023; keyrow = 4096 + b * 1536 + 512 + pos; }
  const size_t crow_o = (size_t)(b * 2 + l) * 256 + pos;
  const u16* zr = (const u16*)(ws + WS_Z) + (size_t)tok * INW;
  const float rowp = (float)(pos >> 6), colp = (float)(pos & 63);
  u16 raw[20];
#pragma unroll
  for (int u = 0; u < 20; ++u) raw[u] = zr[u * 64 + lane];
  float cosA = 1.f, sinA = 0.f, cosC = 1.f, sinC = 0.f;
  if (sample) {
    {
      const int a = lane >> 5, i = lane & 15;
      const float ang = (a ? colp : rowp) * exp2f(-(float)i * (0.0625f * 13.287712379549449f));
      cosA = __cosf(ang); sinA = __sinf(ang);
      if (!((lane >> 4) & 1)) sinA = -sinA;
    }
    {
      const int dd = lane & 31, a = dd >> 4, i = dd & 7;
      const float ang = (a ? colp : rowp) * exp2f(-(float)i * (0.125f * 13.287712379549449f));
      cosC = __cosf(ang); sinC = __sinf(ang);
      if (!((dd >> 3) & 1)) sinC = -sinC;
    }
  }
  const float gaq = p.a_qn_g[l * 64 + lane], gak = p.a_kn_g[l * 64 + lane];
  const float gcq = p.c_qn_g[l * 32 + (lane & 31)], gck = p.c_kn_g[l * 32 + (lane & 31)];
#pragma unroll
  for (int u = 0; u < 20; ++u) {
    const float x = bf2f(raw[u]);
    if (u < 6) {
      const bool isq = u < 4;
      const int hd = isq ? u : u - 4;
      const float ss = wave_sum(x * x);
      float y = x * rsqrtf(ss * (1.f / 64.f) + EPSN) * (isq ? gaq : gak);
      if (!sample && !isq) p.out[O_CAK + crow_o * 128 + hd * 64 + lane] = y;
      if (sample) { const float pr = __shfl_xor(y, 16); y = y * cosA + pr * sinA; }
      if (isq) qA[(size_t)tok * 256 + hd * 64 + lane] = f2bf(y);
      else kA[keyrow * 128 + hd * 64 + lane] = f2bf(y);
    } else if (u < 8) {
      const int hd = u - 6;
      if (!sample) p.out[O_CAV + crow_o * 128 + hd * 64 + lane] = x;
      vA[keyrow * 128 + hd * 64 + lane] = raw[u];
    } else if (u < 16) {
      const bool isq = u < 12;
      const int pr2 = isq ? u - 8 : u - 12;
      float ss = x * x;
#pragma unroll
      for (int o = 16; o >= 1; o >>= 1) ss += __shfl_xor(ss, o);
      float y = x * rsqrtf(ss * (1.f / 32.f) + EPSN) * (isq ? gcq : gck);
      if (!sample && !isq) p.out[O_CCK + crow_o * 256 + pr2 * 64 + lane] = y;
      if (sample) { const float pr = __shfl_xor(y, 8); y = y * cosC + pr * sinC; }
      if (isq) qC[(size_t)tok * 256 + pr2 * 64 + lane] = f2bf(y);
      else kC[keyrow * 256 + pr2 * 64 + lane] = f2bf(y);
    } else {
      const int hd = u - 16;
      if (!sample) p.out[O_CCV + crow_o * 256 + hd * 64 + lane] = x;
      vC[keyrow * 256 + hd * 64 + lane] = raw[u];
    }
  }
}

template <bool ISC>
DI void attn_item(const Params& p, int l, int tok0, int keyrow0, int nkeys, int head, int split, char* smraw) {
  constexpr int NM = ISC ? 2 : 1;
  u16* Ks = (u16*)smraw;
  u16* Vs = Ks + 2 * 64 * 72;
  const u16* qbuf = (const u16*)(p.ws + (ISC ? WS_QC : WS_QA));
  const u16* kbuf = (const u16*)(p.ws + (ISC ? WS_KC : WS_KA));
  const u16* vbuf = (const u16*)(p.ws + (ISC ? WS_VC : WS_VA));
  const int kstride = ISC ? 256 : 128;
  const int koff = ISC ? head * 64 : (head >> 1) * 64;
  const float c2 = (ISC ? 0.17677669529663687f : 0.125f) * 1.4426950408889634f;
  const int t = tid_(), lane = t & 63, w = t >> 6, r = lane & 31, h = lane >> 5;
  const int i16 = lane & 15, tq = i16 >> 2, tp = i16 & 3, blk = (lane >> 4) & 1;
  bf16x8 qf[4];
  {
    const u16* qp = qbuf + (size_t)(tok0 + 32 * w + r) * 256 + head * 64 + 8 * h;
#pragma unroll
    for (int s = 0; s < 4; ++s) qf[s] = *(const bf16x8*)(qp + 16 * s);
  }
  f32x16 O[NM][2];
  float mrun[NM], lsum[NM];
#pragma unroll
  for (int m = 0; m < NM; ++m) {
    mrun[m] = -INFINITY; lsum[m] = 0.f;
#pragma unroll
    for (int d = 0; d < 2; ++d)
#pragma unroll
      for (int e = 0; e < 16; ++e) O[m][d][e] = 0.f;
  }
  const int lrow = t >> 3, lc8 = (t & 7) * 8;
  const u16* kg = kbuf + (size_t)(keyrow0 + lrow) * kstride + koff + lc8;
  const u16* vg = vbuf + (size_t)(keyrow0 + lrow) * kstride + koff + lc8;
  u32x4 rk[2], rv[2];
#pragma unroll
  for (int i = 0; i < 2; ++i) { rk[i] = *(const u32x4*)(kg + (size_t)(32 * i) * kstride); rv[i] = *(const u32x4*)(vg + (size_t)(32 * i) * kstride); }
#pragma unroll
  for (int i = 0; i < 2; ++i) {
    *(u32x4*)(Ks + (lrow + 32 * i) * 72 + lc8) = rk[i];
    *(u32x4*)(Vs + (lrow + 32 * i) * 72 + lc8) = rv[i];
  }
  __syncthreads();
  const int NT = nkeys >> 6;
  for (int kt = 0; kt < NT; ++kt) {
    const int buf = kt & 1;
    if (kt + 1 < NT) {
#pragma unroll
      for (int i = 0; i < 2; ++i) {
        rk[i] = *(const u32x4*)(kg + (size_t)((kt + 1) * 64 + 32 * i) * kstride);
        rv[i] = *(const u32x4*)(vg + (size_t)((kt + 1) * 64 + 32 * i) * kstride);
      }
    }
    const u16* kb_ = Ks + buf * 64 * 72;
    const u16* vb_ = Vs + buf * 64 * 72;
#pragma unroll
    for (int kb = 0; kb < 2; ++kb) {
      f32x16 S[NM];
#pragma unroll
      for (int m = 0; m < NM; ++m)
#pragma unroll
        for (int e = 0; e < 16; ++e) S[m][e] = 0.f;
#pragma unroll
      for (int s = 0; s < 4; ++s) {
        const int m = ISC ? (s >> 1) : 0;
        const bf16x8 kf = *(const bf16x8*)(kb_ + (kb * 32 + r) * 72 + 16 * s + 8 * h);
        S[m] = MFMA(kf, qf[s], S[m]);
      }
#pragma unroll
      for (int m = 0; m < NM; ++m) {
        float mx = S[m][0];
#pragma unroll
        for (int e = 1; e < 16; ++e) mx = fmaxf(mx, S[m][e]);
        mx = fmaxf(mx, __shfl_xor(mx, 32));
        const float mnew = fmaxf(mrun[m], mx);
        const float alpha = exp2f((mrun[m] - mnew) * c2);
        mrun[m] = mnew;
        const float mc = mnew * c2;
        float ps = 0.f;
#pragma unroll
        for (int e = 0; e < 16; ++e) { const float pe = exp2f(S[m][e] * c2 - mc); S[m][e] = pe; ps += pe; }
        lsum[m] = lsum[m] * alpha + ps;
        if (__any(alpha != 1.f)) {
#pragma unroll
          for (int d = 0; d < 2; ++d)
#pragma unroll
            for (int e = 0; e < 16; ++e) O[m][d][e] *= alpha;
        }
      }
#pragma unroll
      for (int st = 0; st < 2; ++st) {
        bf16x8 pf[NM];
#pragma unroll
        for (int m = 0; m < NM; ++m) pf[m] = pack8(S[m], st);
#pragma unroll
        for (int d = 0; d < 2; ++d) {
          const u16* vp = vb_ + (kb * 32 + 16 * st + 4 * h + tq) * 72 + d * 32 + 16 * blk + 4 * tp;
          const bf16x8 vf = trpair(vp, vp + 8 * 72);
#pragma unroll
          for (int m = 0; m < NM; ++m) O[m][d] = MFMA(vf, pf[m], O[m][d]);
        }
      }
    }
    if (kt + 1 < NT) {
      const int nb = (buf ^ 1) * 64 * 72;
#pragma unroll
      for (int i = 0; i < 2; ++i) {
        *(u32x4*)(Ks + nb + (lrow + 32 * i) * 72 + lc8) = rk[i];
        *(u32x4*)(Vs + nb + (lrow + 32 * i) * 72 + lc8) = rv[i];
      }
    }
    __syncthreads();
  }
  if (split >= 0) {
    const int ts = tok0 - NCTX + 32 * w + r;
#pragma unroll
    for (int m = 0; m < NM; ++m) {
      const float lt = lsum[m] + __shfl_xor(lsum[m], 32);
      float* op = ISC ? (float*)(p.ws + WS_PC) + ((size_t)((split * 2048 + ts) * 4 + head) * 2 + m) * 64
                      : (float*)(p.ws + WS_PA) + (size_t)((split * 2048 + ts) * 4 + head) * 64;
#pragma unroll
      for (int d = 0; d < 2; ++d)
#pragma unroll
        for (int g = 0; g < 4; ++g)
          *(float4*)(op + d * 32 + 8 * g + 4 * h) = make_float4(O[m][d][4 * g], O[m][d][4 * g + 1], O[m][d][4 * g + 2], O[m][d][4 * g + 3]);
      if (h == 0) {
        float* mp = (float*)(p.ws + WS_PML) + ((size_t)((split * 2048 + ts) * 8 + (ISC ? 4 : 0) + head) * 2 + m) * 2;
        mp[0] = mrun[m]; mp[1] = lt;
      }
    }
    return;
  }
  float inv[NM];
#pragma unroll
  for (int m = 0; m < NM; ++m) { const float lt = lsum[m] + __shfl_xor(lsum[m], 32); inv[m] = 1.f / lt; }
  const int tok = tok0 + 32 * w + r;
  u16* yc = (u16*)(p.ws + WS_YCAT) + (size_t)tok * 1024;
  if (!ISC) {
#pragma unroll
    for (int d = 0; d < 2; ++d)
#pragma unroll
      for (int g = 0; g < 4; ++g) {
        u32x2 q;
        q[0] = pack2(O[0][d][4 * g] * inv[0], O[0][d][4 * g + 1] * inv[0]);
        q[1] = pack2(O[0][d][4 * g + 2] * inv[0], O[0][d][4 * g + 3] * inv[0]);
        *(u32x2*)(yc + head * 64 + d * 32 + 8 * g + 4 * h) = q;
      }
  } else {
    const float* cl = p.c_lambda + l * 128;
    float d1 = 0.f, d2 = 0.f;
    for (int i = 0; i < 32; ++i) { d1 += cl[i] * cl[32 + i]; d2 += cl[64 + i] * cl[96 + i]; }
    const float lam_init = 0.8f - 0.6f * __expf(-0.3f * (float)l);
    const float lam = __expf(d1) - __expf(d2) + lam_init;
    float ss = 0.f;
#pragma unroll
    for (int d = 0; d < 2; ++d)
#pragma unroll
      for (int e = 0; e < 16; ++e) {
        const float dv = O[0][d][e] * inv[0] - lam * (O[NM - 1][d][e] * inv[NM - 1]);
        O[0][d][e] = dv; ss += dv * dv;
      }
    ss += __shfl_xor(ss, 32);
    const float sc = rsqrtf(ss * (1.f / 64.f) + EPSN) * (1.f - lam_init);
    const float* sg = p.c_subln_g + l * 64;
#pragma unroll
    for (int d = 0; d < 2; ++d)
#pragma unroll
      for (int g = 0; g < 4; ++g) {
        const int dv0 = d * 32 + 8 * g + 4 * h;
        u32x2 q;
        q[0] = pack2(O[0][d][4 * g] * sc * sg[dv0], O[0][d][4 * g + 1] * sc * sg[dv0 + 1]);
        q[1] = pack2(O[0][d][4 * g + 2] * sc * sg[dv0 + 2], O[0][d][4 * g + 3] * sc * sg[dv0 + 3]);
        *(u32x2*)(yc + 512 + head * 64 + dv0) = q;
      }
  }
}
DI void attn_dispatch(const Params& p, int l, int item, char* sm) {
  if (item < 384) {
    const int j = item % 192, split = j / 64, jj = j & 63, b = jj >> 5, qb = (jj >> 2) & 7, head = jj & 3;
    const int tok0 = NCTX + b * 1024 + qb * 128, kr0 = 4096 + b * 1536 + split * 512;
    if (item < 192) attn_item<true>(p, l, tok0, kr0, 512, head, split, sm);
    else attn_item<false>(p, l, tok0, kr0, 512, head, split, sm);
  } else {
    const int j = (item - 384) & 127, sq = j >> 3, qb = (j >> 2) & 1, head = j & 3;
    const int tok0 = sq * 256 + qb * 128, kr0 = sq * 256;
    if (item < 512) attn_item<true>(p, l, tok0, kr0, 256, head, -1, sm);
    else attn_item<false>(p, l, tok0, kr0, 256, head, -1, sm);
  }
}
DI void attn_combine(const Params& p, int l, int item) {
  const int lane = tid_() & 63;
  const int ts = item >> 1, isc = item & 1;
  const float* ml = (const float*)(p.ws + WS_PML);
  u16* yc = (u16*)(p.ws + WS_YCAT) + (size_t)(NCTX + ts) * 1024;
  if (!isc) {
    const float c2 = 0.125f * 1.4426950408889634f;
    float m[4][3], lv[4][3], o[4][3];
#pragma unroll
    for (int hd = 0; hd < 4; ++hd)
#pragma unroll
      for (int sp = 0; sp < 3; ++sp) {
        const float2 mm = *(const float2*)(ml + ((size_t)((sp * 2048 + ts) * 8 + hd) * 2) * 2);
        m[hd][sp] = mm.x; lv[hd][sp] = mm.y;
        o[hd][sp] = ((const float*)(p.ws + WS_PA))[(size_t)((sp * 2048 + ts) * 4 + hd) * 64 + lane];
      }
#pragma unroll
    for (int hd = 0; hd < 4; ++hd) {
      const float M = fmaxf(m[hd][0], fmaxf(m[hd][1], m[hd][2]));
      float num = 0.f, den = 0.f;
#pragma unroll
      for (int sp = 0; sp < 3; ++sp) { const float wgt = exp2f((m[hd][sp] - M) * c2); num += wgt * o[hd][sp]; den += wgt * lv[hd][sp]; }
      yc[hd * 64 + lane] = f2bf(num / den);
    }
  } else {
    const float c2 = 0.17677669529663687f * 1.4426950408889634f;
    const float* cl = p.c_lambda + l * 128;
    const float d1 = wave_sum(lane < 32 ? cl[lane] * cl[32 + lane] : 0.f), d2 = wave_sum(lane < 32 ? cl[64 + lane] * cl[96 + lane] : 0.f);
    const float lam_init = 0.8f - 0.6f * __expf(-0.3f * (float)l);
    const float lam = __expf(d1) - __expf(d2) + lam_init;
    const float sgv = p.c_subln_g[l * 64 + lane];
    float m[4][2][3], lv[4][2][3], o[4][2][3];
#pragma unroll
    for (int hd = 0; hd < 4; ++hd)
#pragma unroll
      for (int mm = 0; mm < 2; ++mm)
#pragma unroll
        for (int sp = 0; sp < 3; ++sp) {
          const float2 q = *(const float2*)(ml + ((size_t)((sp * 2048 + ts) * 8 + 4 + hd) * 2 + mm) * 2);
          m[hd][mm][sp] = q.x; lv[hd][mm][sp] = q.y;
          o[hd][mm][sp] = ((const float*)(p.ws + WS_PC))[((size_t)((sp * 2048 + ts) * 4 + hd) * 2 + mm) * 64 + lane];
        }
#pragma unroll
    for (int hd = 0; hd < 4; ++hd) {
      float res[2];
#pragma unroll
      for (int mm = 0; mm < 2; ++mm) {
        const float M = fmaxf(m[hd][mm][0], fmaxf(m[hd][mm][1], m[hd][mm][2]));
        float num = 0.f, den = 0.f;
#pragma unroll
        for (int sp = 0; sp < 3; ++sp) { const float wgt = exp2f((m[hd][mm][sp] - M) * c2); num += wgt * o[hd][mm][sp]; den += wgt * lv[hd][mm][sp]; }
        res[mm] = num / den;
      }
      const float dv = res[0] - lam * res[1];
      const float ss = wave_sum(dv * dv);
      const float sc = rsqrtf(ss * (1.f / 64.f) + EPSN) * (1.f - lam_init);
      yc[512 + hd * 64 + lane] = f2bf(dv * sc * sgv);
    }
  }
}

template <bool GLA>
struct ScanCtx { float wa[16]; float ba, lbm, oml; int ldir; };
template <bool GLA>
DI void scan_init(const Params& p, int l, int head, int dirh, int lane, ScanCtx<GLA>& cx) {
  const int ldir = GLA ? (lane >> 5) : dirh;
  cx.ldir = ldir;
  if (GLA) {
    const int kc = lane & 31;
#pragma unroll
    for (int j = 0; j < 16; ++j) cx.wa[j] = p.d_alpha_w[((size_t)(l * 2 + ldir) * 16 + j) * 128 + head * 32 + kc];
    cx.ba = p.d_alpha_b[(l * 2 + ldir) * 128 + head * 32 + kc];
  } else {
    float lb = 0.f;
    if (l > 0) {
      const float x0 = p.b_lb_logits[(ldir * 2 + 0) * 256 + head * 64 + lane], x1 = p.b_lb_logits[(ldir * 2 + 1) * 256 + head * 64 + lane];
      lb = 1.f / (1.f + __expf(x0 - x1));
    }
    cx.lbm = fmaxf(lb, 1e-30f); cx.oml = 1.f - lb;
  }
}
template <bool GLA>
DI float scan_la(const ScanCtx<GLA>& cx, const u16* kraw, const u16* rt, int pp, int lane, float& kk) {
  if (GLA) {
    const u32x4 r0 = *(const u32x4*)(rt + pp * 32 + cx.ldir * 16), r1 = *(const u32x4*)(rt + pp * 32 + cx.ldir * 16 + 8);
    float v = cx.ba;
#pragma unroll
    for (int q = 0; q < 4; ++q) {
      v += cx.wa[2 * q] * lo_bf(r0[q]) + cx.wa[2 * q + 1] * hi_bf(r0[q]);
      v += cx.wa[8 + 2 * q] * lo_bf(r1[q]) + cx.wa[8 + 2 * q + 1] * hi_bf(r1[q]);
    }
    kk = bf2f(kraw[pp * 72 + lane]);
    return (fminf(v, 0.f) - __logf(1.f + __expf(-fabsf(v)))) * (1.f / 16.f);
  } else {
    const float zz = bf2f(kraw[pp * 72 + lane]);
    const float sig = 1.f / (1.f + __expf(-zz));
    kk = cx.oml / (1.f + __expf(zz));
    return __logf(cx.lbm + cx.oml * sig);
  }
}
DI void stage64(u16* dst, const u16* z, int start, int col, int lane) {
  u32x4 v[4];
#pragma unroll
  for (int i = 0; i < 4; ++i) v[i] = *(const u32x4*)(z + (size_t)(start + (lane >> 3) + 8 * i) * INW + col + (lane & 7) * 8);
#pragma unroll
  for (int i = 0; i < 4; ++i) *(u32x4*)(dst + ((lane >> 3) + 8 * i) * 72 + (lane & 7) * 8) = v[i];
}
DI void stage32dup(u16* dst, const u16* z, int start, int col, int lane) {
  const int row = lane >> 1, c16 = (lane & 1) * 16;
  const u16* sp = z + (size_t)(start + row) * INW + col + c16;
  const u32x4 v0 = *(const u32x4*)sp, v1 = *(const u32x4*)(sp + 8);
  *(u32x4*)(dst + row * 72 + c16) = v0; *(u32x4*)(dst + row * 72 + c16 + 8) = v1;
  *(u32x4*)(dst + row * 72 + 32 + c16) = v0; *(u32x4*)(dst + row * 72 + 32 + c16 + 8) = v1;
}
DI void stage_r(u16* rt, const u16* z, int start, int lane) {
  const int row = lane >> 1, c16 = (lane & 1) * 16;
  const u16* sp = z + (size_t)(start + row) * INW + ZD_RF + c16;
  const u32x4 v0 = *(const u32x4*)sp, v1 = *(const u32x4*)(sp + 8);
  *(u32x4*)(rt + row * 32 + c16) = v0; *(u32x4*)(rt + row * 32 + c16 + 8) = v1;
}
DI int tile_id(bool gla, int chunk, int head, int dir) { return gla ? 1536 + chunk * 4 + head : (chunk * 4 + head) * 2 + dir; }

constexpr int S1_WAVE_U16 = 2 * 32 * 72 + 32 * 32;
template <bool GLA>
DI void scan_s1(const Params& p, int l, int chunk, int head, int dir, u16* smw) {
  const int lane = tid_() & 63, r = lane & 31, h = lane >> 5;
  const int i16 = lane & 15, tq = i16 >> 2, tp = i16 & 3, blk = (lane >> 4) & 1;
  u16* ko = smw;
  u16* vt = smw + 32 * 72;
  u16* rt = smw + 2 * 32 * 72;
  const int start = chunk * 32;
  const u16* z = (const u16*)(p.ws + WS_Z);
  stage64(vt, z, start, (GLA ? ZD_V : ZB_I) + head * 64, lane);
  if (GLA) { stage32dup(ko, z, start, ZD_K + head * 32, lane); stage_r(rt, z, start, lane); }
  else stage64(ko, z, start, (dir ? ZB_FB : ZB_FF) + head * 64, lane);
  ScanCtx<GLA> cx;
  scan_init<GLA>(p, l, head, dir, lane, cx);
  __syncthreads();
  {
    const int ldir = cx.ldir;
    float cl = 0.f, kk;
#pragma unroll 8
    for (int i = 0; i < 32; ++i) cl += scan_la<GLA>(cx, ko, rt, ldir ? 31 - i : i, lane, kk);
    float cum = 0.f;
#pragma unroll 8
    for (int i = 0; i < 32; ++i) {
      const int pp = ldir ? 31 - i : i;
      cum += scan_la<GLA>(cx, ko, rt, pp, lane, kk);
      ko[pp * 72 + lane] = f2bf(kk * __expf(cl - cum));
    }
    ((float*)(p.ws + WS_CL))[tile_id(GLA, chunk, head, dir) * 64 + lane] = cl;
  }
  __syncthreads();
  f32x16 acc[2][2];
  zero_acc<2>(acc);
#pragma unroll
  for (int st = 0; st < 2; ++st) {
    bf16x8 a[2], b[2];
#pragma unroll
    for (int x = 0; x < 2; ++x) {
      const u16* ap = vt + (16 * st + 8 * h + tq) * 72 + x * 32 + 16 * blk + 4 * tp;
      a[x] = trpair(ap, ap + 4 * 72);
      const u16* bp = ko + (16 * st + 8 * h + tq) * 72 + x * 32 + 16 * blk + 4 * tp;
      b[x] = trpair(bp, bp + 4 * 72);
    }
#pragma unroll
    for (int x = 0; x < 2; ++x)
#pragma unroll
      for (int y = 0; y < 2; ++y) acc[x][y] = MFMA(a[x], b[y], acc[x][y]);
  }
  {
    float* U = (float*)(p.ws + WS_U) + (size_t)tile_id(GLA, chunk, head, dir) * 4096;
#pragma unroll
    for (int x = 0; x < 2; ++x)
#pragma unroll
      for (int y = 0; y < 2; ++y)
#pragma unroll
        for (int e = 0; e < 16; ++e) U[(x * 32 + crow(e, h)) * 64 + y * 32 + r] = acc[x][y][e];
  }
  __syncthreads();
}
DI void scan_s1_block(const Params& p, int l, int bitem, char* sm) {
  const int w = tid_() >> 6;
  int wi = bitem * 4 + w;
  u16* smw = (u16*)sm + w * S1_WAVE_U16;
  if (bitem < 384) scan_s1<false>(p, l, wi >> 3, (wi >> 1) & 3, wi & 1, smw);
  else { wi -= 1536; scan_s1<true>(p, l, wi >> 2, wi & 3, 0, smw); }
}

DI void scan_s2_item(const Params& p, int l, int item) {
  const int t = tid_();
  const int unit = item >> 2, vq = item & 3;
  const bool gla = unit >= 144;
  int seq, head, dir;
  if (!gla) { seq = unit >> 3; head = (unit >> 1) & 3; dir = unit & 1; }
  else { const int g = unit - 144; seq = g >> 2; head = g & 3; dir = 0; }
  const int c = t & 63;
  const int dc = gla ? (c >> 5) : dir;
  int N, chunk0;
  if (seq < 16) { N = 8; chunk0 = seq * 8; } else { N = 32; chunk0 = 128 + (seq - 16) * 32; }
  float S[4];
  int vv[4];
#pragma unroll
  for (int i = 0; i < 4; ++i) {
    vv[i] = vq * 16 + (t >> 6) + 4 * i;
    if (seq < 16) S[i] = 0.f;
    else {
      const int b = seq - 16;
      S[i] = gla ? p.state_gla[(size_t)(((b * 2 + l) * 2 + dc) * 4 + head) * 2048 + (c & 31) * 64 + vv[i]]
                 : p.state_hgrn[(size_t)(((b * 2 + l) * 2 + dc) * 4 + head) * 4096 + c * 64 + vv[i]];
    }
  }
  const float* __restrict__ U = (const float*)(p.ws + WS_U);
  const float* __restrict__ CL = (const float*)(p.ws + WS_CL);
  float* __restrict__ SS = (float*)(p.ws + WS_S);
  for (int m0 = 0; m0 < N; m0 += 4) {
    float tmp[4][4], a[4];
    int ids[4];
#pragma unroll
    for (int mm = 0; mm < 4; ++mm) {
      const int m = m0 + mm;
      ids[mm] = tile_id(gla, chunk0 + (dc ? N - 1 - m : m), head, dir);
      a[mm] = CL[ids[mm] * 64 + c];
#pragma unroll
      for (int i = 0; i < 4; ++i) tmp[mm][i] = U[(size_t)ids[mm] * 4096 + vv[i] * 64 + c];
    }
#pragma unroll
    for (int mm = 0; mm < 4; ++mm) {
      const float ea = __expf(a[mm]);
#pragma unroll
      for (int i = 0; i < 4; ++i) {
        SS[(size_t)ids[mm] * 4096 + vv[i] * 64 + c] = S[i];
        S[i] = ea * S[i] + tmp[mm][i];
      }
    }
  }
  if (seq < 16) {
#pragma unroll
    for (int i = 0; i < 4; ++i) {
      if (gla) p.out[O_SG + (size_t)(((seq * 2 + l) * 2 + dc) * 4 + head) * 2048 + (c & 31) * 64 + vv[i]] = S[i];
      else p.out[O_SH + (size_t)(((seq * 2 + l) * 2 + dc) * 4 + head) * 4096 + c * 64 + vv[i]] = S[i];
    }
  }
}

constexpr int S3_WAVE_U16 = 3 * 32 * 72 + 128 + 32 * 32;
template <bool GLA>
DI void scan_s3(const Params& p, int l, int chunk, int head, u16* smw) {
  const int lane = tid_() & 63, r = lane & 31, h = lane >> 5;
  const int i16 = lane & 15, tq = i16 >> 2, tp = i16 & 3, blk = (lane >> 4) & 1;
  u16* qt = smw;
  u16* kt = smw + 32 * 72;
  u16* vt = smw + 2 * 32 * 72;
  float* sref = (float*)(smw + 3 * 32 * 72);
  u16* rt = smw + 3 * 32 * 72 + 128;
  const int start = chunk * 32;
  const u16* z = (const u16*)(p.ws + WS_Z);
  stage64(vt, z, start, (GLA ? ZD_V : ZB_I) + head * 64, lane);
  if (GLA) stage_r(rt, z, start, lane);
  f32x16 o[2];
#pragma unroll
  for (int x = 0; x < 2; ++x)
#pragma unroll
    for (int e = 0; e < 16; ++e) o[x][e] = 0.f;
  constexpr int NPASS = GLA ? 1 : 2;
#pragma unroll 1
  for (int pass = 0; pass < NPASS; ++pass) {
    if (GLA) { stage32dup(qt, z, start, ZD_Q + head * 32, lane); stage32dup(kt, z, start, ZD_K + head * 32, lane); }
    else { stage64(qt, z, start, ZB_Q + head * 64, lane); stage64(kt, z, start, (pass ? ZB_FB : ZB_FF) + head * 64, lane); }
    const float* Sg = (const float*)(p.ws + WS_S) + (size_t)tile_id(GLA, chunk, head, pass) * 4096;
    ScanCtx<GLA> cx;
    scan_init<GLA>(p, l, head, pass, lane, cx);
    __syncthreads();
    {
      const int ldir = cx.ldir;
      float ref = 0.f, kk, cum = 0.f;
#pragma unroll 8
      for (int i = 0; i < 16; ++i) ref += scan_la<GLA>(cx, kt, rt, ldir ? 31 - i : i, lane, kk);
      sref[lane] = __expf(ref);
#pragma unroll 8
      for (int i = 0; i < 32; ++i) {
        const int pp = ldir ? 31 - i : i;
        cum += scan_la<GLA>(cx, kt, rt, pp, lane, kk);
        const float zq = bf2f(qt[pp * 72 + lane]);
        const float qv = GLA ? zq * 0.17677669529663687f : zq * sigmoidf_(zq);
        qt[pp * 72 + lane] = f2bf(qv * __expf(cum - ref));
        kt[pp * 72 + lane] = f2bf(kk * __expf(ref - cum));
      }
    }
    __syncthreads();
    constexpr int NS = GLA ? 2 : 1;
    f32x16 sc[NS];
#pragma unroll
    for (int m = 0; m < NS; ++m)
#pragma unroll
      for (int e = 0; e < 16; ++e) sc[m][e] = 0.f;
    bf16x8 qfr[4];
#pragma unroll
    for (int st = 0; st < 4; ++st) {
      qfr[st] = *(const bf16x8*)(qt + r * 72 + 16 * st + 8 * h);
      const bf16x8 kf = *(const bf16x8*)(kt + r * 72 + 16 * st + 8 * h);
      const int m = GLA ? (st >> 1) : 0;
      sc[m] = MFMA(kf, qfr[st], sc[m]);
    }
#pragma unroll
    for (int m = 0; m < NS; ++m) {
      const int d = GLA ? m : pass;
#pragma unroll
      for (int e = 0; e < 16; ++e) {
        const int srow = crow(e, h);
        const bool keep = d ? (srow >= r) : (srow <= r);
        sc[m][e] = keep ? sc[m][e] : 0.f;
      }
#pragma unroll
      for (int st = 0; st < 2; ++st) {
        const bf16x8 pf = pack8(sc[m], st);
#pragma unroll
        for (int x = 0; x < 2; ++x) {
          const u16* vp = vt + (16 * st + 4 * h + tq) * 72 + x * 32 + 16 * blk + 4 * tp;
          const bf16x8 vf = trpair(vp, vp + 8 * 72);
          o[x] = MFMA(vf, pf, o[x]);
        }
      }
    }
#pragma unroll
    for (int x = 0; x < 2; ++x) {
      float4 s0[4], s1[4];
#pragma unroll
      for (int st = 0; st < 4; ++st) {
        const float* sp = Sg + (x * 32 + r) * 64 + 16 * st + 8 * h;
        s0[st] = *(const float4*)sp; s1[st] = *(const float4*)(sp + 4);
      }
#pragma unroll
      for (int st = 0; st < 4; ++st) {
        const float4 e0 = *(const float4*)(sref + 16 * st + 8 * h), e1 = *(const float4*)(sref + 16 * st + 8 * h + 4);
        u32x4 q;
        q[0] = pack2(s0[st].x * e0.x, s0[st].y * e0.y); q[1] = pack2(s0[st].z * e0.z, s0[st].w * e0.w);
        q[2] = pack2(s1[st].x * e1.x, s1[st].y * e1.y); q[3] = pack2(s1[st].z * e1.z, s1[st].w * e1.w);
        o[x] = MFMA(__builtin_bit_cast(bf16x8, q), qfr[st], o[x]);
      }
    }
    __syncthreads();
  }
  float ss = 0.f;
#pragma unroll
  for (int x = 0; x < 2; ++x)
#pragma unroll
    for (int e = 0; e < 16; ++e) ss += o[x][e] * o[x][e];
  ss += __shfl_xor(ss, 32);
  const float rstd = rsqrtf(ss * (1.f / 64.f) + EPSN);
  const int tok = start + r;
  const float* gn = (GLA ? p.d_norm_g : p.b_norm_g) + l * 64;
  const u16* gz = z + (size_t)tok * INW + (GLA ? ZD_G : ZB_G) + head * 64;
  u16* yc = (u16*)(p.ws + WS_YCAT) + (size_t)tok * 1024 + (GLA ? 768 : 256) + head * 64;
#pragma unroll
  for (int x = 0; x < 2; ++x)
#pragma unroll
    for (int g = 0; g < 4; ++g) {
      const int v0 = x * 32 + 8 * g + 4 * h;
      const u32x2 gr = *(const u32x2*)(gz + v0);
      const float g0 = lo_bf(gr[0]), g1 = hi_bf(gr[0]), g2 = lo_bf(gr[1]), g3 = hi_bf(gr[1]);
      u32x2 q;
      q[0] = pack2(o[x][4 * g] * rstd * gn[v0] * g0 * sigmoidf_(g0), o[x][4 * g + 1] * rstd * gn[v0 + 1] * g1 * sigmoidf_(g1));
      q[1] = pack2(o[x][4 * g + 2] * rstd * gn[v0 + 2] * g2 * sigmoidf_(g2), o[x][4 * g + 3] * rstd * gn[v0 + 3] * g3 * sigmoidf_(g3));
      *(u32x2*)(yc + v0) = q;
    }
}
DI void scan_s3_block(const Params& p, int l, int bitem, char* sm) {
  const int w = tid_() >> 6;
  u16* smw = (u16*)sm + w * S3_WAVE_U16;
  int wi = bitem * 4 + w;
  if (bitem < 192) scan_s3<false>(p, l, wi >> 2, wi & 3, smw);
  else { wi -= 768; scan_s3<true>(p, l, wi >> 2, wi & 3, smw); }
}

DI void run_phase(const Params& p, int ph, char* sm, bool dry) {
  const int bid = blockIdx.x, nb = gridDim.x;
#ifdef PHASE_ONLY
  if (ph != 0 && (ph - 1) % 11 != PHASE_ONLY - 1) return;
  if (ph == 0 && PHASE_ONLY != 0) return;
#endif
  if (ph == 0) {
    for (int it = bid; it < MOD_ITEMS + CONVW_ITEMS; it += nb) {
      if (it < MOD_ITEMS) mod_item(p, it, sm); else convw_item(p, 0, it - MOD_ITEMS, sm);
    }
    return;
  }
  const int l = (ph - 1) / 11, s = (ph - 1) % 11;
  switch (s) {
    case 0: {
      const int w = tid_() >> 6;
      for (int tk = bid * 4 + w; tk < NTOK; tk += nb * 4) norm_tok(p, l, 0, tk);
      if (l > 0) for (int it = bid; it < CONVW_ITEMS; it += nb) convw_item(p, l, it, sm);
    } break;
    case 1: for (int it = bid; it < 48 * 59; it += nb) gemm_in_item(p, it, sm); break;
    case 2:
      for (int it = bid; it < 576 + 1792; it += nb) {
        if (it < 576) scan_s1_block(p, l, it, sm); else prep_wave(p, l, (it - 576) * 4 + (tid_() >> 6));
      }
      break;
    case 3:
      for (int it = bid; it < 640 + 864; it += nb) {
        if (it < 384) attn_dispatch(p, l, it, sm);
        else if (it < 384 + 864) scan_s2_item(p, l, it - 384);
        else attn_dispatch(p, l, it - 864, sm);
      }
      break;
    case 4:
      for (int it = bid; it < 384 + 1024; it += nb) {
        if (it < 384) scan_s3_block(p, l, it, sm); else attn_combine(p, l, (it - 384) * 4 + (tid_() >> 6));
      }
      break;
    case 5: for (int it = bid; it < 768; it += nb) gemm_branch_item(p, it, sm); break;
    case 6: for (int it = bid; it < 384; it += nb) gemm_out_item(p, l, it, sm, dry); break;
    case 7: {
      const int w = tid_() >> 6;
      for (int tk = bid * 4 + w; tk < NTOK; tk += nb * 4) norm_tok(p, l, 1, tk);
    } break;
    case 8: for (int it = bid; it < 48 * 44; it += nb) gemm_up_item(p, it, sm); break;
    case 9: conv_act(p, l, bid * 256 + tid_(), nb * 256); break;
    case 10: for (int it = bid; it < 384; it += nb) gemm_down_item(p, l, it, sm, dry); break;
  }
}

__global__ void __launch_bounds__(256, 2) fwd_mega(Params p) {
  __shared__ __attribute__((aligned(16))) char sm[SMEM_BYTES];
  __shared__ uint4 xb_words;
  cg::grid_group grid = cg::this_grid();
  if (p.coop == 2) grid.sync();
  if (__builtin_amdgcn_workitem_id_x() == 0) xb_words = make_uint4(0u, 0u, 0u, 0u);
  __syncthreads();
  XcdBarrier xb;
  if (p.coop) xb = xcd_barrier_post((unsigned*)(p.ws + WS_BAR), (volatile LAS unsigned*)&xb_words);
  for (int ph = p.phase_begin; ph < p.phase_end; ++ph) {
    if (ph > p.phase_begin && p.coop) xcd_barrier(xb);
    const int stepid = ph == 0 ? 11 : (ph - 1) % 11;
    const int reps = (stepid == p.pad - 1) ? 2 : 1;
    for (int rep = 0; rep < reps; ++rep) {
      if (rep && p.coop) xcd_barrier(xb);
      run_phase(p, ph, sm, false);
    }
  }
}

extern "C" void kernel_launch(void* const* d_in, const int* in_sizes, int n_in, void* d_out, int out_size, void* d_ws,
                              size_t ws_size, hipStream_t stream) {
  static int grid_blocks = 0;
  if (!grid_blocks) {
    int dev = 0, cus = 0, per_cu = 0;
    hipGetDevice(&dev);
    hipDeviceGetAttribute(&cus, hipDeviceAttributeMultiprocessorCount, dev);
    hipOccupancyMaxActiveBlocksPerMultiprocessor(&per_cu, fwd_mega, 256, 0);
    if (per_cu > 2) per_cu = 2;
    if (per_cu < 1) per_cu = 1;
    grid_blocks = cus * per_cu;
  }
  Params p{};
  const float** pp = (const float**)&p;
  for (int i = 0; i < 32; ++i) pp[i] = (const float*)d_in[i];
  p.out = (float*)d_out;
  p.ws = (char*)d_ws;
  if (ws_size < WS_END) { fprintf(stderr, "workspace too small: %zu < %zu\n", ws_size, (size_t)WS_END); return; }
#if MULTI
  for (int ph = 0; ph < NPHASE; ++ph) {
    p.phase_begin = ph; p.phase_end = ph + 1; p.coop = 0; p.pad = 0;
    hipLaunchKernelGGL(fwd_mega, dim3(grid_blocks), dim3(256), 0, stream, p);
  }
#else
  p.phase_begin = 0; p.phase_end = NPHASE; p.coop = 1; p.pad = PROBE_STEP + 1;
  hipMemsetAsync((char*)d_ws + WS_BAR, 0, 16384, stream);
  void* args[] = {&p};
  hipError_t e = hipLaunchCooperativeKernel((void*)fwd_mega, dim3(grid_blocks), dim3(256), args, 0, stream);
  if (e != hipSuccess) fprintf(stderr, "cooperative launch failed: %s (grid %d)\n", hipGetErrorString(e), grid_blocks);
#endif
}
```

```cpp
#include <hip/hip_runtime.h>
#include <hip/hip_bf16.h>
#include <hip/hip_cooperative_groups.h>
#include <cstdio>
namespace cg = cooperative_groups;

#ifndef MULTI
#define MULTI 0
#endif
#ifndef PROBE_STEP
#define PROBE_STEP -1
#endif

#define DI __device__ __forceinline__
typedef unsigned short u16;
using bf16x8 = __attribute__((ext_vector_type(8))) short;
using s16x4  = __attribute__((ext_vector_type(4))) short;
using f32x16 = __attribute__((ext_vector_type(16))) float;
using u32x4  = __attribute__((ext_vector_type(4))) unsigned;
using u32x2  = __attribute__((ext_vector_type(2))) unsigned;
#define MFMA(a, b, c) __builtin_amdgcn_mfma_f32_32x32x16_bf16((a), (b), (c), 0, 0, 0)

constexpr int NTOK = 6144, NCTX = 4096, DM = 1024, INW = 7456, DFF = 2816, DFF2 = 5632;
constexpr int ZA_Q = 0, ZA_K = 256, ZA_V = 384, ZC_Q = 512, ZC_K = 768, ZC_V = 1024, ZB_Q = 1280, ZB_I = 1536, ZB_FF = 1792,
              ZB_FB = 2048, ZB_G = 2304, ZD_Q = 2560, ZD_K = 2688, ZD_V = 2816, ZD_G = 3072, ZD_RF = 3328, Z_ML = 3360;
constexpr float EPSN = 1e-6f;
constexpr size_t O_CAK = 6291456, O_CAV = 7340032, O_CCK = 8388608, O_CCV = 10485760, O_SH = 12582912, O_SG = 13631488;
constexpr size_t WS_WIN = 0;
constexpr size_t WS_WBR = WS_WIN + (size_t)INW * 1024 * 2;
constexpr size_t WS_WOUT = WS_WBR + (size_t)4 * 1024 * 256 * 2;
constexpr size_t WS_WUP = WS_WOUT + (size_t)1024 * 1024 * 2;
constexpr size_t WS_WDN = WS_WUP + (size_t)DFF2 * 1024 * 2;
constexpr size_t WS_MOD = WS_WDN + (size_t)1024 * DFF * 2;
constexpr size_t WS_H = WS_MOD + (size_t)2 * 3 * 6144 * 4;
constexpr size_t WS_Z = WS_H + (size_t)NTOK * 1024 * 2;
constexpr size_t WS_QA = WS_Z + (size_t)NTOK * INW * 2;
constexpr size_t WS_QC = WS_QA + (size_t)NTOK * 256 * 2;
constexpr size_t WS_KA = WS_QC + (size_t)NTOK * 256 * 2;
constexpr size_t WS_VA = WS_KA + (size_t)7168 * 128 * 2;
constexpr size_t WS_KC = WS_VA + (size_t)7168 * 128 * 2;
constexpr size_t WS_VC = WS_KC + (size_t)7168 * 256 * 2;
constexpr size_t WS_YCAT = WS_VC + (size_t)7168 * 256 * 2;
constexpr size_t WS_ACT = WS_YCAT + (size_t)NTOK * 1024 * 2;
constexpr size_t WS_MIX = WS_ACT + (size_t)NTOK * DFF * 2;
constexpr size_t WS_CL = WS_MIX + (size_t)NTOK * 1024 * 2;
constexpr size_t WS_U = WS_ACT;
constexpr size_t WS_S = WS_CL + (size_t)2304 * 64 * 4;
constexpr size_t WS_BAR = WS_S + (size_t)2304 * 4096 * 4;
constexpr size_t WS_PA = WS_BAR + 16384;
constexpr size_t WS_PML = WS_PA + (size_t)3 * 2048 * 4 * 64 * 4;
constexpr size_t WS_END = WS_PML + (size_t)3 * 2048 * 8 * 2 * 2 * 4;
constexpr size_t WS_PC = WS_H;
static_assert((size_t)2304 * 4096 * 4 <= (size_t)NTOK * DFF * 2 + (size_t)NTOK * 1024 * 2, "U alias");
static_assert(WS_END <= (size_t)256 * 1024 * 1024, "ws budget");
constexpr int SMEM_BYTES = 73728;
constexpr int NPHASE = 23;

struct Params {
  const float *x_prompt, *x_sample, *cache_a_k, *cache_a_v, *cache_c_k, *cache_c_v, *state_hgrn, *state_gla, *c, *c_ctx,
      *w_ada, *b_ada, *norm1_g, *norm2_g, *w_in, *a_qn_g, *a_kn_g, *c_qn_g, *c_kn_g, *c_lambda, *c_subln_g, *b_lb_logits,
      *b_norm_g, *d_alpha_w, *d_alpha_b, *d_norm_g, *w_branch, *w_out, *w_up, *conv_w, *conv_b, *w_down;
  float* out;
  char* ws;
  int phase_begin, phase_end, coop, pad;
};

DI int tid_() { int t = __builtin_amdgcn_workitem_id_x(); asm volatile("" : "+v"(t)); return t; }
DI float bf2f(u16 u) { return __uint_as_float(((unsigned)u) << 16); }
DI u16 f2bf(float a) { __hip_bfloat16 b = __float2bfloat16(a); return *(u16*)&b; }
DI unsigned pack2(float a, float b) { __hip_bfloat162 q = __float22bfloat162_rn(make_float2(a, b)); return *(unsigned*)&q; }
DI float lo_bf(unsigned u) { return __uint_as_float(u << 16); }
DI float hi_bf(unsigned u) { return __uint_as_float(u & 0xffff0000u); }
DI float sigmoidf_(float x) { return 1.f / (1.f + __expf(-x)); }
DI int crow(int e, int h) { return (e & 3) + 8 * (e >> 2) + 4 * h; }
DI bf16x8 pack8(const f32x16& x, int s) {
  u32x4 q;
  q[0] = pack2(x[8 * s + 0], x[8 * s + 1]); q[1] = pack2(x[8 * s + 2], x[8 * s + 3]);
  q[2] = pack2(x[8 * s + 4], x[8 * s + 5]); q[3] = pack2(x[8 * s + 6], x[8 * s + 7]);
  return __builtin_bit_cast(bf16x8, q);
}
DI s16x4 trread(const u16* pl) {
  return __builtin_amdgcn_ds_read_tr16_b64_v4i16((__attribute__((address_space(3))) s16x4*)pl);
}
DI bf16x8 trpair(const u16* p0, const u16* p1) {
  s16x4 a = trread(p0), b = trread(p1);
  return __builtin_shufflevector(a, b, 0, 1, 2, 3, 4, 5, 6, 7);
}
DI float wave_sum(float v) {
#pragma unroll
  for (int o = 32; o >= 1; o >>= 1) v += __shfl_xor(v, o);
  return v;
}
DI int tok_cond(int t) { return t < NCTX ? 0 : 1 + ((t - NCTX) >> 10); }
DI const float* xin_row(const Params& p, int l, int tok) {
  if (l > 0) return p.out + (size_t)tok * DM;
  return tok < NCTX ? p.x_prompt + (size_t)tok * DM : p.x_sample + (size_t)(tok - NCTX) * DM;
}


#define XB_TMO      128
#define XB_XCNT(j)  (256  + 64 * (j))
#define XB_XSUB(j)  (1280 + 64 * (j))
#define XB_XGEN(j)  (2304 + 64 * (j))
#define XB_TOP      3328
#define XB_TOPGEN   3392
#define XCD_BAR_WORDS 3456
#define XB_SPIN_CAP (1u << 22)
#define LAS __attribute__((address_space(3)))
DI unsigned xb_ld(unsigned* p) { return __hip_atomic_load(p, __ATOMIC_RELAXED, __HIP_MEMORY_SCOPE_AGENT); }
DI unsigned xb_add(unsigned* p, unsigned v) { return __hip_atomic_fetch_add(p, v, __ATOMIC_RELAXED, __HIP_MEMORY_SCOPE_AGENT); }
DI unsigned xb_xcc_id() { return (unsigned)__builtin_amdgcn_s_getreg((3 << 11) | 20) & 0xFu; }
#define XB_SPIN(cond, bar) do { unsigned _sp = 0; while (cond) { __builtin_amdgcn_s_sleep(1); \
    if ((++_sp & 255u) == 0u) { if (xb_ld(&(bar)[XB_TMO])) break; if (_sp > XB_SPIN_CAP) { atomicAdd(&(bar)[XB_TMO], 1u); break; } } } } while (0)
struct XcdBarrier { unsigned* bar; unsigned x; volatile LAS unsigned* st; };
DI XcdBarrier xcd_barrier_post(unsigned* bar, volatile LAS unsigned* st) {
  XcdBarrier b; b.bar = bar; b.x = xb_xcc_id(); b.st = st;
  if (__builtin_amdgcn_workitem_id_x() == 0) (void)xb_add(&bar[XB_XCNT(b.x)], 1u);
  return b;
}
DI void xcd_barrier_complete(unsigned* bar, unsigned x, unsigned& nloc, unsigned& nx) {
  const unsigned G = gridDim.x * gridDim.y * gridDim.z;
  unsigned sum, cnt, mine, sp = 0u;
  for (;;) {
    sum = 0u; cnt = 0u; mine = 0u;
#pragma unroll
    for (unsigned j = 0; j < 16; ++j) { const unsigned c = xb_ld(&bar[XB_XCNT(j)]); sum += c; cnt += (c > 0u) ? 1u : 0u; mine = (j == x) ? c : mine; }
    if (sum == G) break;
    __builtin_amdgcn_s_sleep(1);
    if ((++sp & 255u) == 0u) { if (xb_ld(&bar[XB_TMO])) break; if (sp > XB_SPIN_CAP) { atomicAdd(&bar[XB_TMO], 1u); break; } }
  }
  nloc = mine > 0u ? mine : 1u; nx = cnt > 0u ? cnt : 1u;
}
DI void xcd_barrier(const XcdBarrier& b) {
  asm volatile("s_waitcnt vmcnt(0)" ::: "memory");
  __syncthreads();
  if (__builtin_amdgcn_workitem_id_x() == 0) {
    unsigned* bar = b.bar;
    __builtin_amdgcn_s_waitcnt(0);
    unsigned nloc = b.st[0], nx = b.st[1];
    if (nloc == 0u) { xcd_barrier_complete(bar, b.x, nloc, nx); b.st[0] = nloc; b.st[1] = nx; }
    const unsigned old = xb_add(&bar[XB_XSUB(b.x)], 1u);
    const unsigned gen = old / nloc;
    if (old + 1u == (gen + 1u) * nloc) {
      __builtin_amdgcn_fence(__ATOMIC_RELEASE, "agent");
      asm volatile("s_waitcnt vmcnt(0)" ::: "memory");
      const unsigned og = xb_add(&bar[XB_TOP], 1u);
      const unsigned tg = og / nx;
      if (og + 1u == (tg + 1u) * nx) xb_add(&bar[XB_TOPGEN], 1u);
      else XB_SPIN(xb_ld(&bar[XB_TOPGEN]) == tg, bar);
      __builtin_amdgcn_fence(__ATOMIC_ACQUIRE, "agent");
      xb_add(&bar[XB_XGEN(b.x)], 1u);
      asm volatile("s_waitcnt vmcnt(0)" ::: "memory");
    } else {
      XB_SPIN(xb_ld(&bar[XB_XGEN(b.x)]) == gen, bar);
      __builtin_amdgcn_fence(__ATOMIC_ACQUIRE, "agent");
      asm volatile("s_waitcnt vmcnt(0)" ::: "memory");
    }
  }
  __syncthreads();
}

DI void convw_tile(const float* __restrict__ src, u16* __restrict__ dst, int K, int N, int item, float* T) {
  const int t = tid_();
  const int ntn = (N + 63) >> 6;
  const int n0 = (item % ntn) * 64, k0 = (item / ntn) * 64;
  {
    const int n4 = (t & 15) * 4;
    float4 v[4];
#pragma unroll
    for (int i = 0; i < 4; ++i) {
      const int kl = (t >> 4) + 16 * i;
      v[i] = (n0 + n4 < N) ? *(const float4*)(src + (size_t)(k0 + kl) * N + n0 + n4) : make_float4(0.f, 0.f, 0.f, 0.f);
    }
#pragma unroll
    for (int i = 0; i < 4; ++i) {
      const int kl = (t >> 4) + 16 * i;
      T[(n4 + 0) * 65 + kl] = v[i].x; T[(n4 + 1) * 65 + kl] = v[i].y;
      T[(n4 + 2) * 65 + kl] = v[i].z; T[(n4 + 3) * 65 + kl] = v[i].w;
    }
  }
  __syncthreads();
  {
    const int n = t >> 2, k16 = (t & 3) * 16;
    const float* tr = T + n * 65 + k16;
    u32x4 q0, q1;
    q0[0] = pack2(tr[0], tr[1]); q0[1] = pack2(tr[2], tr[3]); q0[2] = pack2(tr[4], tr[5]); q0[3] = pack2(tr[6], tr[7]);
    q1[0] = pack2(tr[8], tr[9]); q1[1] = pack2(tr[10], tr[11]); q1[2] = pack2(tr[12], tr[13]); q1[3] = pack2(tr[14], tr[15]);
    if (n0 + n < N) {
      u16* dp = dst + (size_t)(n0 + n) * K + k0 + k16;
      *(u32x4*)dp = q0; *(u32x4*)(dp + 8) = q1;
    }
  }
  __syncthreads();
}
constexpr int CONVW_ITEMS = 1872 + 256 + 256 + 1408 + 704;
DI void convw_item(const Params& p, int l, int item, char* sm) {
  float* T = (float*)sm;
  char* ws = p.ws;
  if (item < 1872) convw_tile(p.w_in + (size_t)l * 1024 * INW, (u16*)(ws + WS_WIN), 1024, INW, item, T);
  else if (item < 2128) convw_tile(p.w_branch + (size_t)l * 1024 * 1024, (u16*)(ws + WS_WBR), 1024, 1024, item - 1872, T);
  else if (item < 2384) convw_tile(p.w_out + (size_t)l * 1024 * 1024, (u16*)(ws + WS_WOUT), 1024, 1024, item - 2128, T);
  else if (item < 3792) convw_tile(p.w_up + (size_t)l * 1024 * DFF2, (u16*)(ws + WS_WUP), 1024, DFF2, item - 2384, T);
  else convw_tile(p.w_down + (size_t)l * DFF * 1024, (u16*)(ws + WS_WDN), DFF, 1024, item - 3792, T);
}

constexpr int MOD_ITEMS = 384;
DI void mod_item(const Params& p, int item, char* sm) {
  float* sc = (float*)sm;
  float* red = sc + 3072;
  const int t = tid_();
  const int l = item / 192, j0 = (item % 192) * 32;
  for (int i = t; i < 3072; i += 256) {
    const int cnd = i >> 10, k = i & 1023;
    const float v = cnd == 0 ? p.c_ctx[k] : p.c[(cnd - 1) * 1024 + k];
    sc[i] = v * sigmoidf_(v);
  }
  __syncthreads();
  const int cq = t & 7, ks = t >> 3;
  float a0[4] = {0, 0, 0, 0}, a1[4] = {0, 0, 0, 0}, a2[4] = {0, 0, 0, 0};
  const float* wp = p.w_ada + (size_t)l * 1024 * 6144 + j0 + 4 * cq;
#pragma unroll 8
  for (int rr = 0; rr < 32; ++rr) {
    const int row = ks * 32 + rr;
    const float4 w4 = *(const float4*)(wp + (size_t)row * 6144);
    const float s0 = sc[row], s1 = sc[1024 + row], s2 = sc[2048 + row];
    a0[0] += s0 * w4.x; a0[1] += s0 * w4.y; a0[2] += s0 * w4.z; a0[3] += s0 * w4.w;
    a1[0] += s1 * w4.x; a1[1] += s1 * w4.y; a1[2] += s1 * w4.z; a1[3] += s1 * w4.w;
    a2[0] += s2 * w4.x; a2[1] += s2 * w4.y; a2[2] += s2 * w4.z; a2[3] += s2 * w4.w;
  }
#pragma unroll
  for (int q = 0; q < 4; ++q) {
    red[(ks * 3 + 0) * 32 + 4 * cq + q] = a0[q];
    red[(ks * 3 + 1) * 32 + 4 * cq + q] = a1[q];
    red[(ks * 3 + 2) * 32 + 4 * cq + q] = a2[q];
  }
  __syncthreads();
  if (t < 96) {
    const int cnd = t >> 5, col = t & 31;
    float sacc = p.b_ada[l * 6144 + j0 + col];
    for (int k = 0; k < 32; ++k) sacc += red[(k * 3 + cnd) * 32 + col];
    ((float*)(p.ws + WS_MOD))[(l * 3 + cnd) * 6144 + j0 + col] = sacc;
  }
  __syncthreads();
}

DI void norm_tok(const Params& p, int l, int which, int tok) {
  const int lane = tid_() & 63;
  const float* xr = which == 0 ? xin_row(p, l, tok) : p.out + (size_t)tok * DM;
  const float* g = (which == 0 ? p.norm1_g : p.norm2_g) + l * 1024;
  const float* mod = (const float*)(p.ws + WS_MOD) + (l * 3 + tok_cond(tok)) * 6144 + which * 3072;
  float4 v[4];
  float ss = 0.f;
#pragma unroll
  for (int i = 0; i < 4; ++i) {
    v[i] = *(const float4*)(xr + 4 * lane + 256 * i);
    ss += v[i].x * v[i].x + v[i].y * v[i].y + v[i].z * v[i].z + v[i].w * v[i].w;
  }
  ss = wave_sum(ss);
  const float rstd = rsqrtf(ss * (1.f / 1024.f) + EPSN);
  u16* hr = (u16*)(p.ws + WS_H) + (size_t)tok * DM;
#pragma unroll
  for (int i = 0; i < 4; ++i) {
    const int c0 = 4 * lane + 256 * i;
    const float4 gg = *(const float4*)(g + c0);
    const float4 sh = *(const float4*)(mod + c0);
    const float4 scv = *(const float4*)(mod + 1024 + c0);
    u32x2 q;
    q[0] = pack2(v[i].x * rstd * gg.x * (1.f + scv.x) + sh.x, v[i].y * rstd * gg.y * (1.f + scv.y) + sh.y);
    q[1] = pack2(v[i].z * rstd * gg.z * (1.f + scv.z) + sh.z, v[i].w * rstd * gg.w * (1.f + scv.w) + sh.w);
    *(u32x2*)(hr + c0) = q;
  }
}

template <int NJ, bool GATED>
DI void gemm_core(const u16* __restrict__ A, int lda, const u16* __restrict__ Bt, int ldb, int K, int m0, int n0, int N,
                  f32x16 (&acc)[2][NJ], u16* sm, const u16* __restrict__ gz = nullptr, f32x16 (*tot)[NJ] = nullptr) {
  const int t = tid_(), lane = t & 63, w = t >> 6, r = lane & 31, h = lane >> 5;
  const int wm = w & 1, wn = w >> 1;
  u16* As = sm;
  u16* Bs = sm + 2 * 128 * 72;
  const int lrow = t >> 3, lc8 = (t & 7) * 8;
  int aoff[4], boff[2 * NJ];
#pragma unroll
  for (int i = 0; i < 4; ++i) aoff[i] = (m0 + lrow + 32 * i) * lda + lc8;
#pragma unroll
  for (int i = 0; i < 2 * NJ; ++i) {
    int bn = n0 + lrow + 32 * i;
    bn = bn < N ? bn : N - 1;
    boff[i] = bn * ldb + lc8;
  }
  u32x4 ra[2][4], rb[2][2 * NJ];
  const int KT = K >> 6;
  auto gload = [&](int set, int kt) {
    const int k0 = kt * 64;
#pragma unroll
    for (int i = 0; i < 4; ++i) ra[set][i] = *(const u32x4*)(A + aoff[i] + k0);
#pragma unroll
    for (int i = 0; i < 2 * NJ; ++i) rb[set][i] = *(const u32x4*)(Bt + boff[i] + k0);
  };
  auto sstore = [&](int set, int buf) {
    const int nb = buf * 128 * 72;
#pragma unroll
    for (int i = 0; i < 4; ++i) *(u32x4*)(As + nb + (lrow + 32 * i) * 72 + lc8) = ra[set][i];
#pragma unroll
    for (int i = 0; i < 2 * NJ; ++i) *(u32x4*)(Bs + nb + (lrow + 32 * i) * 72 + lc8) = rb[set][i];
  };
  auto compute = [&](int buf) {
    const u16* as = As + buf * 128 * 72 + (wm * 64 + r) * 72 + 8 * h;
    const u16* bs = Bs + buf * 128 * 72 + (wn * 32 * NJ + r) * 72 + 8 * h;
    __builtin_amdgcn_s_setprio(1);
#pragma unroll
    for (int ks = 0; ks < 4; ++ks) {
      const bf16x8 a0 = *(const bf16x8*)(as + ks * 16), a1 = *(const bf16x8*)(as + 32 * 72 + ks * 16);
#pragma unroll
      for (int j = 0; j < NJ; ++j) {
        const bf16x8 b0 = *(const bf16x8*)(bs + j * 32 * 72 + ks * 16);
        acc[0][j] = MFMA(a0, b0, acc[0][j]);
        acc[1][j] = MFMA(a1, b0, acc[1][j]);
      }
    }
    __builtin_amdgcn_s_setprio(0);
  };
  gload(0, 0);
  gload(1, 1);
  sstore(0, 0);
  __syncthreads();
  for (int kt = 0; kt < KT; kt += 2) {
    if (kt + 2 < KT) gload(0, kt + 2);
    compute(0);
    sstore(1, 1);
    __syncthreads();
    if (kt + 3 < KT) gload(1, kt + 3);
    u16 graw[GATED ? 32 * NJ : 1];
    if (GATED && (kt & 3) == 2) {
      const int n = kt >> 2;
#pragma unroll
      for (int i = 0; i < 2; ++i)
#pragma unroll
        for (int j = 0; j < NJ; ++j)
#pragma unroll
          for (int e = 0; e < 16; ++e)
            graw[(i * NJ + j) * 16 + e] = gz[(size_t)(m0 + wm * 64 + i * 32 + crow(e, h)) * INW + n * 1024 + n0 + wn * 32 * NJ + j * 32 + r];
    }
    compute(1);
    if (kt + 2 < KT) sstore(0, 0);
    __syncthreads();
    if (GATED && (kt & 3) == 2) {
#pragma unroll
      for (int i = 0; i < 2; ++i)
#pragma unroll
        for (int j = 0; j < NJ; ++j)
#pragma unroll
          for (int e = 0; e < 16; ++e) {
            tot[i][j][e] += sigmoidf_(bf2f(graw[(i * NJ + j) * 16 + e])) * acc[i][j][e];
            acc[i][j][e] = 0.f;
          }
    }
  }
}
template <int NJ>
DI void zero_acc(f32x16 (&acc)[2][NJ]) {
#pragma unroll
  for (int i = 0; i < 2; ++i)
#pragma unroll
    for (int j = 0; j < NJ; ++j)
#pragma unroll
      for (int e = 0; e < 16; ++e) acc[i][j][e] = 0.f;
}
#define EPI_LOOP_N(NJ_, body)                                                       \
  {                                                                                 \
    const int lane_ = tid_() & 63, w_ = tid_() >> 6, r_ = lane_ & 31, h_ = lane_ >> 5; \
    _Pragma("unroll") for (int i_ = 0; i_ < 2; ++i_)                                 \
    _Pragma("unroll") for (int j_ = 0; j_ < NJ_; ++j_)                               \
    _Pragma("unroll") for (int e_ = 0; e_ < 16; ++e_) {                              \
      const int row = m0 + (w_ & 1) * 64 + i_ * 32 + crow(e_, h_);                  \
      const int col = n0 + (w_ >> 1) * 32 * NJ_ + j_ * 32 + r_;                     \
      body                                                                          \
    }                                                                               \
  }
#define EPI_LOOP(body) EPI_LOOP_N(2, body)

DI void gemm_in_item(const Params& p, int item, char* sm) {
  const int m0 = (item % 48) * 128, n0 = (item / 48) * 128;
  f32x16 acc[2][2];
  zero_acc<2>(acc);
  gemm_core<2, false>((const u16*)(p.ws + WS_H), 1024, (const u16*)(p.ws + WS_WIN), 1024, 1024, m0, n0, INW, acc, (u16*)sm);
  u16* z = (u16*)(p.ws + WS_Z);
  EPI_LOOP(if (col < INW) z[(size_t)row * INW + col] = f2bf(acc[i_][j_][e_]);)
}
DI void gemm_branch_item(const Params& p, int item, char* sm) {
  const int m0 = (item % 48) * 128, n0 = (item / 48) * 64;
  f32x16 tot[2][1], acc[2][1];
  zero_acc<1>(tot);
  zero_acc<1>(acc);
  gemm_core<1, true>((const u16*)(p.ws + WS_YCAT), 1024, (const u16*)(p.ws + WS_WBR), 1024, 1024, m0, n0, 1024, acc, (u16*)sm,
                     (const u16*)(p.ws + WS_Z) + Z_ML, tot);
  u16* mix = (u16*)(p.ws + WS_MIX);
  EPI_LOOP_N(1, mix[(size_t)row * 1024 + col] = f2bf(tot[i_][j_][e_]);)
}
DI void gemm_out_item(const Params& p, int l, int item, char* sm, bool dry) {
  const int m0 = (item % 48) * 128, n0 = (item / 48) * 128;
  f32x16 acc[2][2];
  zero_acc<2>(acc);
  gemm_core<2, false>((const u16*)(p.ws + WS_MIX), 1024, (const u16*)(p.ws + WS_WOUT), 1024, 1024, m0, n0, 1024, acc, (u16*)sm);
  const float* g1 = (const float*)(p.ws + WS_MOD) + (l * 3 + tok_cond(m0)) * 6144 + 2048;
  EPI_LOOP(const float xo = xin_row(p, l, row)[col]; const float xn = xo + g1[col] * acc[i_][j_][e_]; if (!dry) p.out[(size_t)row * DM + col] = xn;)
}
DI void gemm_up_item(const Params& p, int item, char* sm) {
  const int m0 = (item % 48) * 128, n0 = (item / 48) * 128;
  f32x16 acc[2][2];
  zero_acc<2>(acc);
  gemm_core<2, false>((const u16*)(p.ws + WS_H), 1024, (const u16*)(p.ws + WS_WUP), 1024, 1024, m0, n0, DFF2, acc, (u16*)sm);
  u16* u = (u16*)(p.ws + WS_Z);
  EPI_LOOP(u[(size_t)row * DFF2 + col] = f2bf(acc[i_][j_][e_]);)
}
DI void gemm_down_item(const Params& p, int l, int item, char* sm, bool dry) {
  const int m0 = (item % 48) * 128, n0 = (item / 48) * 128;
  f32x16 acc[2][2];
  zero_acc<2>(acc);
  gemm_core<2, false>((const u16*)(p.ws + WS_ACT), DFF, (const u16*)(p.ws + WS_WDN), DFF, DFF, m0, n0, 1024, acc, (u16*)sm);
  const float* g2 = (const float*)(p.ws + WS_MOD) + (l * 3 + tok_cond(m0)) * 6144 + 5120;
  EPI_LOOP(float* xp = p.out + (size_t)row * DM + col; const float xn = *xp + g2[col] * acc[i_][j_][e_]; if (!dry) *xp = xn;)
}

DI void conv_act(const Params& p, int l, int gid, int gstride) {
  const u16* u = (const u16*)(p.ws + WS_Z);
  u16* act = (u16*)(p.ws + WS_ACT);
  const float* cw = p.conv_w + (size_t)l * 3 * DFF2;
  const float* cb = p.conv_b + (size_t)l * DFF2;
  for (int idx = gid; idx < (NTOK / 4) * 352; idx += gstride) {
    const int tok0 = (idx / 352) * 4, c0 = (idx % 352) * 8;
    int pos, L;
    if (tok0 < NCTX) { pos = tok0 & 255; L = 256; } else { pos = (tok0 - NCTX) & 1023; L = 1024; }
    u32x4 ua[6], ug[6];
#pragma unroll
    for (int d = 0; d < 6; ++d) {
      const int pp = pos + d - 1;
      if (pp >= 0 && pp < L) {
        const u16* ur = u + (size_t)(tok0 + d - 1) * DFF2;
        ua[d] = *(const u32x4*)(ur + c0); ug[d] = *(const u32x4*)(ur + DFF + c0);
      } else { ua[d] = u32x4{0u, 0u, 0u, 0u}; ug[d] = u32x4{0u, 0u, 0u, 0u}; }
    }
    float wa[3][8], wg[3][8], ba[8], bg[8];
#pragma unroll
    for (int d = 0; d < 3; ++d) {
      const float4 x0 = *(const float4*)(cw + d * DFF2 + c0), x1 = *(const float4*)(cw + d * DFF2 + c0 + 4);
      const float4 y0 = *(const float4*)(cw + d * DFF2 + DFF + c0), y1 = *(const float4*)(cw + d * DFF2 + DFF + c0 + 4);
      wa[d][0] = x0.x; wa[d][1] = x0.y; wa[d][2] = x0.z; wa[d][3] = x0.w; wa[d][4] = x1.x; wa[d][5] = x1.y; wa[d][6] = x1.z; wa[d][7] = x1.w;
      wg[d][0] = y0.x; wg[d][1] = y0.y; wg[d][2] = y0.z; wg[d][3] = y0.w; wg[d][4] = y1.x; wg[d][5] = y1.y; wg[d][6] = y1.z; wg[d][7] = y1.w;
    }
    {
      const float4 x0 = *(const float4*)(cb + c0), x1 = *(const float4*)(cb + c0 + 4);
      const float4 y0 = *(const float4*)(cb + DFF + c0), y1 = *(const float4*)(cb + DFF + c0 + 4);
      ba[0] = x0.x; ba[1] = x0.y; ba[2] = x0.z; ba[3] = x0.w; ba[4] = x1.x; ba[5] = x1.y; ba[6] = x1.z; ba[7] = x1.w;
      bg[0] = y0.x; bg[1] = y0.y; bg[2] = y0.z; bg[3] = y0.w; bg[4] = y1.x; bg[5] = y1.y; bg[6] = y1.z; bg[7] = y1.w;
    }
#pragma unroll
    for (int tt = 0; tt < 4; ++tt) {
      u32x4 o;
#pragma unroll
      for (int q = 0; q < 4; ++q) {
        float a0 = ba[2 * q], a1 = ba[2 * q + 1], g0 = bg[2 * q], g1 = bg[2 * q + 1];
#pragma unroll
        for (int d = 0; d < 3; ++d) {
          a0 += wa[d][2 * q] * lo_bf(ua[tt + d][q]); a1 += wa[d][2 * q + 1] * hi_bf(ua[tt + d][q]);
          g0 += wg[d][2 * q] * lo_bf(ug[tt + d][q]); g1 += wg[d][2 * q + 1] * hi_bf(ug[tt + d][q]);
        }
        o[q] = pack2(g0 * sigmoidf_(g0) * a0, g1 * sigmoidf_(g1) * a1);
      }
      *(u32x4*)(act + (size_t)(tok0 + tt) * DFF + c0) = o;
    }
  }
}

DI void prep_wave(const Params& p, int l, int item) {
  const int lane = tid_() & 63;
  char* ws = p.ws;
  u16* qA = (u16*)(ws + WS_QA); u16* qC = (u16*)(ws + WS_QC);
  u16* kA = (u16*)(ws + WS_KA); u16* vA = (u16*)(ws + WS_VA);
  u16* kC = (u16*)(ws + WS_KC); u16* vC = (u16*)(ws + WS_VC);
  if (item >= NTOK) {
    const int cr = item - NTOK, b = cr >> 9, key = cr & 511;
    const size_t keyrow = 4096 + b * 1536 + key;
    const size_t srow = (size_t)(b * 2 + l) * 512 + key;
    float v[12];
#pragma unroll
    for (int u = 0; u < 12; ++u) {
      if (u < 2) v[u] = p.cache_a_k[srow * 128 + u * 64 + lane];
      else if (u < 4) v[u] = p.cache_a_v[srow * 128 + (u - 2) * 64 + lane];
      else if (u < 8) v[u] = p.cache_c_k[srow * 256 + (u - 4) * 64 + lane];
      else v[u] = p.cache_c_v[srow * 256 + (u - 8) * 64 + lane];
    }
#pragma unroll
    for (int u = 0; u < 12; ++u) {
      if (u < 2) kA[keyrow * 128 + u * 64 + lane] = f2bf(v[u]);
      else if (u < 4) vA[keyrow * 128 + (u - 2) * 64 + lane] = f2bf(v[u]);
      else if (u < 8) kC[keyrow * 256 + (u - 4) * 64 + lane] = f2bf(v[u]);
      else vC[keyrow * 256 + (u - 8) * 64 + lane] = f2bf(v[u]);
    }
    return;
  }
  const int tok = item;
  const bool sample = tok >= NCTX;
  int b, pos;
  size_t keyrow;
  if (!sample) { b = tok >> 8; pos = tok & 255; keyrow = tok; }
  else { b = (tok - NCTX) >> 10; pos = (tok - NCTX) & 1023; keyrow = 4096 + b * 1536 + 512 + pos; }
  const size_t crow_o = (size_t)(b * 2 + l) * 256 + pos;
  const u16* zr = (const u16*)(ws + WS_Z) + (size_t)tok * INW;
  const float rowp = (float)(pos >> 6), colp = (float)(pos & 63);
  u16 raw[20];
#pragma unroll
  for (int u = 0; u < 20; ++u) raw[u] = zr[u * 64 + lane];
  float cosA = 1.f, sinA = 0.f, cosC = 1.f, sinC = 0.f;
  if (sample) {
    {
      const int a = lane >> 5, i = lane & 15;
      const float ang = (a ? colp : rowp) * exp2f(-(float)i * (0.0625f * 13.287712379549449f));
      cosA = __cosf(ang); sinA = __sinf(ang);
      if (!((lane >> 4) & 1)) sinA = -sinA;
    }
    {
      const int dd = lane & 31, a = dd >> 4, i = dd & 7;
      const float ang = (a ? colp : rowp) * exp2f(-(float)i * (0.125f * 13.287712379549449f));
      cosC = __cosf(ang); sinC = __sinf(ang);
      if (!((dd >> 3) & 1)) sinC = -sinC;
    }
  }
  const float gaq = p.a_qn_g[l * 64 + lane], gak = p.a_kn_g[l * 64 + lane];
  const float gcq = p.c_qn_g[l * 32 + (lane & 31)], gck = p.c_kn_g[l * 32 + (lane & 31)];
#pragma unroll
  for (int u = 0; u < 20; ++u) {
    const float x = bf2f(raw[u]);
    if (u < 6) {
      const bool isq = u < 4;
      const int hd = isq ? u : u - 4;
      const float ss = wave_sum(x * x);
      float y = x * rsqrtf(ss * (1.f / 64.f) + EPSN) * (isq ? gaq : gak);
      if (!sample && !isq) p.out[O_CAK + crow_o * 128 + hd * 64 + lane] = y;
      if (sample) { const float pr = __shfl_xor(y, 16); y = y * cosA + pr * sinA; }
      if (isq) qA[(size_t)tok * 256 + hd * 64 + lane] = f2bf(y);
      else kA[keyrow * 128 + hd * 64 + lane] = f2bf(y);
    } else if (u < 8) {
      const int hd = u - 6;
      if (!sample) p.out[O_CAV + crow_o * 128 + hd * 64 + lane] = x;
      vA[keyrow * 128 + hd * 64 + lane] = raw[u];
    } else if (u < 16) {
      const bool isq = u < 12;
      const int pr2 = isq ? u - 8 : u - 12;
      float ss = x * x;
#pragma unroll
      for (int o = 16; o >= 1; o >>= 1) ss += __shfl_xor(ss, o);
      float y = x * rsqrtf(ss * (1.f / 32.f) + EPSN) * (isq ? gcq : gck);
      if (!sample && !isq) p.out[O_CCK + crow_o * 256 + pr2 * 64 + lane] = y;
      if (sample) { const float pr = __shfl_xor(y, 8); y = y * cosC + pr * sinC; }
      if (isq) qC[(size_t)tok * 256 + pr2 * 64 + lane] = f2bf(y);
      else kC[keyrow * 256 + pr2 * 64 + lane] = f2bf(y);
    } else {
      const int hd = u - 16;
      if (!sample) p.out[O_CCV + crow_o * 256 + hd * 64 + lane] = x;
      vC[keyrow * 256 + hd * 64 + lane] = raw[u];
    }
  }
}

template <bool ISC>
DI void attn_item(const Params& p, int l, int tok0, int keyrow0, int nkeys, int head, int split, char* smraw) {
  constexpr int NM = ISC ? 2 : 1;
  u16* Ks = (u16*)smraw;
  u16* Vs = Ks + 2 * 64 * 72;
  const u16* qbuf = (const u16*)(p.ws + (ISC ? WS_QC : WS_QA));
  const u16* kbuf = (const u16*)(p.ws + (ISC ? WS_KC : WS_KA));
  const u16* vbuf = (const u16*)(p.ws + (ISC ? WS_VC : WS_VA));
  const int kstride = ISC ? 256 : 128;
  const int koff = ISC ? head * 64 : (head >> 1) * 64;
  const float c2 = (ISC ? 0.17677669529663687f : 0.125f) * 1.4426950408889634f;
  const int t = tid_(), lane = t & 63, w = t >> 6, r = lane & 31, h = lane >> 5;
  const int i16 = lane & 15, tq = i16 >> 2, tp = i16 & 3, blk = (lane >> 4) & 1;
  bf16x8 qf[4];
  {
    const u16* qp = qbuf + (size_t)(tok0 + 32 * w + r) * 256 + head * 64 + 8 * h;
#pragma unroll
    for (int s = 0; s < 4; ++s) qf[s] = *(const bf16x8*)(qp + 16 * s);
  }
  f32x16 O[NM][2];
  float mrun[NM], lsum[NM];
#pragma unroll
  for (int m = 0; m < NM; ++m) {
    mrun[m] = -INFINITY; lsum[m] = 0.f;
#pragma unroll
    for (int d = 0; d < 2; ++d)
#pragma unroll
      for (int e = 0; e < 16; ++e) O[m][d][e] = 0.f;
  }
  const int lrow = t >> 3, lc8 = (t & 7) * 8;
  const u16* kg = kbuf + (size_t)(keyrow0 + lrow) * kstride + koff + lc8;
  const u16* vg = vbuf + (size_t)(keyrow0 + lrow) * kstride + koff + lc8;
  u32x4 rk[2], rv[2];
#pragma unroll
  for (int i = 0; i < 2; ++i) { rk[i] = *(const u32x4*)(kg + (size_t)(32 * i) * kstride); rv[i] = *(const u32x4*)(vg + (size_t)(32 * i) * kstride); }
#pragma unroll
  for (int i = 0; i < 2; ++i) {
    *(u32x4*)(Ks + (lrow + 32 * i) * 72 + lc8) = rk[i];
    *(u32x4*)(Vs + (lrow + 32 * i) * 72 + lc8) = rv[i];
  }
  __syncthreads();
  const int NT = nkeys >> 6;
  for (int kt = 0; kt < NT; ++kt) {
    const int buf = kt & 1;
    if (kt + 1 < NT) {
#pragma unroll
      for (int i = 0; i < 2; ++i) {
        rk[i] = *(const u32x4*)(kg + (size_t)((kt + 1) * 64 + 32 * i) * kstride);
        rv[i] = *(const u32x4*)(vg + (size_t)((kt + 1) * 64 + 32 * i) * kstride);
      }
    }
    const u16* kb_ = Ks + buf * 64 * 72;
    const u16* vb_ = Vs + buf * 64 * 72;
#pragma unroll
    for (int kb = 0; kb < 2; ++kb) {
      f32x16 S[NM];
#pragma unroll
      for (int m = 0; m < NM; ++m)
#pragma unroll
        for (int e = 0; e < 16; ++e) S[m][e] = 0.f;
#pragma unroll
      for (int s = 0; s < 4; ++s) {
        const int m = ISC ? (s >> 1) : 0;
        const bf16x8 kf = *(const bf16x8*)(kb_ + (kb * 32 + r) * 72 + 16 * s + 8 * h);
        S[m] = MFMA(kf, qf[s], S[m]);
      }
#pragma unroll
      for (int m = 0; m < NM; ++m) {
        float mx = S[m][0];
#pragma unroll
        for (int e = 1; e < 16; ++e) mx = fmaxf(mx, S[m][e]);
        mx = fmaxf(mx, __shfl_xor(mx, 32));
        const float mnew = fmaxf(mrun[m], mx);
        const float alpha = exp2f((mrun[m] - mnew) * c2);
        mrun[m] = mnew;
        const float mc = mnew * c2;
        float ps = 0.f;
#pragma unroll
        for (int e = 0; e < 16; ++e) { const float pe = exp2f(S[m][e] * c2 - mc); S[m][e] = pe; ps += pe; }
        lsum[m] = lsum[m] * alpha + ps;
        if (__any(alpha != 1.f)) {
#pragma unroll
          for (int d = 0; d < 2; ++d)
#pragma unroll
            for (int e = 0; e < 16; ++e) O[m][d][e] *= alpha;
        }
      }
#pragma unroll
      for (int st = 0; st < 2; ++st) {
        bf16x8 pf[NM];
#pragma unroll
        for (int m = 0; m < NM; ++m) pf[m] = pack8(S[m], st);
#pragma unroll
        for (int d = 0; d < 2; ++d) {
          const u16* vp = vb_ + (kb * 32 + 16 * st + 4 * h + tq) * 72 + d * 32 + 16 * blk + 4 * tp;
          const bf16x8 vf = trpair(vp, vp + 8 * 72);
#pragma unroll
          for (int m = 0; m < NM; ++m) O[m][d] = MFMA(vf, pf[m], O[m][d]);
        }
      }
    }
    if (kt + 1 < NT) {
      const int nb = (buf ^ 1) * 64 * 72;
#pragma unroll
      for (int i = 0; i < 2; ++i) {
        *(u32x4*)(Ks + nb + (lrow + 32 * i) * 72 + lc8) = rk[i];
        *(u32x4*)(Vs + nb + (lrow + 32 * i) * 72 + lc8) = rv[i];
      }
    }
    __syncthreads();
  }
  if (split >= 0) {
    const int ts = tok0 - NCTX + 32 * w + r;
#pragma unroll
    for (int m = 0; m < NM; ++m) {
      const float lt = lsum[m] + __shfl_xor(lsum[m], 32);
      float* op = ISC ? (float*)(p.ws + WS_PC) + ((size_t)((split * 2048 + ts) * 4 + head) * 2 + m) * 64
                      : (float*)(p.ws + WS_PA) + (size_t)((split * 2048 + ts) * 4 + head) * 64;
#pragma unroll
      for (int d = 0; d < 2; ++d)
#pragma unroll
        for (int g = 0; g < 4; ++g)
          *(float4*)(op + d * 32 + 8 * g + 4 * h) = make_float4(O[m][d][4 * g], O[m][d][4 * g + 1], O[m][d][4 * g + 2], O[m][d][4 * g + 3]);
      if (h == 0) {
        float* mp = (float*)(p.ws + WS_PML) + ((size_t)((split * 2048 + ts) * 8 + (ISC ? 4 : 0) + head) * 2 + m) * 2;
        mp[0] = mrun[m]; mp[1] = lt;
      }
    }
    return;
  }
  float inv[NM];
#pragma unroll
  for (int m = 0; m < NM; ++m) { const float lt = lsum[m] + __shfl_xor(lsum[m], 32); inv[m] = 1.f / lt; }
  const int tok = tok0 + 32 * w + r;
  u16* yc = (u16*)(p.ws + WS_YCAT) + (size_t)tok * 1024;
  if (!ISC) {
#pragma unroll
    for (int d = 0; d < 2; ++d)
#pragma unroll
      for (int g = 0; g < 4; ++g) {
        u32x2 q;
        q[0] = pack2(O[0][d][4 * g] * inv[0], O[0][d][4 * g + 1] * inv[0]);
        q[1] = pack2(O[0][d][4 * g + 2] * inv[0], O[0][d][4 * g + 3] * inv[0]);
        *(u32x2*)(yc + head * 64 + d * 32 + 8 * g + 4 * h) = q;
      }
  } else {
    const float* cl = p.c_lambda + l * 128;
    float d1 = 0.f, d2 = 0.f;
    for (int i = 0; i < 32; ++i) { d1 += cl[i] * cl[32 + i]; d2 += cl[64 + i] * cl[96 + i]; }
    const float lam_init = 0.8f - 0.6f * __expf(-0.3f * (float)l);
    const float lam = __expf(d1) - __expf(d2) + lam_init;
    float ss = 0.f;
#pragma unroll
    for (int d = 0; d < 2; ++d)
#pragma unroll
      for (int e = 0; e < 16; ++e) {
        const float dv = O[0][d][e] * inv[0] - lam * (O[NM - 1][d][e] * inv[NM - 1]);
        O[0][d][e] = dv; ss += dv * dv;
      }
    ss += __shfl_xor(ss, 32);
    const float sc = rsqrtf(ss * (1.f / 64.f) + EPSN) * (1.f - lam_init);
    const float* sg = p.c_subln_g + l * 64;
#pragma unroll
    for (int d = 0; d < 2; ++d)
#pragma unroll
      for (int g = 0; g < 4; ++g) {
        const int dv0 = d * 32 + 8 * g + 4 * h;
        u32x2 q;
        q[0] = pack2(O[0][d][4 * g] * sc * sg[dv0], O[0][d][4 * g + 1] * sc * sg[dv0 + 1]);
        q[1] = pack2(O[0][d][4 * g + 2] * sc * sg[dv0 + 2], O[0][d][4 * g + 3] * sc * sg[dv0 + 3]);
        *(u32x2*)(yc + 512 + head * 64 + dv0) = q;
      }
  }
}
DI void attn_dispatch(const Params& p, int l, int item, char* sm) {
  if (item < 384) {
    const int j = item % 192, split = j / 64, jj = j & 63, b = jj >> 5, qb = (jj >> 2) & 7, head = jj & 3;
    const int tok0 = NCTX + b * 1024 + qb * 128, kr0 = 4096 + b * 1536 + split * 512;
    if (item < 192) attn_item<true>(p, l, tok0, kr0, 512, head, split, sm);
    else attn_item<false>(p, l, tok0, kr0, 512, head, split, sm);
  } else {
    const int j = (item - 384) & 127, sq = j >> 3, qb = (j >> 2) & 1, head = j & 3;
    const int tok0 = sq * 256 + qb * 128, kr0 = sq * 256;
    if (item < 512) attn_item<true>(p, l, tok0, kr0, 256, head, -1, sm);
    else attn_item<false>(p, l, tok0, kr0, 256, head, -1, sm);
  }
}
DI void attn_combine(const Params& p, int l, int item) {
  const int lane = tid_() & 63;
  const int ts = item >> 1, isc = item & 1;
  const float* ml = (const float*)(p.ws + WS_PML);
  u16* yc = (u16*)(p.ws + WS_YCAT) + (size_t)(NCTX + ts) * 1024;
  if (!isc) {
    const float c2 = 0.125f * 1.4426950408889634f;
    float m[4][3], lv[4][3], o[4][3];
#pragma unroll
    for (int hd = 0; hd < 4; ++hd)
#pragma unroll
      for (int sp = 0; sp < 3; ++sp) {
        const float2 mm = *(const float2*)(ml + ((size_t)((sp * 2048 + ts) * 8 + hd) * 2) * 2);
        m[hd][sp] = mm.x; lv[hd][sp] = mm.y;
        o[hd][sp] = ((const float*)(p.ws + WS_PA))[(size_t)((sp * 2048 + ts) * 4 + hd) * 64 + lane];
      }
#pragma unroll
    for (int hd = 0; hd < 4; ++hd) {
      const float M = fmaxf(m[hd][0], fmaxf(m[hd][1], m[hd][2]));
      float num = 0.f, den = 0.f;
#pragma unroll
      for (int sp = 0; sp < 3; ++sp) { const float wgt = exp2f((m[hd][sp] - M) * c2); num += wgt * o[hd][sp]; den += wgt * lv[hd][sp]; }
      yc[hd * 64 + lane] = f2bf(num / den);
    }
  } else {
    const float c2 = 0.17677669529663687f * 1.4426950408889634f;
    const float* cl = p.c_lambda + l * 128;
    const float d1 = wave_sum(lane < 32 ? cl[lane] * cl[32 + lane] : 0.f), d2 = wave_sum(lane < 32 ? cl[64 + lane] * cl[96 + lane] : 0.f);
    const float lam_init = 0.8f - 0.6f * __expf(-0.3f * (float)l);
    const float lam = __expf(d1) - __expf(d2) + lam_init;
    const float sgv = p.c_subln_g[l * 64 + lane];
    float m[4][2][3], lv[4][2][3], o[4][2][3];
#pragma unroll
    for (int hd = 0; hd < 4; ++hd)
#pragma unroll
      for (int mm = 0; mm < 2; ++mm)
#pragma unroll
        for (int sp = 0; sp < 3; ++sp) {
          const float2 q = *(const float2*)(ml + ((size_t)((sp * 2048 + ts) * 8 + 4 + hd) * 2 + mm) * 2);
          m[hd][mm][sp] = q.x; lv[hd][mm][sp] = q.y;
          o[hd][mm][sp] = ((const float*)(p.ws + WS_PC))[((size_t)((sp * 2048 + ts) * 4 + hd) * 2 + mm) * 64 + lane];
        }
#pragma unroll
    for (int hd = 0; hd < 4; ++hd) {
      float res[2];
#pragma unroll
      for (int mm = 0; mm < 2; ++mm) {
        const float M = fmaxf(m[hd][mm][0], fmaxf(m[hd][mm][1], m[hd][mm][2]));
        float num = 0.f, den = 0.f;
#pragma unroll
        for (int sp = 0; sp < 3; ++sp) { const float wgt = exp2f((m[hd][mm][sp] - M) * c2); num += wgt * o[hd][mm][sp]; den += wgt * lv[hd][mm][sp]; }
        res[mm] = num / den;
      }
      const float dv = res[0] - lam * res[1];
      const float ss = wave_sum(dv * dv);
      const float sc = rsqrtf(ss * (1.f / 64.f) + EPSN) * (1.f - lam_init);
      yc[512 + hd * 64 + lane] = f2bf(dv * sc * sgv);
    }
  }
}

template <bool GLA>
struct ScanCtx { float wa[16]; float ba, lbm, oml; int ldir; };
template <bool GLA>
DI void scan_init(const Params& p, int l, int head, int dirh, int lane, ScanCtx<GLA>& cx) {
  const int ldir = GLA ? (lane >> 5) : dirh;
  cx.ldir = ldir;
  if (GLA) {
    const int kc = lane & 31;
#pragma unroll
    for (int j = 0; j < 16; ++j) cx.wa[j] = p.d_alpha_w[((size_t)(l * 2 + ldir) * 16 + j) * 128 + head * 32 + kc];
    cx.ba = p.d_alpha_b[(l * 2 + ldir) * 128 + head * 32 + kc];
  } else {
    float lb = 0.f;
    if (l > 0) {
      const float x0 = p.b_lb_logits[(ldir * 2 + 0) * 256 + head * 64 + lane], x1 = p.b_lb_logits[(ldir * 2 + 1) * 256 + head * 64 + lane];
      lb = 1.f / (1.f + __expf(x0 - x1));
    }
    cx.lbm = fmaxf(lb, 1e-30f); cx.oml = 1.f - lb;
  }
}
template <bool GLA>
DI float scan_la(const ScanCtx<GLA>& cx, const u16* kraw, const u16* rt, int pp, int lane, float& kk) {
  if (GLA) {
    const u32x4 r0 = *(const u32x4*)(rt + pp * 32 + cx.ldir * 16), r1 = *(const u32x4*)(rt + pp * 32 + cx.ldir * 16 + 8);
    float v = cx.ba;
#pragma unroll
    for (int q = 0; q < 4; ++q) {
      v += cx.wa[2 * q] * lo_bf(r0[q]) + cx.wa[2 * q + 1] * hi_bf(r0[q]);
      v += cx.wa[8 + 2 * q] * lo_bf(r1[q]) + cx.wa[8 + 2 * q + 1] * hi_bf(r1[q]);
    }
    kk = bf2f(kraw[pp * 72 + lane]);
    return (fminf(v, 0.f) - __logf(1.f + __expf(-fabsf(v)))) * (1.f / 16.f);
  } else {
    const float zz = bf2f(kraw[pp * 72 + lane]);
    const float sig = 1.f / (1.f + __expf(-zz));
    kk = cx.oml / (1.f + __expf(zz));
    return __logf(cx.lbm + cx.oml * sig);
  }
}
DI void stage64(u16* dst, const u16* z, int start, int col, int lane) {
  u32x4 v[4];
#pragma unroll
  for (int i = 0; i < 4; ++i) v[i] = *(const u32x4*)(z + (size_t)(start + (lane >> 3) + 8 * i) * INW + col + (lane & 7) * 8);
#pragma unroll
  for (int i = 0; i < 4; ++i) *(u32x4*)(dst + ((lane >> 3) + 8 * i) * 72 + (lane & 7) * 8) = v[i];
}
DI void stage32dup(u16* dst, const u16* z, int start, int col, int lane) {
  const int row = lane >> 1, c16 = (lane & 1) * 16;
  const u16* sp = z + (size_t)(start + row) * INW + col + c16;
  const u32x4 v0 = *(const u32x4*)sp, v1 = *(const u32x4*)(sp + 8);
  *(u32x4*)(dst + row * 72 + c16) = v0; *(u32x4*)(dst + row * 72 + c16 + 8) = v1;
  *(u32x4*)(dst + row * 72 + 32 + c16) = v0; *(u32x4*)(dst + row * 72 + 32 + c16 + 8) = v1;
}
DI void stage_r(u16* rt, const u16* z, int start, int lane) {
  const int row = lane >> 1, c16 = (lane & 1) * 16;
  const u16* sp = z + (size_t)(start + row) * INW + ZD_RF + c16;
  const u32x4 v0 = *(const u32x4*)sp, v1 = *(const u32x4*)(sp + 8);
  *(u32x4*)(rt + row * 32 + c16) = v0; *(u32x4*)(rt + row * 32 + c16 + 8) = v1;
}
DI int tile_id(bool gla, int chunk, int head, int dir) { return gla ? 1536 + chunk * 4 + head : (chunk * 4 + head) * 2 + dir; }

constexpr int S1_WAVE_U16 = 2 * 32 * 72 + 32 * 32;
template <bool GLA>
DI void scan_s1(const Params& p, int l, int chunk, int head, int dir, u16* smw) {
  const int lane = tid_() & 63, r = lane & 31, h = lane >> 5;
  const int i16 = lane & 15, tq = i16 >> 2, tp = i16 & 3, blk = (lane >> 4) & 1;
  u16* ko = smw;
  u16* vt = smw + 32 * 72;
  u16* rt = smw + 2 * 32 * 72;
  const int start = chunk * 32;
  const u16* z = (const u16*)(p.ws + WS_Z);
  stage64(vt, z, start, (GLA ? ZD_V : ZB_I) + head * 64, lane);
  if (GLA) { stage32dup(ko, z, start, ZD_K + head * 32, lane); stage_r(rt, z, start, lane); }
  else stage64(ko, z, start, (dir ? ZB_FB : ZB_FF) + head * 64, lane);
  ScanCtx<GLA> cx;
  scan_init<GLA>(p, l, head, dir, lane, cx);
  __syncthreads();
  {
    const int ldir = cx.ldir;
    float cl = 0.f, kk;
#pragma unroll 8
    for (int i = 0; i < 32; ++i) cl += scan_la<GLA>(cx, ko, rt, ldir ? 31 - i : i, lane, kk);
    float cum = 0.f;
#pragma unroll 8
    for (int i = 0; i < 32; ++i) {
      const int pp = ldir ? 31 - i : i;
      cum += scan_la<GLA>(cx, ko, rt, pp, lane, kk);
      ko[pp * 72 + lane] = f2bf(kk * __expf(cl - cum));
    }
    ((float*)(p.ws + WS_CL))[tile_id(GLA, chunk, head, dir) * 64 + lane] = cl;
  }
  __syncthreads();
  f32x16 acc[2][2];
  zero_acc<2>(acc);
#pragma unroll
  for (int st = 0; st < 2; ++st) {
    bf16x8 a[2], b[2];
#pragma unroll
    for (int x = 0; x < 2; ++x) {
      const u16* ap = vt + (16 * st + 8 * h + tq) * 72 + x * 32 + 16 * blk + 4 * tp;
      a[x] = trpair(ap, ap + 4 * 72);
      const u16* bp = ko + (16 * st + 8 * h + tq) * 72 + x * 32 + 16 * blk + 4 * tp;
      b[x] = trpair(bp, bp + 4 * 72);
    }
#pragma unroll
    for (int x = 0; x < 2; ++x)
#pragma unroll
      for (int y = 0; y < 2; ++y) acc[x][y] = MFMA(a[x], b[y], acc[x][y]);
  }
  {
    float* U = (float*)(p.ws + WS_U) + (size_t)tile_id(GLA, chunk, head, dir) * 4096;
#pragma unroll
    for (int x = 0; x < 2; ++x)
#pragma unroll
      for (int y = 0; y < 2; ++y)
#pragma unroll
        for (int e = 0; e < 16; ++e) U[(x * 32 + crow(e, h)) * 64 + y * 32 + r] = acc[x][y][e];
  }
  __syncthreads();
}
DI void scan_s1_block(const Params& p, int l, int bitem, char* sm) {
  const int w = tid_() >> 6;
  int wi = bitem * 4 + w;
  u16* smw = (u16*)sm + w * S1_WAVE_U16;
  if (bitem < 384) scan_s1<false>(p, l, wi >> 3, (wi >> 1) & 3, wi & 1, smw);
  else { wi -= 1536; scan_s1<true>(p, l, wi >> 2, wi & 3, 0, smw); }
}

DI void scan_s2_item(const Params& p, int l, int item) {
  const int t = tid_();
  const int unit = item >> 2, vq = item & 3;
  bool gla;
  int seq, head, dir;
  if (unit < 16) { gla = false; seq = 16 + (unit >> 3); head = (unit >> 1) & 3; dir = unit & 1; }
  else if (unit < 24) { gla = true; const int g = unit - 16; seq = 16 + (g >> 2); head = g & 3; dir = 0; }
  else if (unit < 152) { gla = false; const int u = unit - 24; seq = u >> 3; head = (u >> 1) & 3; dir = u & 1; }
  else { gla = true; const int g = unit - 152; seq = g >> 2; head = g & 3; dir = 0; }
  const int c = t & 63;
  const int dc = gla ? (c >> 5) : dir;
  int N, chunk0;
  if (seq < 16) { N = 8; chunk0 = seq * 8; } else { N = 32; chunk0 = 128 + (seq - 16) * 32; }
  float S[4];
  int vv[4];
#pragma unroll
  for (int i = 0; i < 4; ++i) {
    vv[i] = vq * 16 + (t >> 6) + 4 * i;
    if (seq < 16) S[i] = 0.f;
    else {
      const int b = seq - 16;
      S[i] = gla ? p.state_gla[(size_t)(((b * 2 + l) * 2 + dc) * 4 + head) * 2048 + (c & 31) * 64 + vv[i]]
                 : p.state_hgrn[(size_t)(((b * 2 + l) * 2 + dc) * 4 + head) * 4096 + c * 64 + vv[i]];
    }
  }
  const float* __restrict__ U = (const float*)(p.ws + WS_U);
  const float* __restrict__ CL = (const float*)(p.ws + WS_CL);
  float* __restrict__ SS = (float*)(p.ws + WS_S);
  for (int m0 = 0; m0 < N; m0 += 8) {
    float tmp[8][4], a[8];
    int ids[8];
#pragma unroll
    for (int mm = 0; mm < 8; ++mm) {
      const int m = m0 + mm;
      ids[mm] = tile_id(gla, chunk0 + (dc ? N - 1 - m : m), head, dir);
      a[mm] = CL[ids[mm] * 64 + c];
#pragma unroll
      for (int i = 0; i < 4; ++i) tmp[mm][i] = U[(size_t)ids[mm] * 4096 + vv[i] * 64 + c];
    }
#pragma unroll
    for (int mm = 0; mm < 8; ++mm) {
      const float ea = __expf(a[mm]);
#pragma unroll
      for (int i = 0; i < 4; ++i) {
        SS[(size_t)ids[mm] * 4096 + vv[i] * 64 + c] = S[i];
        S[i] = ea * S[i] + tmp[mm][i];
      }
    }
  }
  if (seq < 16) {
#pragma unroll
    for (int i = 0; i < 4; ++i) {
      if (gla) p.out[O_SG + (size_t)(((seq * 2 + l) * 2 + dc) * 4 + head) * 2048 + (c & 31) * 64 + vv[i]] = S[i];
      else p.out[O_SH + (size_t)(((seq * 2 + l) * 2 + dc) * 4 + head) * 4096 + c * 64 + vv[i]] = S[i];
    }
  }
}

constexpr int S3_WAVE_U16 = 3 * 32 * 72 + 128 + 32 * 32;
template <bool GLA>
DI void scan_s3(const Params& p, int l, int chunk, int head, u16* smw) {
  const int lane = tid_() & 63, r = lane & 31, h = lane >> 5;
  const int i16 = lane & 15, tq = i16 >> 2, tp = i16 & 3, blk = (lane >> 4) & 1;
  u16* qt = smw;
  u16* kt = smw + 32 * 72;
  u16* vt = smw + 2 * 32 * 72;
  float* sref = (float*)(smw + 3 * 32 * 72);
  u16* rt = smw + 3 * 32 * 72 + 128;
  const int start = chunk * 32;
  const u16* z = (const u16*)(p.ws + WS_Z);
  stage64(vt, z, start, (GLA ? ZD_V : ZB_I) + head * 64, lane);
  if (GLA) stage_r(rt, z, start, lane);
  f32x16 o[2];
#pragma unroll
  for (int x = 0; x < 2; ++x)
#pragma unroll
    for (int e = 0; e < 16; ++e) o[x][e] = 0.f;
  constexpr int NPASS = GLA ? 1 : 2;
#pragma unroll 1
  for (int pass = 0; pass < NPASS; ++pass) {
    if (GLA) { stage32dup(qt, z, start, ZD_Q + head * 32, lane); stage32dup(kt, z, start, ZD_K + head * 32, lane); }
    else { stage64(qt, z, start, ZB_Q + head * 64, lane); stage64(kt, z, start, (pass ? ZB_FB : ZB_FF) + head * 64, lane); }
    const float* Sg = (const float*)(p.ws + WS_S) + (size_t)tile_id(GLA, chunk, head, pass) * 4096;
    ScanCtx<GLA> cx;
    scan_init<GLA>(p, l, head, pass, lane, cx);
    __syncthreads();
    {
      const int ldir = cx.ldir;
      float ref = 0.f, kk, cum = 0.f;
#pragma unroll 8
      for (int i = 0; i < 16; ++i) ref += scan_la<GLA>(cx, kt, rt, ldir ? 31 - i : i, lane, kk);
      sref[lane] = __expf(ref);
#pragma unroll 8
      for (int i = 0; i < 32; ++i) {
        const int pp = ldir ? 31 - i : i;
        cum += scan_la<GLA>(cx, kt, rt, pp, lane, kk);
        const float zq = bf2f(qt[pp * 72 + lane]);
        const float qv = GLA ? zq * 0.17677669529663687f : zq * sigmoidf_(zq);
        qt[pp * 72 + lane] = f2bf(qv * __expf(cum - ref));
        kt[pp * 72 + lane] = f2bf(kk * __expf(ref - cum));
      }
    }
    __syncthreads();
    constexpr int NS = GLA ? 2 : 1;
    f32x16 sc[NS];
#pragma unroll
    for (int m = 0; m < NS; ++m)
#pragma unroll
      for (int e = 0; e < 16; ++e) sc[m][e] = 0.f;
    bf16x8 qfr[4];
#pragma unroll
    for (int st = 0; st < 4; ++st) {
      qfr[st] = *(const bf16x8*)(qt + r * 72 + 16 * st + 8 * h);
      const bf16x8 kf = *(const bf16x8*)(kt + r * 72 + 16 * st + 8 * h);
      const int m = GLA ? (st >> 1) : 0;
      sc[m] = MFMA(kf, qfr[st], sc[m]);
    }
#pragma unroll
    for (int m = 0; m < NS; ++m) {
      const int d = GLA ? m : pass;
#pragma unroll
      for (int e = 0; e < 16; ++e) {
        const int srow = crow(e, h);
        const bool keep = d ? (srow >= r) : (srow <= r);
        sc[m][e] = keep ? sc[m][e] : 0.f;
      }
#pragma unroll
      for (int st = 0; st < 2; ++st) {
        const bf16x8 pf = pack8(sc[m], st);
#pragma unroll
        for (int x = 0; x < 2; ++x) {
          const u16* vp = vt + (16 * st + 4 * h + tq) * 72 + x * 32 + 16 * blk + 4 * tp;
          const bf16x8 vf = trpair(vp, vp + 8 * 72);
          o[x] = MFMA(vf, pf, o[x]);
        }
      }
    }
#pragma unroll
    for (int x = 0; x < 2; ++x) {
      float4 s0[4], s1[4];
#pragma unroll
      for (int st = 0; st < 4; ++st) {
        const float* sp = Sg + (x * 32 + r) * 64 + 16 * st + 8 * h;
        s0[st] = *(const float4*)sp; s1[st] = *(const float4*)(sp + 4);
      }
#pragma unroll
      for (int st = 0; st < 4; ++st) {
        const float4 e0 = *(const float4*)(sref + 16 * st + 8 * h), e1 = *(const float4*)(sref + 16 * st + 8 * h + 4);
        u32x4 q;
        q[0] = pack2(s0[st].x * e0.x, s0[st].y * e0.y); q[1] = pack2(s0[st].z * e0.z, s0[st].w * e0.w);
        q[2] = pack2(s1[st].x * e1.x, s1[st].y * e1.y); q[3] = pack2(s1[st].z * e1.z, s1[st].w * e1.w);
        o[x] = MFMA(__builtin_bit_cast(bf16x8, q), qfr[st], o[x]);
      }
    }
    __syncthreads();
  }
  float ss = 0.f;
#pragma unroll
  for (int x = 0; x < 2; ++x)
#pragma unroll
    for (int e = 0; e < 16; ++e) ss += o[x][e] * o[x][e];
  ss += __shfl_xor(ss, 32);
  const float rstd = rsqrtf(ss * (1.f / 64.f) + EPSN);
  const int tok = start + r;
  const float* gn = (GLA ? p.d_norm_g : p.b_norm_g) + l * 64;
  const u16* gz = z + (size_t)tok * INW + (GLA ? ZD_G : ZB_G) + head * 64;
  u16* yc = (u16*)(p.ws + WS_YCAT) + (size_t)tok * 1024 + (GLA ? 768 : 256) + head * 64;
#pragma unroll
  for (int x = 0; x < 2; ++x)
#pragma unroll
    for (int g = 0; g < 4; ++g) {
      const int v0 = x * 32 + 8 * g + 4 * h;
      const u32x2 gr = *(const u32x2*)(gz + v0);
      const float g0 = lo_bf(gr[0]), g1 = hi_bf(gr[0]), g2 = lo_bf(gr[1]), g3 = hi_bf(gr[1]);
      u32x2 q;
      q[0] = pack2(o[x][4 * g] * rstd * gn[v0] * g0 * sigmoidf_(g0), o[x][4 * g + 1] * rstd * gn[v0 + 1] * g1 * sigmoidf_(g1));
      q[1] = pack2(o[x][4 * g + 2] * rstd * gn[v0 + 2] * g2 * sigmoidf_(g2), o[x][4 * g + 3] * rstd * gn[v0 + 3] * g3 * sigmoidf_(g3));
      *(u32x2*)(yc + v0) = q;
    }
}
DI void scan_s3_block(const Params& p, int l, int bitem, char* sm) {
  const int w = tid_() >> 6;
  u16* smw = (u16*)sm + w * S3_WAVE_U16;
  int wi = bitem * 4 + w;
  if (bitem < 192) scan_s3<false>(p, l, wi >> 2, wi & 3, smw);
  else { wi -= 768; scan_s3<true>(p, l, wi >> 2, wi & 3, smw); }
}

DI void run_phase(const Params& p, int ph, char* sm, bool dry) {
  const int bid = blockIdx.x, nb = gridDim.x;
#ifdef PHASE_ONLY
  if (ph != 0 && (ph - 1) % 11 != PHASE_ONLY - 1) return;
  if (ph == 0 && PHASE_ONLY != 0) return;
#endif
  if (ph == 0) {
    for (int it = bid; it < MOD_ITEMS + CONVW_ITEMS; it += nb) {
      if (it < MOD_ITEMS) mod_item(p, it, sm); else convw_item(p, 0, it - MOD_ITEMS, sm);
    }
    return;
  }
  const int l = (ph - 1) / 11, s = (ph - 1) % 11;
  switch (s) {
    case 0: {
      const int w = tid_() >> 6;
      for (int tk = bid * 4 + w; tk < NTOK; tk += nb * 4) norm_tok(p, l, 0, tk);
      if (l > 0) for (int it = bid; it < CONVW_ITEMS; it += nb) convw_item(p, l, it, sm);
    } break;
    case 1: for (int it = bid; it < 48 * 59; it += nb) gemm_in_item(p, it, sm); break;
    case 2:
      for (int it = bid; it < 576 + 1792; it += nb) {
        if (it < 576) scan_s1_block(p, l, it, sm); else prep_wave(p, l, (it - 576) * 4 + (tid_() >> 6));
      }
      break;
    case 3:
      for (int it = bid; it < 640 + 864; it += nb) {
        if (it < 96) scan_s2_item(p, l, it);
        else if (it < 480) attn_dispatch(p, l, it - 96, sm);
        else if (it < 1248) scan_s2_item(p, l, it - 384);
        else attn_dispatch(p, l, it - 864, sm);
      }
      break;
    case 4:
      for (int it = bid; it < 384 + 1024; it += nb) {
        if (it < 384) scan_s3_block(p, l, it, sm); else attn_combine(p, l, (it - 384) * 4 + (tid_() >> 6));
      }
      break;
    case 5: for (int it = bid; it < 768; it += nb) gemm_branch_item(p, it, sm); break;
    case 6: for (int it = bid; it < 384; it += nb) gemm_out_item(p, l, it, sm, dry); break;
    case 7: {
      const int w = tid_() >> 6;
      for (int tk = bid * 4 + w; tk < NTOK; tk += nb * 4) norm_tok(p, l, 1, tk);
    } break;
    case 8: for (int it = bid; it < 48 * 44; it += nb) gemm_up_item(p, it, sm); break;
    case 9: conv_act(p, l, bid * 256 + tid_(), nb * 256); break;
    case 10: for (int it = bid; it < 384; it += nb) gemm_down_item(p, l, it, sm, dry); break;
  }
}

__global__ void __launch_bounds__(256, 2) fwd_mega(Params p) {
  __shared__ __attribute__((aligned(16))) char sm[SMEM_BYTES];
  __shared__ uint4 xb_words;
  cg::grid_group grid = cg::this_grid();
  if (p.coop == 2) grid.sync();
  if (__builtin_amdgcn_workitem_id_x() == 0) xb_words = make_uint4(0u, 0u, 0u, 0u);
  __syncthreads();
  XcdBarrier xb;
  if (p.coop) xb = xcd_barrier_post((unsigned*)(p.ws + WS_BAR), (volatile LAS unsigned*)&xb_words);
  for (int ph = p.phase_begin; ph < p.phase_end; ++ph) {
    if (ph > p.phase_begin && p.coop) xcd_barrier(xb);
    const int stepid = ph == 0 ? 11 : (ph - 1) % 11;
    const int reps = (stepid == p.pad - 1) ? 2 : 1;
    for (int rep = 0; rep < reps; ++rep) {
      if (rep && p.coop) xcd_barrier(xb);
      run_phase(p, ph, sm, false);
    }
  }
}

extern "C" void kernel_launch(void* const* d_in, const int* in_sizes, int n_in, void* d_out, int out_size, void* d_ws,
                              size_t ws_size, hipStream_t stream) {
  static int grid_blocks = 0;
  if (!grid_blocks) {
    int dev = 0, cus = 0, per_cu = 0;
    hipGetDevice(&dev);
    hipDeviceGetAttribute(&cus, hipDeviceAttributeMultiprocessorCount, dev);
    hipOccupancyMaxActiveBlocksPerMultiprocessor(&per_cu, fwd_mega, 256, 0);
    if (per_cu > 2) per_cu = 2;
    if (per_cu < 1) per_cu = 1;
    grid_blocks = cus * per_cu;
  }
  Params p{};
  const float** pp = (const float**)&p;
  for (int i = 0; i < 32; ++i) pp[i] = (const float*)d_in[i];
  p.out = (float*)d_out;
  p.ws = (char*)d_ws;
  if (ws_size < WS_END) { fprintf(stderr, "workspace too small: %zu < %zu\n", ws_size, (size_t)WS_END); return; }
#if MULTI
  for (int ph = 0; ph < NPHASE; ++ph) {
    p.phase_begin = ph; p.phase_end = ph + 1; p.coop = 0; p.pad = 0;
    hipLaunchKernelGGL(fwd_mega, dim3(grid_blocks), dim3(256), 0, stream, p);
  }
#else
  p.phase_begin = 0; p.phase_end = NPHASE; p.coop = 1; p.pad = PROBE_STEP + 1;
  hipMemsetAsync((char*)d_ws + WS_BAR, 0, 16384, stream);
  void* args[] = {&p};
  hipError_t e = hipLaunchCooperativeKernel((void*)fwd_mega, dim3(grid_blocks), dim3(256), args, 0, stream);
  if (e != hipSuccess) fprintf(stderr, "cooperative launch failed: %s (grid %d)\n", hipGetErrorString(e), grid_blocks);
#endif
}
```

```cpp
#include <hip/hip_runtime.h>
#include <hip/hip_bf16.h>
#include <hip/hip_cooperative_groups.h>
#include <cstdio>
namespace cg = cooperative_groups;

#ifndef MULTI
#define MULTI 0
#endif
#ifndef PROBE_STEP
#define PROBE_STEP -1
#endif

#define DI __device__ __forceinline__
typedef unsigned short u16;
using bf16x8 = __attribute__((ext_vector_type(8))) short;
using s16x4  = __attribute__((ext_vector_type(4))) short;
using f32x16 = __attribute__((ext_vector_type(16))) float;
using u32x4  = __attribute__((ext_vector_type(4))) unsigned;
using u32x2  = __attribute__((ext_vector_type(2))) unsigned;
#define MFMA(a, b, c) __builtin_amdgcn_mfma_f32_32x32x16_bf16((a), (b), (c), 0, 0, 0)

constexpr int NTOK = 6144, NCTX = 4096, DM = 1024, INW = 7456, DFF = 2816, DFF2 = 5632;
constexpr int ZA_Q = 0, ZA_K = 256, ZA_V = 384, ZC_Q = 512, ZC_K = 768, ZC_V = 1024, ZB_Q = 1280, ZB_I = 1536, ZB_FF = 1792,
              ZB_FB = 2048, ZB_G = 2304, ZD_Q = 2560, ZD_K = 2688, ZD_V = 2816, ZD_G = 3072, ZD_RF = 3328, Z_ML = 3360;
constexpr float EPSN = 1e-6f;
constexpr size_t O_CAK = 6291456, O_CAV = 7340032, O_CCK = 8388608, O_CCV = 10485760, O_SH = 12582912, O_SG = 13631488;
constexpr size_t WS_WIN = 0;
constexpr size_t WS_WBR = WS_WIN + (size_t)INW * 1024 * 2;
constexpr size_t WS_WOUT = WS_WBR + (size_t)4 * 1024 * 256 * 2;
constexpr size_t WS_WUP = WS_WOUT + (size_t)1024 * 1024 * 2;
constexpr size_t WS_WDN = WS_WUP + (size_t)DFF2 * 1024 * 2;
constexpr size_t WS_MOD = WS_WDN + (size_t)1024 * DFF * 2;
constexpr size_t WS_H = WS_MOD + (size_t)2 * 3 * 6144 * 4;
constexpr size_t WS_Z = WS_H + (size_t)NTOK * 1024 * 2;
constexpr size_t WS_QA = WS_Z + (size_t)NTOK * INW * 2;
constexpr size_t WS_QC = WS_QA + (size_t)NTOK * 256 * 2;
constexpr size_t WS_KA = WS_QC + (size_t)NTOK * 256 * 2;
constexpr size_t WS_VA = WS_KA + (size_t)7168 * 128 * 2;
constexpr size_t WS_KC = WS_VA + (size_t)7168 * 128 * 2;
constexpr size_t WS_VC = WS_KC + (size_t)7168 * 256 * 2;
constexpr size_t WS_YCAT = WS_VC + (size_t)7168 * 256 * 2;
constexpr size_t WS_ACT = WS_YCAT + (size_t)NTOK * 1024 * 2;
constexpr size_t WS_MIX = WS_ACT + (size_t)NTOK * DFF * 2;
constexpr size_t WS_CL = WS_MIX + (size_t)NTOK * 1024 * 2;
constexpr size_t WS_U = WS_ACT;
constexpr size_t WS_S = WS_CL + (size_t)2304 * 64 * 4;
constexpr size_t WS_BAR = WS_S + (size_t)2304 * 4096 * 4;
constexpr size_t WS_PA = WS_BAR + 16384;
constexpr size_t WS_PML = WS_PA + (size_t)3 * 2048 * 4 * 64 * 4;
constexpr size_t WS_END = WS_PML + (size_t)3 * 2048 * 8 * 2 * 2 * 4;
constexpr size_t WS_PC = WS_H;
static_assert((size_t)2304 * 4096 * 4 <= (size_t)NTOK * DFF * 2 + (size_t)NTOK * 1024 * 2, "U alias");
static_assert(WS_END <= (size_t)256 * 1024 * 1024, "ws budget");
constexpr size_t WS_PART = WS_Z;
constexpr int SMEM_BYTES = 73728;
constexpr int NPHASE = 26;

struct Params {
  const float *x_prompt, *x_sample, *cache_a_k, *cache_a_v, *cache_c_k, *cache_c_v, *state_hgrn, *state_gla, *c, *c_ctx,
      *w_ada, *b_ada, *norm1_g, *norm2_g, *w_in, *a_qn_g, *a_kn_g, *c_qn_g, *c_kn_g, *c_lambda, *c_subln_g, *b_lb_logits,
      *b_norm_g, *d_alpha_w, *d_alpha_b, *d_norm_g, *w_branch, *w_out, *w_up, *conv_w, *conv_b, *w_down;
  float* out;
  char* ws;
  int phase_begin, phase_end, coop, pad;
};

DI int tid_() { int t = __builtin_amdgcn_workitem_id_x() & 255; asm volatile("" : "+v"(t)); return t; }
DI void wave_sync_() { __builtin_amdgcn_fence(__ATOMIC_ACQ_REL, "wavefront"); __builtin_amdgcn_wave_barrier(); }
DI float bf2f(u16 u) { return __uint_as_float(((unsigned)u) << 16); }
DI u16 f2bf(float a) { __hip_bfloat16 b = __float2bfloat16(a); return *(u16*)&b; }
DI unsigned pack2(float a, float b) { __hip_bfloat162 q = __float22bfloat162_rn(make_float2(a, b)); return *(unsigned*)&q; }
DI float lo_bf(unsigned u) { return __uint_as_float(u << 16); }
DI float hi_bf(unsigned u) { return __uint_as_float(u & 0xffff0000u); }
DI float rcp_(float x) { return __builtin_amdgcn_rcpf(x); }
DI void st16_wt(void* ptr, u32x4 v) { asm volatile("global_store_dwordx4 %0, %1, off sc1\n\ts_nop 3" :: "v"(ptr), "v"(v) : "memory");     }
DI void st16_wt(void* ptr, float4 v) { u32x4 q; q[0] = __float_as_uint(v.x); q[1] = __float_as_uint(v.y); q[2] = __float_as_uint(v.z); q[3] = __float_as_uint(v.w); st16_wt(ptr, q); }
DI float sigmoidf_(float x) { return rcp_(1.f + __expf(-x)); }
DI int crow(int e, int h) { return (e & 3) + 8 * (e >> 2) + 4 * h; }
DI bf16x8 pack8(const f32x16& x, int s) {
  u32x4 q;
  q[0] = pack2(x[8 * s + 0], x[8 * s + 1]); q[1] = pack2(x[8 * s + 2], x[8 * s + 3]);
  q[2] = pack2(x[8 * s + 4], x[8 * s + 5]); q[3] = pack2(x[8 * s + 6], x[8 * s + 7]);
  return __builtin_bit_cast(bf16x8, q);
}
DI s16x4 trread(const u16* pl) {
  return __builtin_amdgcn_ds_read_tr16_b64_v4i16((__attribute__((address_space(3))) s16x4*)pl);
}
DI bf16x8 trpair(const u16* p0, const u16* p1) {
  s16x4 a = trread(p0), b = trread(p1);
  return __builtin_shufflevector(a, b, 0, 1, 2, 3, 4, 5, 6, 7);
}
DI float wave_sum(float v) {
#pragma unroll
  for (int o = 32; o >= 1; o >>= 1) v += __shfl_xor(v, o);
  return v;
}
DI int tok_cond(int t) { return t < NCTX ? 0 : 1 + ((t - NCTX) >> 10); }
DI const float* xin_row(const Params& p, int l, int tok) {
  if (l > 0) return p.out + (size_t)tok * DM;
  return tok < NCTX ? p.x_prompt + (size_t)tok * DM : p.x_sample + (size_t)(tok - NCTX) * DM;
}


constexpr int SMEM_BYTES_ = 73728;
DI void vb_sync() {
  extern __shared__ __attribute__((aligned(16))) char vb_dyn_[];
  const int half = __builtin_amdgcn_readfirstlane(__builtin_amdgcn_workitem_id_x() >> 8);
  unsigned* ctr = (unsigned*)(vb_dyn_ + 2 * SMEM_BYTES_ + 16) + half;
  asm volatile("s_waitcnt lgkmcnt(0)" ::: "memory");
  if ((__builtin_amdgcn_workitem_id_x() & 63) == 0) {
    const unsigned old = __hip_atomic_fetch_add(ctr, 1u, __ATOMIC_RELAXED, __HIP_MEMORY_SCOPE_WORKGROUP);
    const unsigned target = (old & ~3u) + 4u;
    unsigned spins = 0;
    while ((int)(__hip_atomic_load(ctr, __ATOMIC_RELAXED, __HIP_MEMORY_SCOPE_WORKGROUP) - target) < 0) {
      __builtin_amdgcn_s_sleep(1);
      if (++spins > (1u << 22)) break;
    }
  }
  asm volatile("" ::: "memory");
}

#define XB_TMO      128
#define XB_XCNT(j)  (256  + 64 * (j))
#define XB_XSUB(j)  (1280 + 64 * (j))
#define XB_XGEN(j)  (2304 + 64 * (j))
#define XB_TOP      3328
#define XB_TOPGEN   3392
#define XCD_BAR_WORDS 3456
#define XB_SPIN_CAP (1u << 22)
#define LAS __attribute__((address_space(3)))
DI unsigned xb_ld(unsigned* p) { return __hip_atomic_load(p, __ATOMIC_RELAXED, __HIP_MEMORY_SCOPE_AGENT); }
DI unsigned xb_add(unsigned* p, unsigned v) { return __hip_atomic_fetch_add(p, v, __ATOMIC_RELAXED, __HIP_MEMORY_SCOPE_AGENT); }
DI unsigned xb_xcc_id() { return (unsigned)__builtin_amdgcn_s_getreg((3 << 11) | 20) & 0xFu; }
#define XB_SPIN(cond, bar) do { unsigned _sp = 0; while (cond) { __builtin_amdgcn_s_sleep(1); \
    if ((++_sp & 255u) == 0u) { if (xb_ld(&(bar)[XB_TMO])) break; if (_sp > XB_SPIN_CAP) { atomicAdd(&(bar)[XB_TMO], 1u); break; } } } } while (0)
struct XcdBarrier { unsigned* bar; unsigned x; volatile LAS unsigned* st; };
DI XcdBarrier xcd_barrier_post(unsigned* bar, volatile LAS unsigned* st) {
  XcdBarrier b; b.bar = bar; b.x = xb_xcc_id(); b.st = st;
  if (__builtin_amdgcn_workitem_id_x() == 0) (void)xb_add(&bar[XB_XCNT(b.x)], 1u);
  return b;
}
DI void xcd_barrier_complete(unsigned* bar, unsigned x, unsigned& nloc, unsigned& nx) {
  const unsigned G = gridDim.x * gridDim.y * gridDim.z;
  unsigned sum, cnt, mine, sp = 0u;
  for (;;) {
    sum = 0u; cnt = 0u; mine = 0u;
#pragma unroll
    for (unsigned j = 0; j < 16; ++j) { const unsigned c = xb_ld(&bar[XB_XCNT(j)]); sum += c; cnt += (c > 0u) ? 1u : 0u; mine = (j == x) ? c : mine; }
    if (sum == G) break;
    __builtin_amdgcn_s_sleep(1);
    if ((++sp & 255u) == 0u) { if (xb_ld(&bar[XB_TMO])) break; if (sp > XB_SPIN_CAP) { atomicAdd(&bar[XB_TMO], 1u); break; } }
  }
  nloc = mine > 0u ? mine : 1u; nx = cnt > 0u ? cnt : 1u;
}
DI void xcd_barrier(const XcdBarrier& b) {
  asm volatile("s_waitcnt vmcnt(0)" ::: "memory");
  __syncthreads();
  if (__builtin_amdgcn_workitem_id_x() == 0) {
    unsigned* bar = b.bar;
    __builtin_amdgcn_s_waitcnt(0);
    unsigned nloc = b.st[0], nx = b.st[1];
    if (nloc == 0u) { xcd_barrier_complete(bar, b.x, nloc, nx); b.st[0] = nloc; b.st[1] = nx; }
    const unsigned old = xb_add(&bar[XB_XSUB(b.x)], 1u);
    const unsigned gen = old / nloc;
    if (old + 1u == (gen + 1u) * nloc) {
      __builtin_amdgcn_fence(__ATOMIC_RELEASE, "agent");
      asm volatile("s_waitcnt vmcnt(0)" ::: "memory");
      const unsigned og = xb_add(&bar[XB_TOP], 1u);
      const unsigned tg = og / nx;
      if (og + 1u == (tg + 1u) * nx) xb_add(&bar[XB_TOPGEN], 1u);
      else XB_SPIN(xb_ld(&bar[XB_TOPGEN]) == tg, bar);
      __builtin_amdgcn_fence(__ATOMIC_ACQUIRE, "agent");
      xb_add(&bar[XB_XGEN(b.x)], 1u);
      asm volatile("s_waitcnt vmcnt(0)" ::: "memory");
    } else {
      XB_SPIN(xb_ld(&bar[XB_XGEN(b.x)]) == gen, bar);
      __builtin_amdgcn_fence(__ATOMIC_ACQUIRE, "agent");
      asm volatile("s_waitcnt vmcnt(0)" ::: "memory");
    }
  }
  __syncthreads();
}

DI void convw_tile(const float* __restrict__ src, u16* __restrict__ dst, int K, int N, int item, float* T) {
  const int t = tid_();
  const int ntn = (N + 63) >> 6;
  const int n0 = (item % ntn) * 64, k0 = (item / ntn) * 64;
  {
    const int n4 = (t & 15) * 4;
    float4 v[4];
#pragma unroll
    for (int i = 0; i < 4; ++i) {
      const int kl = (t >> 4) + 16 * i;
      v[i] = (n0 + n4 < N) ? *(const float4*)(src + (size_t)(k0 + kl) * N + n0 + n4) : make_float4(0.f, 0.f, 0.f, 0.f);
    }
#pragma unroll
    for (int i = 0; i < 4; ++i) {
      const int kl = (t >> 4) + 16 * i;
      T[(n4 + 0) * 65 + kl] = v[i].x; T[(n4 + 1) * 65 + kl] = v[i].y;
      T[(n4 + 2) * 65 + kl] = v[i].z; T[(n4 + 3) * 65 + kl] = v[i].w;
    }
  }
  vb_sync();
  {
    const int n = t >> 2, k16 = (t & 3) * 16;
    const float* tr = T + n * 65 + k16;
    u32x4 q0, q1;
    q0[0] = pack2(tr[0], tr[1]); q0[1] = pack2(tr[2], tr[3]); q0[2] = pack2(tr[4], tr[5]); q0[3] = pack2(tr[6], tr[7]);
    q1[0] = pack2(tr[8], tr[9]); q1[1] = pack2(tr[10], tr[11]); q1[2] = pack2(tr[12], tr[13]); q1[3] = pack2(tr[14], tr[15]);
    if (n0 + n < N) {
      u16* dp = dst + (size_t)(n0 + n) * K + k0 + k16;
      *(u32x4*)dp = q0; *(u32x4*)(dp + 8) = q1;
    }
  }
  vb_sync();
}
constexpr int CONVW_ITEMS = 1872 + 256 + 256 + 1408 + 704;
DI void convw_item(const Params& p, int l, int item, char* sm) {
  float* T = (float*)sm;
  char* ws = p.ws;
  if (item < 1872) convw_tile(p.w_in + (size_t)l * 1024 * INW, (u16*)(ws + WS_WIN), 1024, INW, item, T);
  else if (item < 2128) convw_tile(p.w_branch + (size_t)l * 1024 * 1024, (u16*)(ws + WS_WBR), 1024, 1024, item - 1872, T);
  else if (item < 2384) convw_tile(p.w_out + (size_t)l * 1024 * 1024, (u16*)(ws + WS_WOUT), 1024, 1024, item - 2128, T);
  else if (item < 3792) convw_tile(p.w_up + (size_t)l * 1024 * DFF2, (u16*)(ws + WS_WUP), 1024, DFF2, item - 2384, T);
  else convw_tile(p.w_down + (size_t)l * DFF * 1024, (u16*)(ws + WS_WDN), DFF, 1024, item - 3792, T);
}

constexpr int MOD_ITEMS = 384;
DI void mod_item(const Params& p, int item, char* sm) {
  float* sc = (float*)sm;
  float* red = sc + 3072;
  const int t = tid_();
  const int l = item / 192, j0 = (item % 192) * 32;
  for (int i = t; i < 3072; i += 256) {
    const int cnd = i >> 10, k = i & 1023;
    const float v = cnd == 0 ? p.c_ctx[k] : p.c[(cnd - 1) * 1024 + k];
    sc[i] = v * sigmoidf_(v);
  }
  vb_sync();
  const int cq = t & 7, ks = t >> 3;
  float a0[4] = {0, 0, 0, 0}, a1[4] = {0, 0, 0, 0}, a2[4] = {0, 0, 0, 0};
  const float* wp = p.w_ada + (size_t)l * 1024 * 6144 + j0 + 4 * cq;
#pragma unroll 8
  for (int rr = 0; rr < 32; ++rr) {
    const int row = ks * 32 + rr;
    const float4 w4 = *(const float4*)(wp + (size_t)row * 6144);
    const float s0 = sc[row], s1 = sc[1024 + row], s2 = sc[2048 + row];
    a0[0] += s0 * w4.x; a0[1] += s0 * w4.y; a0[2] += s0 * w4.z; a0[3] += s0 * w4.w;
    a1[0] += s1 * w4.x; a1[1] += s1 * w4.y; a1[2] += s1 * w4.z; a1[3] += s1 * w4.w;
    a2[0] += s2 * w4.x; a2[1] += s2 * w4.y; a2[2] += s2 * w4.z; a2[3] += s2 * w4.w;
  }
#pragma unroll
  for (int q = 0; q < 4; ++q) {
    red[(ks * 3 + 0) * 32 + 4 * cq + q] = a0[q];
    red[(ks * 3 + 1) * 32 + 4 * cq + q] = a1[q];
    red[(ks * 3 + 2) * 32 + 4 * cq + q] = a2[q];
  }
  vb_sync();
  if (t < 96) {
    const int cnd = t >> 5, col = t & 31;
    float sacc = p.b_ada[l * 6144 + j0 + col];
    for (int k = 0; k < 32; ++k) sacc += red[(k * 3 + cnd) * 32 + col];
    ((float*)(p.ws + WS_MOD))[(l * 3 + cnd) * 6144 + j0 + col] = sacc;
  }
  vb_sync();
}

DI void norm_tok(const Params& p, int l, int which, int tok) {
  const int lane = tid_() & 63;
  const float* xr = which == 0 ? xin_row(p, l, tok) : p.out + (size_t)tok * DM;
  const float* g = (which == 0 ? p.norm1_g : p.norm2_g) + l * 1024;
  const float* mod = (const float*)(p.ws + WS_MOD) + (l * 3 + tok_cond(tok)) * 6144 + which * 3072;
  float4 v[4];
  float ss = 0.f;
  const bool fold = (which == 1) || (l > 0);
  const int gidx = which == 1 ? (l * 3 + tok_cond(tok)) * 6144 + 2048 : ((l - 1) * 3 + tok_cond(tok)) * 6144 + 5120;
#pragma unroll
  for (int i = 0; i < 4; ++i) {
    v[i] = *(const float4*)(xr + 4 * lane + 256 * i);
    if (fold) {
      const size_t o = (size_t)tok * DM + 4 * lane + 256 * i;
      const u16* P = (const u16*)(p.ws + WS_PART);
      const u32x2 pa = *(const u32x2*)(P + o), pb = *(const u32x2*)(P + (size_t)NTOK * DM + o);
      const float4 a = make_float4(lo_bf(pa[0]), hi_bf(pa[0]), lo_bf(pa[1]), hi_bf(pa[1])), b = make_float4(lo_bf(pb[0]), hi_bf(pb[0]), lo_bf(pb[1]), hi_bf(pb[1]));
      const float4 g2 = *(const float4*)((const float*)(p.ws + WS_MOD) + gidx + 4 * lane + 256 * i);
      v[i].x += g2.x * (a.x + b.x); v[i].y += g2.y * (a.y + b.y); v[i].z += g2.z * (a.z + b.z); v[i].w += g2.w * (a.w + b.w);
      st16_wt(p.out + o, v[i]);
    }
    ss += v[i].x * v[i].x + v[i].y * v[i].y + v[i].z * v[i].z + v[i].w * v[i].w;
  }
  ss = wave_sum(ss);
  const float rstd = rsqrtf(ss * (1.f / 1024.f) + EPSN);
  if (which == 0 && l == 0) {
#pragma unroll
    for (int i = 0; i < 4; ++i) st16_wt(p.out + (size_t)tok * DM + 4 * lane + 256 * i, v[i]);
  }
  u16* hr = (u16*)(p.ws + WS_H) + (size_t)tok * DM;
#pragma unroll
  for (int i = 0; i < 4; ++i) {
    const int c0 = 4 * lane + 256 * i;
    const float4 gg = *(const float4*)(g + c0);
    const float4 sh = *(const float4*)(mod + c0);
    const float4 scv = *(const float4*)(mod + 1024 + c0);
    u32x2 q;
    q[0] = pack2(v[i].x * rstd * gg.x * (1.f + scv.x) + sh.x, v[i].y * rstd * gg.y * (1.f + scv.y) + sh.y);
    q[1] = pack2(v[i].z * rstd * gg.z * (1.f + scv.z) + sh.z, v[i].w * rstd * gg.w * (1.f + scv.w) + sh.w);
    *(u32x2*)(hr + c0) = q;
  }
}

template <int NJ, bool GATED>
DI void gemm_core(const u16* __restrict__ A, int lda, const u16* __restrict__ Bt, int ldb, int K, int m0, int n0, int N,
                  f32x16 (&acc)[2][NJ], u16* sm, const u16* __restrict__ gz = nullptr, f32x16 (*tot)[NJ] = nullptr) {
  const int t = tid_(), lane = t & 63, w = t >> 6, r = lane & 31, h = lane >> 5;
  const int wm = w & 1, wn = w >> 1;
  u16* As = sm;
  u16* Bs = sm + 2 * 128 * 72;
  const int lrow = t >> 3, lc8 = (t & 7) * 8;
  int aoff[4], boff[2 * NJ];
#pragma unroll
  for (int i = 0; i < 4; ++i) aoff[i] = (m0 + lrow + 32 * i) * lda + lc8;
#pragma unroll
  for (int i = 0; i < 2 * NJ; ++i) {
    int bn = n0 + lrow + 32 * i;
    bn = bn < N ? bn : N - 1;
    boff[i] = bn * ldb + lc8;
  }
  u32x4 ra[2][4], rb[2][2 * NJ];
  const int KT = K >> 6;
  auto gload = [&](int set, int kt) {
    const int k0 = kt * 64;
#pragma unroll
    for (int i = 0; i < 4; ++i) ra[set][i] = *(const u32x4*)(A + aoff[i] + k0);
#pragma unroll
    for (int i = 0; i < 2 * NJ; ++i) rb[set][i] = *(const u32x4*)(Bt + boff[i] + k0);
  };
  auto sstore = [&](int set, int buf) {
    const int nb = buf * 128 * 72;
#pragma unroll
    for (int i = 0; i < 4; ++i) *(u32x4*)(As + nb + (lrow + 32 * i) * 72 + lc8) = ra[set][i];
#pragma unroll
    for (int i = 0; i < 2 * NJ; ++i) *(u32x4*)(Bs + nb + (lrow + 32 * i) * 72 + lc8) = rb[set][i];
  };
  auto compute = [&](int buf) {
    const u16* as = As + buf * 128 * 72 + (wm * 64 + r) * 72 + 8 * h;
    const u16* bs = Bs + buf * 128 * 72 + (wn * 32 * NJ + r) * 72 + 8 * h;
    __builtin_amdgcn_s_setprio(1);
#pragma unroll
    for (int ks = 0; ks < 4; ++ks) {
      const bf16x8 a0 = *(const bf16x8*)(as + ks * 16), a1 = *(const bf16x8*)(as + 32 * 72 + ks * 16);
#pragma unroll
      for (int j = 0; j < NJ; ++j) {
        const bf16x8 b0 = *(const bf16x8*)(bs + j * 32 * 72 + ks * 16);
        acc[0][j] = MFMA(a0, b0, acc[0][j]);
        acc[1][j] = MFMA(a1, b0, acc[1][j]);
      }
    }
    __builtin_amdgcn_s_setprio(0);
  };
  gload(0, 0);
  gload(1, 1);
  sstore(0, 0);
  vb_sync();
  for (int kt = 0; kt < KT; kt += 2) {
    if (kt + 2 < KT) gload(0, kt + 2);
    compute(0);
    sstore(1, 1);
    vb_sync();
    if (kt + 3 < KT) gload(1, kt + 3);
    u16 graw[GATED ? 32 * NJ : 1];
    if (GATED && (kt & 3) == 2) {
      const int n = kt >> 2;
#pragma unroll
      for (int i = 0; i < 2; ++i)
#pragma unroll
        for (int j = 0; j < NJ; ++j)
#pragma unroll
          for (int e = 0; e < 16; ++e)
            graw[(i * NJ + j) * 16 + e] = gz[(size_t)(m0 + wm * 64 + i * 32 + crow(e, h)) * INW + n * 1024 + n0 + wn * 32 * NJ + j * 32 + r];
    }
    compute(1);
    if (kt + 2 < KT) sstore(0, 0);
    vb_sync();
    if (GATED && (kt & 3) == 2) {
#pragma unroll
      for (int i = 0; i < 2; ++i)
#pragma unroll
        for (int j = 0; j < NJ; ++j)
#pragma unroll
          for (int e = 0; e < 16; ++e) {
            tot[i][j][e] += sigmoidf_(bf2f(graw[(i * NJ + j) * 16 + e])) * acc[i][j][e];
            acc[i][j][e] = 0.f;
          }
    }
  }
}
template <int NJ>
DI void zero_acc(f32x16 (&acc)[2][NJ]) {
#pragma unroll
  for (int i = 0; i < 2; ++i)
#pragma unroll
    for (int j = 0; j < NJ; ++j)
#pragma unroll
      for (int e = 0; e < 16; ++e) acc[i][j][e] = 0.f;
}
#define EPI_LOOP_N(NJ_, body)                                                       \
  {                                                                                 \
    const int lane_ = tid_() & 63, w_ = tid_() >> 6, r_ = lane_ & 31, h_ = lane_ >> 5; \
    _Pragma("unroll") for (int i_ = 0; i_ < 2; ++i_)                                 \
    _Pragma("unroll") for (int j_ = 0; j_ < NJ_; ++j_)                               \
    _Pragma("unroll") for (int e_ = 0; e_ < 16; ++e_) {                              \
      const int row = m0 + (w_ & 1) * 64 + i_ * 32 + crow(e_, h_);                  \
      const int col = n0 + (w_ >> 1) * 32 * NJ_ + j_ * 32 + r_;                     \
      body                                                                          \
    }                                                                               \
  }
#define EPI_LOOP(body) EPI_LOOP_N(2, body)

DI void gemm_in_item(const Params& p, int item, char* sm) {
  const int m0 = (item % 48) * 128, n0 = (item / 48) * 128;
  f32x16 acc[2][2];
  zero_acc<2>(acc);
  gemm_core<2, false>((const u16*)(p.ws + WS_H), 1024, (const u16*)(p.ws + WS_WIN), 1024, 1024, m0, n0, INW, acc, (u16*)sm);
  u16* z = (u16*)(p.ws + WS_Z);
  EPI_LOOP(if (col < INW) z[(size_t)row * INW + col] = f2bf(acc[i_][j_][e_]);)
}
DI void gemm_branch_item(const Params& p, int item, char* sm) {
  const int m0 = (item % 48) * 128, n0 = (item / 48) * 64;
  f32x16 tot[2][1], acc[2][1];
  zero_acc<1>(tot);
  zero_acc<1>(acc);
  gemm_core<1, true>((const u16*)(p.ws + WS_YCAT), 1024, (const u16*)(p.ws + WS_WBR), 1024, 1024, m0, n0, 1024, acc, (u16*)sm,
                     (const u16*)(p.ws + WS_Z) + Z_ML, tot);
  u16* mix = (u16*)(p.ws + WS_MIX);
  EPI_LOOP_N(1, mix[(size_t)row * 1024 + col] = f2bf(tot[i_][j_][e_]);)
}
DI void gemm_out_item(const Params& p, int l, int item, char* sm, bool dry) {
  const int m0 = (item % 48) * 128, n0 = (item / 48) * 128;
  f32x16 acc[2][2];
  zero_acc<2>(acc);
  gemm_core<2, false>((const u16*)(p.ws + WS_MIX), 1024, (const u16*)(p.ws + WS_WOUT), 1024, 1024, m0, n0, 1024, acc, (u16*)sm);
  const float* g1 = (const float*)(p.ws + WS_MOD) + (l * 3 + tok_cond(m0)) * 6144 + 2048;
  EPI_LOOP(const float xo = xin_row(p, l, row)[col]; const float xn = xo + g1[col] * acc[i_][j_][e_]; if (!dry) p.out[(size_t)row * DM + col] = xn;)
}
DI void gemm_up_item(const Params& p, int item, char* sm) {
  const int m0 = (item % 48) * 128, n0 = (item / 48) * 128;
  f32x16 acc[2][2];
  zero_acc<2>(acc);
  gemm_core<2, false>((const u16*)(p.ws + WS_H), 1024, (const u16*)(p.ws + WS_WUP), 1024, 1024, m0, n0, DFF2, acc, (u16*)sm);
  u16* u = (u16*)(p.ws + WS_Z);
  EPI_LOOP(u[(size_t)row * DFF2 + col] = f2bf(acc[i_][j_][e_]);)
}
DI void gemm_down_item(const Params& p, int l, int item, char* sm, bool dry) {
  const int m0 = (item % 48) * 128, n0 = (item / 48) * 128;
  f32x16 acc[2][2];
  zero_acc<2>(acc);
  gemm_core<2, false>((const u16*)(p.ws + WS_ACT), DFF, (const u16*)(p.ws + WS_WDN), DFF, DFF, m0, n0, 1024, acc, (u16*)sm);
  const float* g2 = (const float*)(p.ws + WS_MOD) + (l * 3 + tok_cond(m0)) * 6144 + 5120;
  EPI_LOOP(float* xp = p.out + (size_t)row * DM + col; const float xn = *xp + g2[col] * acc[i_][j_][e_]; if (!dry) *xp = xn;)
}

namespace pg8 {
#define PG8_LAS __attribute__((address_space(3)))
typedef unsigned short bf16_t;
typedef short bf16x8 __attribute__((ext_vector_type(8)));
typedef float f32x4 __attribute__((ext_vector_type(4)));
typedef unsigned u32x4 __attribute__((ext_vector_type(4)));
constexpr int BM = 256, BK = 64, HALF = 128, HTB = HALF * BK * 2  , STAGE_BYTES = 8 * HTB, NXCD = 8, WGM = 8;

__host__ __device__ __forceinline__ int lds_byte(int r, int c) { const int st = (r >> 4) * 2 + (c >> 5), rr = r & 15, cc = c & 31, ob = rr * 64 + cc * 2; return st * 1024 + (ob ^ (((ob >> 9) & 1) << 5)); }
__host__ __device__ __forceinline__ void stage_rc(int b, int& R, int& C) { const int st = b / 1024, sb = b % 1024, swz = sb ^ (((sb >> 9) & 1) << 5); R = (st >> 1) * 16 + swz / 64; C = (st & 1) * 32 + (swz % 64) / 2; }
__host__ __device__ __forceinline__ int perm32(int rho) { const int n = rho >> 4, i = rho & 15; return 8 * (i >> 2) + 4 * n + (i & 3); }

struct Unit { int pm, pn, kh; };
struct Gemm { const bf16_t* A; const bf16_t* Bt; int M, N, K; int ldk; size_t kpart; };

struct StaticOrder {
    int nM, nN, nwg, G, c;
    __host__ __device__ void init(int M, int N, int G_, int c_) { nM = M / BM; nN = N / BM; nwg = nM * nN; G = G_; c = c_; }
    __host__ __device__ bool next(int i, Unit& u) const {
        const long L = (long)i * G + c; if (L >= nwg) return false;
        int wgid = (int)L; { const int q = nwg / NXCD, r = nwg % NXCD, xcd = wgid % NXCD, off = wgid / NXCD; wgid = (xcd < r ? xcd * (q + 1) : r * (q + 1) + (xcd - r) * q) + off; }
        const int nig = WGM * nN, gid = wgid / nig, fm = gid * WGM, gsz = (nM - fm) < WGM ? (nM - fm) : WGM;
        u.pm = fm + ((wgid % nig) % gsz); u.pn = (wgid % nig) / gsz; u.kh = 0; return true;
    }
    __device__ __forceinline__ void a_ready(const Unit&) const {}
    __device__ __forceinline__ void done(const Unit&) const {}
};
struct CountedOrder : StaticOrder {
    const unsigned* ready; unsigned need; unsigned* tmo;
    __device__ __forceinline__ void a_ready(const Unit& u) const {
        if (threadIdx.x < 64) {
            const unsigned long long t0 = __builtin_amdgcn_s_memrealtime(); unsigned polls = 0;
            while ((unsigned)__builtin_amdgcn_readfirstlane(__hip_atomic_load(ready + 64 * u.pm, __ATOMIC_RELAXED, __HIP_MEMORY_SCOPE_AGENT)) < need) {
                if ((++polls & 255u) == 0u && __builtin_amdgcn_readfirstlane(__hip_atomic_load(tmo, __ATOMIC_RELAXED, __HIP_MEMORY_SCOPE_AGENT)) != 0u) break;
                if (__builtin_amdgcn_s_memrealtime() - t0 > 2000000ull) {
                    if (threadIdx.x == 0) { unsigned expect = 0u; __hip_atomic_compare_exchange_strong(tmo + 1, &expect, 0x600u | (unsigned)(u.pm & 0xff), __ATOMIC_RELAXED, __ATOMIC_RELAXED, __HIP_MEMORY_SCOPE_AGENT); __hip_atomic_store(tmo, 1u, __ATOMIC_RELAXED, __HIP_MEMORY_SCOPE_AGENT); }
                    break; }
                __builtin_amdgcn_s_sleep(2); }
            __builtin_amdgcn_fence(__ATOMIC_ACQUIRE, "agent");
            asm volatile("s_waitcnt vmcnt(0)" ::: "memory");
        }
#if !defined(BROKEN_HOOK_NO_BARRIER)
        asm volatile("" ::: "memory"); __builtin_amdgcn_s_barrier(); asm volatile("" ::: "memory");
#endif
    }
};

__device__ __forceinline__ unsigned cvt_pk_bf16(float lo, float hi) { unsigned r; asm volatile("v_cvt_pk_bf16_f32 %0, %1, %2" : "=v"(r) : "v"(lo), "v"(hi)); return r; }
template <class Epi, class Sched, bool STAMP = false>
__device__ __forceinline__ void gemm_phase(PG8_LAS unsigned char* lds, const Gemm g, const Sched& S, const Epi& E, unsigned long long* stamps) {
    int tid_raw = threadIdx.x; asm volatile("" : "+v"(tid_raw));
    const int tid = tid_raw, wid = __builtin_amdgcn_readfirstlane(tid >> 6), lane = tid & 63, wr = wid >> 2, wc = wid & 3, fr = lane & 15, fq = lane >> 4;
    const int K = g.K, nt = K / BK;
    int ts_lo = 0, ts_hi = 0, nts = 0; const unsigned long long rt_entry = STAMP ? (unsigned long long)wall_clock64() : 0ull;
#define PG8_STAMP() do { if (STAMP && wid == 0 && nts < 64) { const unsigned long long _c = (unsigned long long)clock64(); \
        ts_lo = (lane == nts) ? (int)(unsigned)_c : ts_lo; ts_hi = (lane == nts) ? (int)(unsigned)(_c >> 32) : ts_hi; ++nts; } } while (0)
    PG8_STAMP();
    unsigned voffA[2], voffB[2];
#pragma unroll
    for (int i = 0; i < 2; ++i) { int R, C; stage_rc(tid * 16 + i * 8192, R, C); const int Rb = Epi::PERM ? ((R & ~31) + perm32(R & 31)) : R;
        voffA[i] = (unsigned)(R * g.ldk + C) * 2u; voffB[i] = (unsigned)(Rb * g.ldk + C) * 2u; }
    const size_t kstep = (size_t)(BK * 2);
    const size_t hstep = (size_t)HALF * g.ldk * 2;
    const size_t tstep = 2 * hstep;
    const unsigned ldsw = (unsigned)wid * 1024u;
    const int aoff = lds_byte(wr * 64 + fr, fq * 8), boff = lds_byte(wc * 32 + fr, fq * 8);
#define PG8_SA(b, h) (((b) * 2 + (h)) * HTB)
#define PG8_SB(b, h) ((4 + (b) * 2 + (h)) * HTB)
#define PG8_STAGE(bufoff, gbase, voff) do { _Pragma("unroll") for (int _i = 0; _i < 2; ++_i) \
        __builtin_amdgcn_global_load_lds((const unsigned*)((const char*)(gbase) + (voff)[_i]), (PG8_LAS unsigned*)(lds + (bufoff) + ldsw + _i * 8192), 16, 0, 0); } while (0)
#define PG8_LDA(dst, b, h) do { _Pragma("unroll") for (int m = 0; m < 4; ++m) _Pragma("unroll") for (int k = 0; k < 2; ++k) dst[m][k] = *(const PG8_LAS bf16x8*)(lds + PG8_SA(b, h) + aoff + m * 2048 + k * 1024); } while (0)
#define PG8_LDB(dst, b, h) do { _Pragma("unroll") for (int n = 0; n < 2; ++n) _Pragma("unroll") for (int k = 0; k < 2; ++k) dst[n][k] = *(const PG8_LAS bf16x8*)(lds + PG8_SB(b, h) + boff + n * 2048 + k * 1024); } while (0)
#define PG8_MMA(ai, bj, At, Bt) do { __builtin_amdgcn_s_setprio(1); _Pragma("unroll") for (int m = 0; m < 4; ++m) _Pragma("unroll") for (int n = 0; n < 2; ++n) _Pragma("unroll") for (int k = 0; k < 2; ++k) \
        acc[ai][bj][m][n] = __builtin_amdgcn_mfma_f32_16x16x32_bf16(Bt[n][k], At[m][k], acc[ai][bj][m][n], 0, 0, 0); __builtin_amdgcn_s_setprio(0); } while (0)
#define PG8_WAIT_V(n) asm volatile("s_waitcnt vmcnt(" #n ")" ::: "memory")
#define PG8_WAIT_L(n) asm volatile("s_waitcnt lgkmcnt(" #n ")" ::: "memory")
#define PG8_BAR __builtin_amdgcn_s_barrier()
#define PG8_SCHED __builtin_amdgcn_sched_barrier(0)
    Unit cur, nxt; int ui = 0;
    if (!S.next(0, cur)) return;
    f32x4 acc[2][2][4][2];
#pragma unroll
    for (int a = 0; a < 2; ++a)
#pragma unroll
        for (int b = 0; b < 2; ++b)
#pragma unroll
            for (int m = 0; m < 4; ++m)
#pragma unroll
                for (int n = 0; n < 2; ++n) acc[a][b][m][n] = (f32x4){0.f, 0.f, 0.f, 0.f};
    bf16x8 At[4][2], B0[2][2], B1[2][2];
    const char* cA = (const char*)g.A + (size_t)cur.pm * tstep + cur.kh * g.kpart; const char* cB = (const char*)g.Bt + (size_t)cur.pn * tstep + cur.kh * g.kpart;
    S.a_ready(cur);
    PG8_STAGE(PG8_SB(0, 0), cB, voffB); PG8_STAGE(PG8_SA(0, 0), cA, voffA); PG8_STAGE(PG8_SB(0, 1), cB + hstep, voffB); PG8_STAGE(PG8_SA(0, 1), cA + hstep, voffA);
    if (wr == 1) PG8_BAR;
    PG8_WAIT_V(4); PG8_BAR;
    PG8_STAGE(PG8_SB(1, 0), cB + kstep, voffB); PG8_STAGE(PG8_SA(1, 0), cA + kstep, voffA); PG8_STAGE(PG8_SB(1, 1), cB + hstep + kstep, voffB);
    PG8_WAIT_V(6); PG8_BAR;
    PG8_STAMP();
    for (;;) {
        const bool has_next = S.next(ui + 1, nxt);
        const char* nA = has_next ? (const char*)g.A + (size_t)nxt.pm * tstep + nxt.kh * g.kpart : cA; const char* nB = has_next ? (const char*)g.Bt + (size_t)nxt.pn * tstep + nxt.kh * g.kpart : cB;
        for (int t = 0; t < nt; t += 2) {
            const bool last = (t == nt - 2);
            const char* a1 = cA + (size_t)(t + 1) * kstep;
            const char* a2 = last ? nA : cA + (size_t)(t + 2) * kstep; const char* b2 = last ? nB : cB + (size_t)(t + 2) * kstep;
            const char* a3 = a2 + kstep; const char* b3 = b2 + kstep;
            if (last && has_next) S.a_ready(nxt);
            PG8_LDB(B0, 0, 0); PG8_SCHED; PG8_LDA(At, 0, 0); PG8_STAGE(PG8_SA(1, 1), a1 + hstep, voffA);
            PG8_WAIT_L(8); PG8_BAR; PG8_WAIT_L(0); PG8_MMA(0, 0, At, B0); PG8_BAR; PG8_SCHED;
            PG8_LDB(B1, 0, 1); PG8_STAGE(PG8_SB(0, 0), b2, voffB);
            PG8_BAR; PG8_WAIT_L(0); PG8_MMA(0, 1, At, B1); PG8_BAR;
            PG8_LDA(At, 0, 1); PG8_STAGE(PG8_SA(0, 0), a2, voffA);
            PG8_BAR; PG8_WAIT_L(0); PG8_MMA(1, 0, At, B0); PG8_BAR; PG8_SCHED;
            PG8_STAGE(PG8_SB(0, 1), b2 + hstep, voffB);
            PG8_WAIT_V(6); PG8_BAR; PG8_MMA(1, 1, At, B1); PG8_BAR;
            PG8_LDB(B0, 1, 0); PG8_SCHED; PG8_LDA(At, 1, 0); PG8_STAGE(PG8_SA(0, 1), a2 + hstep, voffA);
            PG8_WAIT_L(8); PG8_BAR; PG8_WAIT_L(0); PG8_MMA(0, 0, At, B0); PG8_BAR; PG8_SCHED;
            PG8_LDB(B1, 1, 1); PG8_STAGE(PG8_SB(1, 0), b3, voffB);
            PG8_BAR; PG8_WAIT_L(0); PG8_MMA(0, 1, At, B1); PG8_BAR;
            PG8_LDA(At, 1, 1); PG8_STAGE(PG8_SA(1, 0), a3, voffA);
            PG8_BAR; PG8_WAIT_L(0); PG8_MMA(1, 0, At, B0); PG8_BAR; PG8_SCHED;
            PG8_STAGE(PG8_SB(1, 1), b3 + hstep, voffB);
            PG8_WAIT_V(6); PG8_BAR; PG8_MMA(1, 1, At, B1); PG8_BAR;
        }
        PG8_STAMP();
        if constexpr (!Epi::AFTER_DRAIN) { E(acc, cur, wr, wc, fr, fq); S.done(cur); }
        PG8_STAMP();
        if (!has_next) break;
#pragma unroll
        for (int a = 0; a < 2; ++a)
#pragma unroll
            for (int b = 0; b < 2; ++b)
#pragma unroll
                for (int m = 0; m < 4; ++m)
#pragma unroll
                    for (int n = 0; n < 2; ++n) acc[a][b][m][n] = (f32x4){0.f, 0.f, 0.f, 0.f};
        cur = nxt; cA = nA; cB = nB; ++ui;
    }
    PG8_WAIT_V(0);
    if (wr == 0) PG8_BAR;
    PG8_BAR;
    if constexpr (Epi::AFTER_DRAIN) { E.fused(acc, cur, wr, wc, fr, fq, lds, wid, lane); S.done(cur); }
    PG8_STAMP();
    if (STAMP && wid == 0) { stamps[lane] = lane < nts ? (((unsigned long long)(unsigned)ts_hi << 32) | (unsigned)ts_lo) : 0ull;
        if (lane == 62) stamps[62] = rt_entry; if (lane == 63) stamps[63] = (unsigned long long)wall_clock64(); }
#undef PG8_STAMP
#undef PG8_SA
#undef PG8_SB
#undef PG8_STAGE
#undef PG8_LDA
#undef PG8_LDB
#undef PG8_MMA
#undef PG8_WAIT_V
#undef PG8_WAIT_L
#undef PG8_BAR
#undef PG8_SCHED
}
}

struct EpiBf16N {
  static constexpr bool PERM = true, AFTER_DRAIN = false;
  unsigned short* O; int ldc; int nvalid; size_t khstride;
  unsigned short* O3;
  __device__ __forceinline__ void operator()(const pg8::f32x4 (&acc)[2][2][4][2], const pg8::Unit& u, int wr, int wc, int fr, int fq) const {
    const int row0 = u.pm * 256 + wr * 64 + fr, col0 = u.pn * 256 + wc * 32 + 8 * fq;
#pragma unroll
    for (int ai = 0; ai < 2; ++ai)
#pragma unroll
      for (int m = 0; m < 4; ++m) {
        unsigned short* rowp = ((O3 && u.kh == 3) ? O3 : O + (size_t)u.kh * khstride) + (size_t)(row0 + ai * 128 + m * 16) * ldc + col0;
#pragma unroll
        for (int bj = 0; bj < 2; ++bj) {
          if (col0 + bj * 128 < nvalid) {
            const pg8::f32x4 v0 = acc[ai][bj][m][0], v1 = acc[ai][bj][m][1];
            pg8::u32x4 w;
            w.x = pg8::cvt_pk_bf16(v0[0], v0[1]); w.y = pg8::cvt_pk_bf16(v0[2], v0[3]); w.z = pg8::cvt_pk_bf16(v1[0], v1[1]); w.w = pg8::cvt_pk_bf16(v1[2], v1[3]);
            asm volatile("global_store_dwordx4 %0, %1, off sc1\n\ts_nop 3" :: "v"(rowp + bj * 128), "v"(w) : "memory");
          }
        }
      }
  }
};


struct SplitKOrder {
  int nM, nN, G, c, NP;
  __device__ void init(int M, int N, int G_, int c_, int np) { nM = M / 256; nN = N / 256; G = G_; c = c_; NP = np; }
  __device__ bool next(int i, pg8::Unit& u) const {
    const int L = i * G + c; if (L >= nM * nN * NP) return false;
    u.kh = L % NP; const int t = L / NP; u.pm = t % nM; u.pn = t / nM; return true;
  }
  __device__ __forceinline__ void a_ready(const pg8::Unit&) const {}
  __device__ __forceinline__ void done(const pg8::Unit&) const {}
};

struct EpiPartF32 {
  static constexpr bool PERM = false, AFTER_DRAIN = false;
  float* P;
  __device__ __forceinline__ void operator()(const pg8::f32x4 (&acc)[2][2][4][2], const pg8::Unit& u, int wr, int wc, int fr, int fq) const {
    const int row0 = u.pm * 256 + wr * 64 + fr, col0 = u.pn * 256 + wc * 32 + 4 * fq;
    float* pb = P + (size_t)u.kh * NTOK * DM;
#pragma unroll
    for (int ai = 0; ai < 2; ++ai)
#pragma unroll
      for (int m = 0; m < 4; ++m) {
        float* rowp = pb + (size_t)(row0 + ai * 128 + m * 16) * DM + col0;
#pragma unroll
        for (int bj = 0; bj < 2; ++bj)
#pragma unroll
          for (int n = 0; n < 2; ++n) *(pg8::f32x4*)(rowp + bj * 128 + n * 16) = acc[ai][bj][m][n];
      }
  }
};


DI void gemm8_step(const Params& p, int s, char* smfull) {
  char* ws = p.ws;
  const u16* A; const u16* Bt; u16* O; u16* O3 = nullptr;
  int N, nvalid, K, ldk, ldc, np; size_t kpart = 0, khstride = 0;
  if (s == 1)      { A = (const u16*)(ws + WS_H);    Bt = (const u16*)(ws + WS_WIN);  N = 7680; nvalid = INW;  K = 1024; ldk = 1024; np = 1; O = (u16*)(ws + WS_Z); ldc = INW; }
  else if (s == 5) { A = (const u16*)(ws + WS_YCAT); Bt = (const u16*)(ws + WS_WBR);  N = 1024; nvalid = 1024; K = 256;  ldk = 1024; np = 4; O = (u16*)(ws + WS_S); ldc = DM;
                     kpart = 512; khstride = (size_t)NTOK * DM; O3 = (u16*)(ws + WS_H); }
  else if (s == 7) { A = (const u16*)(ws + WS_MIX);  Bt = (const u16*)(ws + WS_WOUT); N = 1024; nvalid = 1024; K = 512;  ldk = 1024; np = 2; O = (u16*)(ws + WS_PART); ldc = DM;
                     kpart = 1024; khstride = (size_t)NTOK * DM; }
  else if (s == 9) { A = (const u16*)(ws + WS_H);    Bt = (const u16*)(ws + WS_WUP);  N = DFF2; nvalid = DFF2; K = 1024; ldk = 1024; np = 1; O = (u16*)(ws + WS_Z); ldc = DFF2; }
  else             { A = (const u16*)(ws + WS_ACT);  Bt = (const u16*)(ws + WS_WDN);  N = 1024; nvalid = 1024; K = 1408; ldk = DFF;  np = 2; O = (u16*)(ws + WS_PART); ldc = DM;
                     kpart = 2816; khstride = (size_t)NTOK * DM; }
  asm volatile("" : "+s"(A), "+s"(Bt));
  pg8::Gemm g; g.A = A; g.Bt = Bt; g.M = NTOK; g.N = N; g.K = K; g.ldk = ldk; g.kpart = kpart;
  SplitKOrder S; S.init(NTOK, N, (int)gridDim.x, (int)blockIdx.x, np);
  EpiBf16N E; E.O = O; E.ldc = ldc; E.nvalid = nvalid; E.khstride = khstride; E.O3 = O3;
  pg8::gemm_phase<EpiBf16N, SplitKOrder, false>((PG8_LAS unsigned char*)smfull, g, S, E, nullptr);
}
DI void fold_branch_tok(const Params& p, int tok) {
  const int lane = tid_() & 63;
  const u16* zr = (const u16*)(p.ws + WS_Z) + (size_t)tok * INW + Z_ML;
  u16* mix = (u16*)(p.ws + WS_MIX) + (size_t)tok * DM;
#pragma unroll
  for (int i = 0; i < 4; ++i) {
    const int c = 4 * lane + 256 * i;
    u32x2 gt[4], pv[4];
#pragma unroll
    for (int n = 0; n < 4; ++n) {
      gt[n] = *(const u32x2*)(zr + n * 1024 + c);
      const u16* P = (n == 3) ? (const u16*)(p.ws + WS_H) : (const u16*)(p.ws + WS_S) + (size_t)n * NTOK * DM;
      pv[n] = *(const u32x2*)(P + (size_t)tok * DM + c);
    }
    float m0 = 0.f, m1 = 0.f, m2 = 0.f, m3 = 0.f;
#pragma unroll
    for (int n = 0; n < 4; ++n) {
      m0 += sigmoidf_(lo_bf(gt[n][0])) * lo_bf(pv[n][0]); m1 += sigmoidf_(hi_bf(gt[n][0])) * hi_bf(pv[n][0]);
      m2 += sigmoidf_(lo_bf(gt[n][1])) * lo_bf(pv[n][1]); m3 += sigmoidf_(hi_bf(gt[n][1])) * hi_bf(pv[n][1]);
    }
    u32x2 q; q[0] = pack2(m0, m1); q[1] = pack2(m2, m3);
    *(u32x2*)(mix + c) = q;
  }
}
DI void fold_part_tok(const Params& p, int lprev, int tok) {
  const int lane = tid_() & 63;
  const u16* P = (const u16*)(p.ws + WS_PART);
  const float* g2 = (const float*)(p.ws + WS_MOD) + (lprev * 3 + tok_cond(tok)) * 6144 + 5120;
#pragma unroll
  for (int i = 0; i < 4; ++i) {
    const size_t o = (size_t)tok * DM + 4 * lane + 256 * i;
    float4 x = *(const float4*)(p.out + o);
    const u32x2 pa = *(const u32x2*)(P + o), pb = *(const u32x2*)(P + (size_t)NTOK * DM + o);
    const float4 a = make_float4(lo_bf(pa[0]), hi_bf(pa[0]), lo_bf(pa[1]), hi_bf(pa[1])), b = make_float4(lo_bf(pb[0]), hi_bf(pb[0]), lo_bf(pb[1]), hi_bf(pb[1]));
    const float4 g = *(const float4*)(g2 + 4 * lane + 256 * i);
    x.x += g.x * (a.x + b.x); x.y += g.y * (a.y + b.y); x.z += g.z * (a.z + b.z); x.w += g.w * (a.w + b.w);
    st16_wt(p.out + o, x);
  }
}

DI void conv_act(const Params& p, int l, int gid, int gstride) {
  const u16* u = (const u16*)(p.ws + WS_Z);
  u16* act = (u16*)(p.ws + WS_ACT);
  const float* cw = p.conv_w + (size_t)l * 3 * DFF2;
  const float* cb = p.conv_b + (size_t)l * DFF2;
  for (int idx = gid; idx < (NTOK / 4) * 352; idx += gstride) {
    const int tok0 = (idx / 352) * 4, c0 = (idx % 352) * 8;
    int pos, L;
    if (tok0 < NCTX) { pos = tok0 & 255; L = 256; } else { pos = (tok0 - NCTX) & 1023; L = 1024; }
    u32x4 ua[6], ug[6];
#pragma unroll
    for (int d = 0; d < 6; ++d) {
      const int pp = pos + d - 1;
      if (pp >= 0 && pp < L) {
        const u16* ur = u + (size_t)(tok0 + d - 1) * DFF2;
        ua[d] = *(const u32x4*)(ur + c0); ug[d] = *(const u32x4*)(ur + DFF + c0);
      } else { ua[d] = u32x4{0u, 0u, 0u, 0u}; ug[d] = u32x4{0u, 0u, 0u, 0u}; }
    }
    float wa[3][8], wg[3][8], ba[8], bg[8];
#pragma unroll
    for (int d = 0; d < 3; ++d) {
      const float4 x0 = *(const float4*)(cw + d * DFF2 + c0), x1 = *(const float4*)(cw + d * DFF2 + c0 + 4);
      const float4 y0 = *(const float4*)(cw + d * DFF2 + DFF + c0), y1 = *(const float4*)(cw + d * DFF2 + DFF + c0 + 4);
      wa[d][0] = x0.x; wa[d][1] = x0.y; wa[d][2] = x0.z; wa[d][3] = x0.w; wa[d][4] = x1.x; wa[d][5] = x1.y; wa[d][6] = x1.z; wa[d][7] = x1.w;
      wg[d][0] = y0.x; wg[d][1] = y0.y; wg[d][2] = y0.z; wg[d][3] = y0.w; wg[d][4] = y1.x; wg[d][5] = y1.y; wg[d][6] = y1.z; wg[d][7] = y1.w;
    }
    {
      const float4 x0 = *(const float4*)(cb + c0), x1 = *(const float4*)(cb + c0 + 4);
      const float4 y0 = *(const float4*)(cb + DFF + c0), y1 = *(const float4*)(cb + DFF + c0 + 4);
      ba[0] = x0.x; ba[1] = x0.y; ba[2] = x0.z; ba[3] = x0.w; ba[4] = x1.x; ba[5] = x1.y; ba[6] = x1.z; ba[7] = x1.w;
      bg[0] = y0.x; bg[1] = y0.y; bg[2] = y0.z; bg[3] = y0.w; bg[4] = y1.x; bg[5] = y1.y; bg[6] = y1.z; bg[7] = y1.w;
    }
#pragma unroll
    for (int tt = 0; tt < 4; ++tt) {
      u32x4 o;
#pragma unroll
      for (int q = 0; q < 4; ++q) {
        float a0 = ba[2 * q], a1 = ba[2 * q + 1], g0 = bg[2 * q], g1 = bg[2 * q + 1];
#pragma unroll
        for (int d = 0; d < 3; ++d) {
          a0 += wa[d][2 * q] * lo_bf(ua[tt + d][q]); a1 += wa[d][2 * q + 1] * hi_bf(ua[tt + d][q]);
          g0 += wg[d][2 * q] * lo_bf(ug[tt + d][q]); g1 += wg[d][2 * q + 1] * hi_bf(ug[tt + d][q]);
        }
        o[q] = pack2(g0 * sigmoidf_(g0) * a0, g1 * sigmoidf_(g1) * a1);
      }
      st16_wt(act + (size_t)(tok0 + tt) * DFF + c0, o);
    }
  }
}

DI void prep_wave(const Params& p, int l, int item) {
  const int lane = tid_() & 63;
  char* ws = p.ws;
  u16* qA = (u16*)(ws + WS_QA); u16* qC = (u16*)(ws + WS_QC);
  u16* kA = (u16*)(ws + WS_KA); u16* vA = (u16*)(ws + WS_VA);
  u16* kC = (u16*)(ws + WS_KC); u16* vC = (u16*)(ws + WS_VC);
  if (item >= NTOK) {
    const int cr = item - NTOK, b = cr >> 9, key = cr & 511;
    const size_t keyrow = 4096 + b * 1536 + key;
    const size_t srow = (size_t)(b * 2 + l) * 512 + key;
    float v[12];
#pragma unroll
    for (int u = 0; u < 12; ++u) {
      if (u < 2) v[u] = p.cache_a_k[srow * 128 + u * 64 + lane];
      else if (u < 4) v[u] = p.cache_a_v[srow * 128 + (u - 2) * 64 + lane];
      else if (u < 8) v[u] = p.cache_c_k[srow * 256 + (u - 4) * 64 + lane];
      else v[u] = p.cache_c_v[srow * 256 + (u - 8) * 64 + lane];
    }
#pragma unroll
    for (int u = 0; u < 12; ++u) {
      if (u < 2) kA[keyrow * 128 + u * 64 + lane] = f2bf(v[u]);
      else if (u < 4) vA[keyrow * 128 + (u - 2) * 64 + lane] = f2bf(v[u]);
      else if (u < 8) kC[keyrow * 256 + (u - 4) * 64 + lane] = f2bf(v[u]);
      else vC[keyrow * 256 + (u - 8) * 64 + lane] = f2bf(v[u]);
    }
    return;
  }
  const int tok = item;
  const bool sample = tok >= NCTX;
  int b, pos;
  size_t keyrow;
  if (!sample) { b = tok >> 8; pos = tok & 255; keyrow = tok; }
  else { b = (tok - NCTX) >> 10; pos = (tok - NCTX) & 1023; keyrow = 4096 + b * 1536 + 512 + pos; }
  const size_t crow_o = (size_t)(b * 2 + l) * 256 + pos;
  const u16* zr = (const u16*)(ws + WS_Z) + (size_t)tok * INW;
  const float rowp = (float)(pos >> 6), colp = (float)(pos & 63);
  u16 raw[20];
#pragma unroll
  for (int u = 0; u < 20; ++u) raw[u] = zr[u * 64 + lane];
  float cosA = 1.f, sinA = 0.f, cosC = 1.f, sinC = 0.f;
  if (sample) {
    {
      const int a = lane >> 5, i = lane & 15;
      const float ang = (a ? colp : rowp) * exp2f(-(float)i * (0.0625f * 13.287712379549449f));
      cosA = __cosf(ang); sinA = __sinf(ang);
      if (!((lane >> 4) & 1)) sinA = -sinA;
    }
    {
      const int dd = lane & 31, a = dd >> 4, i = dd & 7;
      const float ang = (a ? colp : rowp) * exp2f(-(float)i * (0.125f * 13.287712379549449f));
      cosC = __cosf(ang); sinC = __sinf(ang);
      if (!((dd >> 3) & 1)) sinC = -sinC;
    }
  }
  const float gaq = p.a_qn_g[l * 64 + lane], gak = p.a_kn_g[l * 64 + lane];
  const float gcq = p.c_qn_g[l * 32 + (lane & 31)], gck = p.c_kn_g[l * 32 + (lane & 31)];
#pragma unroll
  for (int u = 0; u < 20; ++u) {
    const float x = bf2f(raw[u]);
    if (u < 6) {
      const bool isq = u < 4;
      const int hd = isq ? u : u - 4;
      const float ss = wave_sum(x * x);
      float y = x * rsqrtf(ss * (1.f / 64.f) + EPSN) * (isq ? gaq : gak);
      if (!sample && !isq) p.out[O_CAK + crow_o * 128 + hd * 64 + lane] = y;
      if (sample) { const float pr = __shfl_xor(y, 16); y = y * cosA + pr * sinA; }
      if (isq) qA[(size_t)tok * 256 + hd * 64 + lane] = f2bf(y);
      else kA[keyrow * 128 + hd * 64 + lane] = f2bf(y);
    } else if (u < 8) {
      const int hd = u - 6;
      if (!sample) p.out[O_CAV + crow_o * 128 + hd * 64 + lane] = x;
      vA[keyrow * 128 + hd * 64 + lane] = raw[u];
    } else if (u < 16) {
      const bool isq = u < 12;
      const int pr2 = isq ? u - 8 : u - 12;
      float ss = x * x;
#pragma unroll
      for (int o = 16; o >= 1; o >>= 1) ss += __shfl_xor(ss, o);
      float y = x * rsqrtf(ss * (1.f / 32.f) + EPSN) * (isq ? gcq : gck);
      if (!sample && !isq) p.out[O_CCK + crow_o * 256 + pr2 * 64 + lane] = y;
      if (sample) { const float pr = __shfl_xor(y, 8); y = y * cosC + pr * sinC; }
      if (isq) qC[(size_t)tok * 256 + pr2 * 64 + lane] = f2bf(y);
      else kC[keyrow * 256 + pr2 * 64 + lane] = f2bf(y);
    } else {
      const int hd = u - 16;
      if (!sample) p.out[O_CCV + crow_o * 256 + hd * 64 + lane] = x;
      vC[keyrow * 256 + hd * 64 + lane] = raw[u];
    }
  }
}

template <bool ISC>
DI void attn_item(const Params& p, int l, int tok0, int keyrow0, int nkeys, int head, int split, char* smraw) {
  constexpr int NM = ISC ? 2 : 1;
  u16* Ks = (u16*)smraw;
  u16* Vs = Ks + 2 * 64 * 72;
  const u16* qbuf = (const u16*)(p.ws + (ISC ? WS_QC : WS_QA));
  const u16* kbuf = (const u16*)(p.ws + (ISC ? WS_KC : WS_KA));
  const u16* vbuf = (const u16*)(p.ws + (ISC ? WS_VC : WS_VA));
  const int kstride = ISC ? 256 : 128;
  const int koff = ISC ? head * 64 : (head >> 1) * 64;
  const float c2 = (ISC ? 0.17677669529663687f : 0.125f) * 1.4426950408889634f;
  const int t = tid_(), lane = t & 63, w = t >> 6, r = lane & 31, h = lane >> 5;
  const int i16 = lane & 15, tq = i16 >> 2, tp = i16 & 3, blk = (lane >> 4) & 1;
  bf16x8 qf[4];
  {
    const u16* qp = qbuf + (size_t)(tok0 + 32 * w + r) * 256 + head * 64 + 8 * h;
#pragma unroll
    for (int s = 0; s < 4; ++s) qf[s] = *(const bf16x8*)(qp + 16 * s);
  }
  f32x16 O[NM][2];
  float mrun[NM], lsum[NM];
#pragma unroll
  for (int m = 0; m < NM; ++m) {
    mrun[m] = -INFINITY; lsum[m] = 0.f;
#pragma unroll
    for (int d = 0; d < 2; ++d)
#pragma unroll
      for (int e = 0; e < 16; ++e) O[m][d][e] = 0.f;
  }
  const int lrow = t >> 3, lc8 = (t & 7) * 8;
  const u16* kg = kbuf + (size_t)(keyrow0 + lrow) * kstride + koff + lc8;
  const u16* vg = vbuf + (size_t)(keyrow0 + lrow) * kstride + koff + lc8;
  u32x4 rk[2], rv[2];
#pragma unroll
  for (int i = 0; i < 2; ++i) { rk[i] = *(const u32x4*)(kg + (size_t)(32 * i) * kstride); rv[i] = *(const u32x4*)(vg + (size_t)(32 * i) * kstride); }
#pragma unroll
  for (int i = 0; i < 2; ++i) {
    *(u32x4*)(Ks + (lrow + 32 * i) * 72 + lc8) = rk[i];
    *(u32x4*)(Vs + (lrow + 32 * i) * 72 + lc8) = rv[i];
  }
  vb_sync();
  const int NT = nkeys >> 6;
  for (int kt = 0; kt < NT; ++kt) {
    const int buf = kt & 1;
    if (kt + 1 < NT) {
#pragma unroll
      for (int i = 0; i < 2; ++i) {
        rk[i] = *(const u32x4*)(kg + (size_t)((kt + 1) * 64 + 32 * i) * kstride);
        rv[i] = *(const u32x4*)(vg + (size_t)((kt + 1) * 64 + 32 * i) * kstride);
      }
    }
    const u16* kb_ = Ks + buf * 64 * 72;
    const u16* vb_ = Vs + buf * 64 * 72;
#pragma unroll
    for (int kb = 0; kb < 2; ++kb) {
      f32x16 S[NM];
#pragma unroll
      for (int m = 0; m < NM; ++m)
#pragma unroll
        for (int e = 0; e < 16; ++e) S[m][e] = 0.f;
      __builtin_amdgcn_s_setprio(1);
#pragma unroll
      for (int s = 0; s < 4; ++s) {
        const int m = ISC ? (s >> 1) : 0;
        const bf16x8 kf = *(const bf16x8*)(kb_ + (kb * 32 + r) * 72 + 16 * s + 8 * h);
        S[m] = MFMA(kf, qf[s], S[m]);
      }
      __builtin_amdgcn_s_setprio(0);
#pragma unroll
      for (int m = 0; m < NM; ++m) {
        float mx = S[m][0];
#pragma unroll
        for (int e = 1; e < 16; ++e) mx = fmaxf(mx, S[m][e]);
        mx = fmaxf(mx, __shfl_xor(mx, 32));
        const float mnew = fmaxf(mrun[m], mx);
        const float alpha = __builtin_amdgcn_exp2f((mrun[m] - mnew) * c2);
        mrun[m] = mnew;
        const float mc = mnew * c2;
        float ps = 0.f;
#pragma unroll
        for (int e = 0; e < 16; ++e) { const float pe = __builtin_amdgcn_exp2f(S[m][e] * c2 - mc); S[m][e] = pe; ps += pe; }
        lsum[m] = lsum[m] * alpha + ps;
        if (__any(alpha != 1.f)) {
#pragma unroll
          for (int d = 0; d < 2; ++d)
#pragma unroll
            for (int e = 0; e < 16; ++e) O[m][d][e] *= alpha;
        }
      }
#pragma unroll
      for (int st = 0; st < 2; ++st) {
        bf16x8 pf[NM];
#pragma unroll
        for (int m = 0; m < NM; ++m) pf[m] = pack8(S[m], st);
#pragma unroll
        for (int d = 0; d < 2; ++d) {
          const u16* vp = vb_ + (kb * 32 + 16 * st + 4 * h + tq) * 72 + d * 32 + 16 * blk + 4 * tp;
          const bf16x8 vf = trpair(vp, vp + 8 * 72);
          __builtin_amdgcn_s_setprio(1);
#pragma unroll
          for (int m = 0; m < NM; ++m) O[m][d] = MFMA(vf, pf[m], O[m][d]);
          __builtin_amdgcn_s_setprio(0);
        }
      }
    }
    if (kt + 1 < NT) {
      const int nb = (buf ^ 1) * 64 * 72;
#pragma unroll
      for (int i = 0; i < 2; ++i) {
        *(u32x4*)(Ks + nb + (lrow + 32 * i) * 72 + lc8) = rk[i];
        *(u32x4*)(Vs + nb + (lrow + 32 * i) * 72 + lc8) = rv[i];
      }
    }
    vb_sync();
  }
  if (split >= 0) {
    const int ts = tok0 - NCTX + 32 * w + r;
#pragma unroll
    for (int m = 0; m < NM; ++m) {
      const float lt = lsum[m] + __shfl_xor(lsum[m], 32);
      float* op = ISC ? (float*)(p.ws + WS_PC) + ((size_t)((split * 2048 + ts) * 4 + head) * 2 + m) * 64
                      : (float*)(p.ws + WS_PA) + (size_t)((split * 2048 + ts) * 4 + head) * 64;
#pragma unroll
      for (int d = 0; d < 2; ++d)
#pragma unroll
        for (int g = 0; g < 4; ++g)
          st16_wt(op + d * 32 + 8 * g + 4 * h, make_float4(O[m][d][4 * g], O[m][d][4 * g + 1], O[m][d][4 * g + 2], O[m][d][4 * g + 3]));
      if (h == 0) {
        float* mp = (float*)(p.ws + WS_PML) + ((size_t)((split * 2048 + ts) * 8 + (ISC ? 4 : 0) + head) * 2 + m) * 2;
        mp[0] = mrun[m]; mp[1] = lt;
      }
    }
    return;
  }
  float inv[NM];
#pragma unroll
  for (int m = 0; m < NM; ++m) { const float lt = lsum[m] + __shfl_xor(lsum[m], 32); inv[m] = rcp_(lt); }
  const int tok = tok0 + 32 * w + r;
  u16* yc = (u16*)(p.ws + WS_YCAT) + (size_t)tok * 1024;
  if (!ISC) {
#pragma unroll
    for (int d = 0; d < 2; ++d)
#pragma unroll
      for (int g = 0; g < 4; ++g) {
        u32x2 q;
        q[0] = pack2(O[0][d][4 * g] * inv[0], O[0][d][4 * g + 1] * inv[0]);
        q[1] = pack2(O[0][d][4 * g + 2] * inv[0], O[0][d][4 * g + 3] * inv[0]);
        *(u32x2*)(yc + head * 64 + d * 32 + 8 * g + 4 * h) = q;
      }
  } else {
    const float* cl = p.c_lambda + l * 128;
    float d1 = 0.f, d2 = 0.f;
    for (int i = 0; i < 32; ++i) { d1 += cl[i] * cl[32 + i]; d2 += cl[64 + i] * cl[96 + i]; }
    const float lam_init = 0.8f - 0.6f * __expf(-0.3f * (float)l);
    const float lam = __expf(d1) - __expf(d2) + lam_init;
    float ss = 0.f;
#pragma unroll
    for (int d = 0; d < 2; ++d)
#pragma unroll
      for (int e = 0; e < 16; ++e) {
        const float dv = O[0][d][e] * inv[0] - lam * (O[NM - 1][d][e] * inv[NM - 1]);
        O[0][d][e] = dv; ss += dv * dv;
      }
    ss += __shfl_xor(ss, 32);
    const float sc = rsqrtf(ss * (1.f / 64.f) + EPSN) * (1.f - lam_init);
    const float* sg = p.c_subln_g + l * 64;
#pragma unroll
    for (int d = 0; d < 2; ++d)
#pragma unroll
      for (int g = 0; g < 4; ++g) {
        const int dv0 = d * 32 + 8 * g + 4 * h;
        u32x2 q;
        q[0] = pack2(O[0][d][4 * g] * sc * sg[dv0], O[0][d][4 * g + 1] * sc * sg[dv0 + 1]);
        q[1] = pack2(O[0][d][4 * g + 2] * sc * sg[dv0 + 2], O[0][d][4 * g + 3] * sc * sg[dv0 + 3]);
        *(u32x2*)(yc + 512 + head * 64 + dv0) = q;
      }
  }
}
DI void attn_dispatch(const Params& p, int l, int item, char* sm) {
  if (item < 384) {
    const int j = item % 192, split = j / 64, jj = j & 63, b = jj >> 5, qb = (jj >> 2) & 7, head = jj & 3;
    const int tok0 = NCTX + b * 1024 + qb * 128, kr0 = 4096 + b * 1536 + split * 512;
    if (item < 192) attn_item<true>(p, l, tok0, kr0, 512, head, split, sm);
    else attn_item<false>(p, l, tok0, kr0, 512, head, split, sm);
  } else {
    const int j = (item - 384) & 127, sq = j >> 3, qb = (j >> 2) & 1, head = j & 3;
    const int tok0 = sq * 256 + qb * 128, kr0 = sq * 256;
    if (item < 512) attn_item<true>(p, l, tok0, kr0, 256, head, -1, sm);
    else attn_item<false>(p, l, tok0, kr0, 256, head, -1, sm);
  }
}
DI void attn_combine(const Params& p, int l, int item) {
  const int lane = tid_() & 63;
  const int ts = item >> 1, isc = item & 1;
  const float* ml = (const float*)(p.ws + WS_PML);
  u16* yc = (u16*)(p.ws + WS_YCAT) + (size_t)(NCTX + ts) * 1024;
  if (!isc) {
    const float c2 = 0.125f * 1.4426950408889634f;
    float m[4][3], lv[4][3], o[4][3];
#pragma unroll
    for (int hd = 0; hd < 4; ++hd)
#pragma unroll
      for (int sp = 0; sp < 3; ++sp) {
        const float2 mm = *(const float2*)(ml + ((size_t)((sp * 2048 + ts) * 8 + hd) * 2) * 2);
        m[hd][sp] = mm.x; lv[hd][sp] = mm.y;
        o[hd][sp] = ((const float*)(p.ws + WS_PA))[(size_t)((sp * 2048 + ts) * 4 + hd) * 64 + lane];
      }
#pragma unroll
    for (int hd = 0; hd < 4; ++hd) {
      const float M = fmaxf(m[hd][0], fmaxf(m[hd][1], m[hd][2]));
      float num = 0.f, den = 0.f;
#pragma unroll
      for (int sp = 0; sp < 3; ++sp) { const float wgt = exp2f((m[hd][sp] - M) * c2); num += wgt * o[hd][sp]; den += wgt * lv[hd][sp]; }
      yc[hd * 64 + lane] = f2bf(num * rcp_(den));
    }
  } else {
    const float c2 = 0.17677669529663687f * 1.4426950408889634f;
    const float* cl = p.c_lambda + l * 128;
    const float d1 = wave_sum(lane < 32 ? cl[lane] * cl[32 + lane] : 0.f), d2 = wave_sum(lane < 32 ? cl[64 + lane] * cl[96 + lane] : 0.f);
    const float lam_init = 0.8f - 0.6f * __expf(-0.3f * (float)l);
    const float lam = __expf(d1) - __expf(d2) + lam_init;
    const float sgv = p.c_subln_g[l * 64 + lane];
    float m[4][2][3], lv[4][2][3], o[4][2][3];
#pragma unroll
    for (int hd = 0; hd < 4; ++hd)
#pragma unroll
      for (int mm = 0; mm < 2; ++mm)
#pragma unroll
        for (int sp = 0; sp < 3; ++sp) {
          const float2 q = *(const float2*)(ml + ((size_t)((sp * 2048 + ts) * 8 + 4 + hd) * 2 + mm) * 2);
          m[hd][mm][sp] = q.x; lv[hd][mm][sp] = q.y;
          o[hd][mm][sp] = ((const float*)(p.ws + WS_PC))[((size_t)((sp * 2048 + ts) * 4 + hd) * 2 + mm) * 64 + lane];
        }
#pragma unroll
    for (int hd = 0; hd < 4; ++hd) {
      float res[2];
#pragma unroll
      for (int mm = 0; mm < 2; ++mm) {
        const float M = fmaxf(m[hd][mm][0], fmaxf(m[hd][mm][1], m[hd][mm][2]));
        float num = 0.f, den = 0.f;
#pragma unroll
        for (int sp = 0; sp < 3; ++sp) { const float wgt = exp2f((m[hd][mm][sp] - M) * c2); num += wgt * o[hd][mm][sp]; den += wgt * lv[hd][mm][sp]; }
        res[mm] = num * rcp_(den);
      }
      const float dv = res[0] - lam * res[1];
      const float ss = wave_sum(dv * dv);
      const float sc = rsqrtf(ss * (1.f / 64.f) + EPSN) * (1.f - lam_init);
      yc[512 + hd * 64 + lane] = f2bf(dv * sc * sgv);
    }
  }
}

template <bool GLA>
struct ScanCtx { float wa[16]; float ba, lbm, oml; int ldir; };
template <bool GLA>
DI void scan_init(const Params& p, int l, int head, int dirh, int lane, ScanCtx<GLA>& cx) {
  const int ldir = GLA ? (lane >> 5) : dirh;
  cx.ldir = ldir;
  if (GLA) {
    const int kc = lane & 31;
#pragma unroll
    for (int j = 0; j < 16; ++j) cx.wa[j] = p.d_alpha_w[((size_t)(l * 2 + ldir) * 16 + j) * 128 + head * 32 + kc];
    cx.ba = p.d_alpha_b[(l * 2 + ldir) * 128 + head * 32 + kc];
  } else {
    float lb = 0.f;
    if (l > 0) {
      const float x0 = p.b_lb_logits[(ldir * 2 + 0) * 256 + head * 64 + lane], x1 = p.b_lb_logits[(ldir * 2 + 1) * 256 + head * 64 + lane];
      lb = 1.f / (1.f + __expf(x0 - x1));
    }
    cx.lbm = fmaxf(lb, 1e-30f); cx.oml = 1.f - lb;
  }
}
template <bool GLA>
DI float scan_la(const ScanCtx<GLA>& cx, const u16* kraw, const u16* rt, int pp, int lane, float& kk) {
  if (GLA) {
    const u32x4 r0 = *(const u32x4*)(rt + pp * 32 + cx.ldir * 16), r1 = *(const u32x4*)(rt + pp * 32 + cx.ldir * 16 + 8);
    float v = cx.ba;
#pragma unroll
    for (int q = 0; q < 4; ++q) {
      v += cx.wa[2 * q] * lo_bf(r0[q]) + cx.wa[2 * q + 1] * hi_bf(r0[q]);
      v += cx.wa[8 + 2 * q] * lo_bf(r1[q]) + cx.wa[8 + 2 * q + 1] * hi_bf(r1[q]);
    }
    kk = bf2f(kraw[pp * 72 + lane]);
    return (fminf(v, 0.f) - __logf(1.f + __expf(-fabsf(v)))) * (1.f / 16.f);
  } else {
    const float zz = bf2f(kraw[pp * 72 + lane]);
    const float sig = rcp_(1.f + __expf(-zz));
    kk = cx.oml * rcp_(1.f + __expf(zz));
    return __logf(cx.lbm + cx.oml * sig);
  }
}
DI void stage64(u16* dst, const u16* z, int start, int col, int lane) {
  u32x4 v[4];
#pragma unroll
  for (int i = 0; i < 4; ++i) v[i] = *(const u32x4*)(z + (size_t)(start + (lane >> 3) + 8 * i) * INW + col + (lane & 7) * 8);
#pragma unroll
  for (int i = 0; i < 4; ++i) *(u32x4*)(dst + ((lane >> 3) + 8 * i) * 72 + (lane & 7) * 8) = v[i];
}
DI void stage32dup(u16* dst, const u16* z, int start, int col, int lane) {
  const int row = lane >> 1, c16 = (lane & 1) * 16;
  const u16* sp = z + (size_t)(start + row) * INW + col + c16;
  const u32x4 v0 = *(const u32x4*)sp, v1 = *(const u32x4*)(sp + 8);
  *(u32x4*)(dst + row * 72 + c16) = v0; *(u32x4*)(dst + row * 72 + c16 + 8) = v1;
  *(u32x4*)(dst + row * 72 + 32 + c16) = v0; *(u32x4*)(dst + row * 72 + 32 + c16 + 8) = v1;
}
DI void stage_r(u16* rt, const u16* z, int start, int lane) {
  const int row = lane >> 1, c16 = (lane & 1) * 16;
  const u16* sp = z + (size_t)(start + row) * INW + ZD_RF + c16;
  const u32x4 v0 = *(const u32x4*)sp, v1 = *(const u32x4*)(sp + 8);
  *(u32x4*)(rt + row * 32 + c16) = v0; *(u32x4*)(rt + row * 32 + c16 + 8) = v1;
}
DI int tile_id(bool gla, int chunk, int head, int dir) { return gla ? 1536 + chunk * 4 + head : (chunk * 4 + head) * 2 + dir; }

constexpr int S1_WAVE_U16 = 2 * 32 * 72 + 32 * 32;
template <bool GLA>
DI void scan_s1(const Params& p, int l, int chunk, int head, int dir, u16* smw) {
  const int lane = tid_() & 63, r = lane & 31, h = lane >> 5;
  const int i16 = lane & 15, tq = i16 >> 2, tp = i16 & 3, blk = (lane >> 4) & 1;
  u16* ko = smw;
  u16* vt = smw + 32 * 72;
  u16* rt = smw + 2 * 32 * 72;
  const int start = chunk * 32;
  const u16* z = (const u16*)(p.ws + WS_Z);
  stage64(vt, z, start, (GLA ? ZD_V : ZB_I) + head * 64, lane);
  if (GLA) { stage32dup(ko, z, start, ZD_K + head * 32, lane); stage_r(rt, z, start, lane); }
  else stage64(ko, z, start, (dir ? ZB_FB : ZB_FF) + head * 64, lane);
  ScanCtx<GLA> cx;
  scan_init<GLA>(p, l, head, dir, lane, cx);
  wave_sync_();
  float cl_lane;
  {
    const int ldir = cx.ldir;
    float kk, cum = 0.f;
#pragma unroll 8
    for (int i = 0; i < 32; ++i) {
      const int pp = ldir ? 31 - i : i;
      cum += scan_la<GLA>(cx, ko, rt, pp, lane, kk);
      ko[pp * 72 + lane] = f2bf(kk * __expf(-cum));
    }
    cl_lane = cum;
    ((float*)(p.ws + WS_CL))[tile_id(GLA, chunk, head, dir) * 64 + lane] = cum;
  }
  wave_sync_();
  f32x16 acc[2][2];
  zero_acc<2>(acc);
#pragma unroll
  for (int st = 0; st < 2; ++st) {
    bf16x8 a[2], b[2];
#pragma unroll
    for (int x = 0; x < 2; ++x) {
      const u16* ap = vt + (16 * st + 8 * h + tq) * 72 + x * 32 + 16 * blk + 4 * tp;
      a[x] = trpair(ap, ap + 4 * 72);
      const u16* bp = ko + (16 * st + 8 * h + tq) * 72 + x * 32 + 16 * blk + 4 * tp;
      b[x] = trpair(bp, bp + 4 * 72);
    }
#pragma unroll
    for (int x = 0; x < 2; ++x)
#pragma unroll
      for (int y = 0; y < 2; ++y) acc[x][y] = MFMA(a[x], b[y], acc[x][y]);
  }
  {
    float* U = (float*)(p.ws + WS_U) + (size_t)tile_id(GLA, chunk, head, dir) * 4096;
    const float ecl_own = __expf(cl_lane);
    float ecl[2];
    ecl[0] = __shfl(ecl_own, r); ecl[1] = __shfl(ecl_own, 32 + r);
#pragma unroll
    for (int x = 0; x < 2; ++x)
#pragma unroll
      for (int y = 0; y < 2; ++y)
#pragma unroll
        for (int e = 0; e < 16; ++e) U[(x * 32 + crow(e, h)) * 64 + y * 32 + r] = acc[x][y][e] * ecl[y];
  }
  wave_sync_();
}
DI void scan_s1_block(const Params& p, int l, int bitem, char* sm) {
  const int w = tid_() >> 6;
  int wi = bitem * 4 + w;
  u16* smw = (u16*)sm + w * S1_WAVE_U16;
  if (bitem < 384) scan_s1<false>(p, l, wi >> 3, (wi >> 1) & 3, wi & 1, smw);
  else { wi -= 1536; scan_s1<true>(p, l, wi >> 2, wi & 3, 0, smw); }
}

DI void scan_s2_item(const Params& p, int l, int item) {
  const int t = tid_();
  const int unit = item >> 2, vq = item & 3;
  bool gla;
  int seq, head, dir;
  if (unit < 16) { gla = false; seq = 16 + (unit >> 3); head = (unit >> 1) & 3; dir = unit & 1; }
  else if (unit < 24) { gla = true; const int g = unit - 16; seq = 16 + (g >> 2); head = g & 3; dir = 0; }
  else if (unit < 152) { gla = false; const int u = unit - 24; seq = u >> 3; head = (u >> 1) & 3; dir = u & 1; }
  else { gla = true; const int g = unit - 152; seq = g >> 2; head = g & 3; dir = 0; }
  const int c = t & 63;
  const int dc = gla ? (c >> 5) : dir;
  int N, chunk0;
  if (seq < 16) { N = 8; chunk0 = seq * 8; } else { N = 32; chunk0 = 128 + (seq - 16) * 32; }
  float S[4];
  int vv[4];
#pragma unroll
  for (int i = 0; i < 4; ++i) {
    vv[i] = vq * 16 + (t >> 6) + 4 * i;
    if (seq < 16) S[i] = 0.f;
    else {
      const int b = seq - 16;
      S[i] = gla ? p.state_gla[(size_t)(((b * 2 + l) * 2 + dc) * 4 + head) * 2048 + (c & 31) * 64 + vv[i]]
                 : p.state_hgrn[(size_t)(((b * 2 + l) * 2 + dc) * 4 + head) * 4096 + c * 64 + vv[i]];
    }
  }
  const float* __restrict__ U = (const float*)(p.ws + WS_U);
  const float* __restrict__ CL = (const float*)(p.ws + WS_CL);
  float* __restrict__ SS = (float*)(p.ws + WS_S);
  for (int m0 = 0; m0 < N; m0 += 8) {
    float tmp[8][4], a[8];
    int ids[8];
#pragma unroll
    for (int mm = 0; mm < 8; ++mm) {
      const int m = m0 + mm;
      ids[mm] = tile_id(gla, chunk0 + (dc ? N - 1 - m : m), head, dir);
      a[mm] = CL[ids[mm] * 64 + c];
#pragma unroll
      for (int i = 0; i < 4; ++i) tmp[mm][i] = U[(size_t)ids[mm] * 4096 + vv[i] * 64 + c];
    }
#pragma unroll
    for (int mm = 0; mm < 8; ++mm) {
      const float ea = __expf(a[mm]);
#pragma unroll
      for (int i = 0; i < 4; ++i) {
        SS[(size_t)ids[mm] * 4096 + vv[i] * 64 + c] = S[i];
        S[i] = ea * S[i] + tmp[mm][i];
      }
    }
  }
  if (seq < 16) {
#pragma unroll
    for (int i = 0; i < 4; ++i) {
      if (gla) p.out[O_SG + (size_t)(((seq * 2 + l) * 2 + dc) * 4 + head) * 2048 + (c & 31) * 64 + vv[i]] = S[i];
      else p.out[O_SH + (size_t)(((seq * 2 + l) * 2 + dc) * 4 + head) * 4096 + c * 64 + vv[i]] = S[i];
    }
  }
}

constexpr int S3_WAVE_U16 = 3 * 32 * 72 + 128 + 32 * 32;
template <bool GLA>
DI void scan_s3(const Params& p, int l, int chunk, int head, u16* smw) {
  const int lane = tid_() & 63, r = lane & 31, h = lane >> 5;
  const int i16 = lane & 15, tq = i16 >> 2, tp = i16 & 3, blk = (lane >> 4) & 1;
  u16* qt = smw;
  u16* kt = smw + 32 * 72;
  u16* vt = smw + 2 * 32 * 72;
  float* sref = (float*)(smw + 3 * 32 * 72);
  u16* rt = smw + 3 * 32 * 72 + 128;
  const int start = chunk * 32;
  const u16* z = (const u16*)(p.ws + WS_Z);
  stage64(vt, z, start, (GLA ? ZD_V : ZB_I) + head * 64, lane);
  if (GLA) stage_r(rt, z, start, lane);
  f32x16 o[2];
#pragma unroll
  for (int x = 0; x < 2; ++x)
#pragma unroll
    for (int e = 0; e < 16; ++e) o[x][e] = 0.f;
  constexpr int NPASS = GLA ? 1 : 2;
#pragma unroll 1
  for (int pass = 0; pass < NPASS; ++pass) {
    if (GLA) { stage32dup(qt, z, start, ZD_Q + head * 32, lane); stage32dup(kt, z, start, ZD_K + head * 32, lane); }
    else { stage64(qt, z, start, ZB_Q + head * 64, lane); stage64(kt, z, start, (pass ? ZB_FB : ZB_FF) + head * 64, lane); }
    const float* Sg = (const float*)(p.ws + WS_S) + (size_t)tile_id(GLA, chunk, head, pass) * 4096;
    ScanCtx<GLA> cx;
    scan_init<GLA>(p, l, head, pass, lane, cx);
    wave_sync_();
    {
      const int ldir = cx.ldir;
      float kk, cum = 0.f;
      const float ref = 0.5f * ((const float*)(p.ws + WS_CL))[tile_id(GLA, chunk, head, pass) * 64 + lane];
      sref[lane] = __expf(ref);
#pragma unroll 8
      for (int i = 0; i < 32; ++i) {
        const int pp = ldir ? 31 - i : i;
        cum += scan_la<GLA>(cx, kt, rt, pp, lane, kk);
        const float zq = bf2f(qt[pp * 72 + lane]);
        const float qv = GLA ? zq * 0.17677669529663687f : zq * sigmoidf_(zq);
        qt[pp * 72 + lane] = f2bf(qv * __expf(cum - ref));
        kt[pp * 72 + lane] = f2bf(kk * __expf(ref - cum));
      }
    }
    wave_sync_();
    constexpr int NS = GLA ? 2 : 1;
    f32x16 sc[NS];
#pragma unroll
    for (int m = 0; m < NS; ++m)
#pragma unroll
      for (int e = 0; e < 16; ++e) sc[m][e] = 0.f;
    bf16x8 qfr[4];
#pragma unroll
    for (int st = 0; st < 4; ++st) {
      qfr[st] = *(const bf16x8*)(qt + r * 72 + 16 * st + 8 * h);
      const bf16x8 kf = *(const bf16x8*)(kt + r * 72 + 16 * st + 8 * h);
      const int m = GLA ? (st >> 1) : 0;
      sc[m] = MFMA(kf, qfr[st], sc[m]);
    }
#pragma unroll
    for (int m = 0; m < NS; ++m) {
      const int d = GLA ? m : pass;
#pragma unroll
      for (int e = 0; e < 16; ++e) {
        const int srow = crow(e, h);
        const bool keep = d ? (srow >= r) : (srow <= r);
        sc[m][e] = keep ? sc[m][e] : 0.f;
      }
#pragma unroll
      for (int st = 0; st < 2; ++st) {
        const bf16x8 pf = pack8(sc[m], st);
#pragma unroll
        for (int x = 0; x < 2; ++x) {
          const u16* vp = vt + (16 * st + 4 * h + tq) * 72 + x * 32 + 16 * blk + 4 * tp;
          const bf16x8 vf = trpair(vp, vp + 8 * 72);
          o[x] = MFMA(vf, pf, o[x]);
        }
      }
    }
#pragma unroll
    for (int x = 0; x < 2; ++x) {
      float4 s0[4], s1[4];
#pragma unroll
      for (int st = 0; st < 4; ++st) {
        const float* sp = Sg + (x * 32 + r) * 64 + 16 * st + 8 * h;
        s0[st] = *(const float4*)sp; s1[st] = *(const float4*)(sp + 4);
      }
#pragma unroll
      for (int st = 0; st < 4; ++st) {
        const float4 e0 = *(const float4*)(sref + 16 * st + 8 * h), e1 = *(const float4*)(sref + 16 * st + 8 * h + 4);
        u32x4 q;
        q[0] = pack2(s0[st].x * e0.x, s0[st].y * e0.y); q[1] = pack2(s0[st].z * e0.z, s0[st].w * e0.w);
        q[2] = pack2(s1[st].x * e1.x, s1[st].y * e1.y); q[3] = pack2(s1[st].z * e1.z, s1[st].w * e1.w);
        o[x] = MFMA(__builtin_bit_cast(bf16x8, q), qfr[st], o[x]);
      }
    }
    wave_sync_();
  }
  float ss = 0.f;
#pragma unroll
  for (int x = 0; x < 2; ++x)
#pragma unroll
    for (int e = 0; e < 16; ++e) ss += o[x][e] * o[x][e];
  ss += __shfl_xor(ss, 32);
  const float rstd = rsqrtf(ss * (1.f / 64.f) + EPSN);
  const int tok = start + r;
  const float* gn = (GLA ? p.d_norm_g : p.b_norm_g) + l * 64;
  const u16* gz = z + (size_t)tok * INW + (GLA ? ZD_G : ZB_G) + head * 64;
  u16* yc = (u16*)(p.ws + WS_YCAT) + (size_t)tok * 1024 + (GLA ? 768 : 256) + head * 64;
#pragma unroll
  for (int x = 0; x < 2; ++x)
#pragma unroll
    for (int g = 0; g < 4; ++g) {
      const int v0 = x * 32 + 8 * g + 4 * h;
      const u32x2 gr = *(const u32x2*)(gz + v0);
      const float g0 = lo_bf(gr[0]), g1 = hi_bf(gr[0]), g2 = lo_bf(gr[1]), g3 = hi_bf(gr[1]);
      u32x2 q;
      q[0] = pack2(o[x][4 * g] * rstd * gn[v0] * g0 * sigmoidf_(g0), o[x][4 * g + 1] * rstd * gn[v0 + 1] * g1 * sigmoidf_(g1));
      q[1] = pack2(o[x][4 * g + 2] * rstd * gn[v0 + 2] * g2 * sigmoidf_(g2), o[x][4 * g + 3] * rstd * gn[v0 + 3] * g3 * sigmoidf_(g3));
      *(u32x2*)(yc + v0) = q;
    }
}
DI void scan_s3_block(const Params& p, int l, int bitem, char* sm) {
  const int w = tid_() >> 6;
  u16* smw = (u16*)sm + w * S3_WAVE_U16;
  int wi = bitem * 4 + w;
  if (bitem < 192) scan_s3<false>(p, l, wi >> 2, wi & 3, smw);
  else { wi -= 768; scan_s3<true>(p, l, wi >> 2, wi & 3, smw); }
}

DI void run_phase(const Params& p, int ph, char* smfull, bool dry) {
  const int half = __builtin_amdgcn_readfirstlane(__builtin_amdgcn_workitem_id_x() >> 8);
  const int bid = 2 * blockIdx.x + half, nb = 2 * gridDim.x;
  char* sm = smfull + half * SMEM_BYTES;
#ifdef PHASE_ONLY
  if (ph != 0 && (ph - 1) % 11 != PHASE_ONLY - 1) return;
  if (ph == 0 && PHASE_ONLY != 0) return;
#endif
  if (ph == 0) {
    if (nb == 512) {
      const int vb = (int)blockIdx.x + 256 * half;
      if (vb < MOD_ITEMS) {
        mod_item(p, vb, sm);
        for (int j = 0; j < 8; ++j) convw_item(p, 0, 8 * vb + j, sm);
      } else {
        for (int it = 8 * MOD_ITEMS + (vb - MOD_ITEMS); it < CONVW_ITEMS; it += 128) convw_item(p, 0, it, sm);
      }
    } else {
      for (int it = bid; it < MOD_ITEMS + CONVW_ITEMS; it += nb) {
        if (it < MOD_ITEMS) mod_item(p, it, sm); else convw_item(p, 0, it - MOD_ITEMS, sm);
      }
    }
    return;
  }
  if (ph == 25) {
    const int w = tid_() >> 6;
    for (int tk = bid * 4 + w; tk < NTOK; tk += nb * 4) fold_part_tok(p, 1, tk);
    return;
  }
  const int l = (ph - 1) / 12, s = (ph - 1) % 12;
  if (s == 1 || s == 5 || s == 7 || s == 9 || s == 11) {
    gemm8_step(p, s, smfull);
    if (l == 0 && nb == 512) {
      if (s == 7 && blockIdx.x >= 192) { for (int it = 2 * ((int)blockIdx.x - 192) + half; it < 384; it += 128) convw_item(p, 1, it, sm); }
      else if (s == 9 && blockIdx.x >= 16) { for (int it = 384 + 2 * ((int)blockIdx.x - 16) + half; it < 2384; it += 480) convw_item(p, 1, it, sm); }
      else if (s == 11 && blockIdx.x >= 192) { for (int it = 2384 + 2 * ((int)blockIdx.x - 192) + half; it < 3664; it += 128) convw_item(p, 1, it, sm); }
    } else if (l == 1 && nb == 512) {
      if (s == 7 && blockIdx.x >= 192) { for (int it = 3664 + 2 * ((int)blockIdx.x - 192) + half; it < 3792; it += 128) convw_item(p, 1, it, sm); }
      else if (s == 9 && blockIdx.x >= 16) { for (int it = 3792 + 2 * ((int)blockIdx.x - 16) + half; it < 4496; it += 480) convw_item(p, 1, it, sm); }
    }
    return;
  }
  switch (s) {
    case 0: {
      const int w = tid_() >> 6;
      for (int tk = bid * 4 + w; tk < NTOK; tk += nb * 4) norm_tok(p, l, 0, tk);
      if (l > 0) for (int it = (nb == 512 ? CONVW_ITEMS : 0) + bid; it < CONVW_ITEMS; it += nb) convw_item(p, l, it, sm);
    } break;
    case 2:
      if (nb == 512) {
        const int vb = (int)blockIdx.x + 256 * half;
        scan_s1_block(p, l, vb, sm);
        if (vb < 64) scan_s1_block(p, l, 512 + vb, sm);
        else for (int j = 0; j < 4; ++j) prep_wave(p, l, (4 * (vb - 64) + j) * 4 + (tid_() >> 6));
      } else {
        for (int it = bid; it < 576 + 1792; it += nb) {
          if (it < 576) scan_s1_block(p, l, it, sm); else prep_wave(p, l, (it - 576) * 4 + (tid_() >> 6));
        }
      }
      break;
    case 3:
      if (nb == 512) {
        const int bid = (int)blockIdx.x + 256 * half;
        if (bid < 192) attn_dispatch(p, l, bid, sm);
        else if (bid < 320) { attn_dispatch(p, l, bid, sm); attn_dispatch(p, l, 512 + (bid - 192), sm); scan_s2_item(p, l, 96 + 640 + (bid - 192)); }
        else if (bid < 384) { attn_dispatch(p, l, bid, sm); for (int j = 0; j < 6; ++j) scan_s2_item(p, l, 96 + 6 * (bid - 320) + j); }
        else if (bid < 480) { scan_s2_item(p, l, bid - 384); attn_dispatch(p, l, bid, sm); }
        else { attn_dispatch(p, l, bid, sm); for (int j = 0; j < 8; ++j) scan_s2_item(p, l, 96 + 384 + 8 * (bid - 480) + j); }
      } else {
        for (int it = bid; it < 640 + 864; it += nb) {
          if (it < 96) scan_s2_item(p, l, it);
          else if (it < 480) attn_dispatch(p, l, it - 96, sm);
          else if (it < 1248) scan_s2_item(p, l, it - 384);
          else attn_dispatch(p, l, it - 864, sm);
        }
      }
      break;
    case 4:
      if (nb == 512) {
        const int vb = (int)blockIdx.x + 256 * half;
        if (vb < 384) scan_s3_block(p, l, vb, sm);
        else for (int j = 0; j < 8; ++j) attn_combine(p, l, (8 * (vb - 384) + j) * 4 + (tid_() >> 6));
      } else {
        for (int it = bid; it < 384 + 1024; it += nb) {
          if (it < 384) scan_s3_block(p, l, it, sm); else attn_combine(p, l, (it - 384) * 4 + (tid_() >> 6));
        }
      }
      break;
    case 6: {
      const int w = tid_() >> 6;
      for (int tk = bid * 4 + w; tk < NTOK; tk += nb * 4) fold_branch_tok(p, tk);
    } break;
    case 8: {
      const int w = tid_() >> 6;
      for (int tk = bid * 4 + w; tk < NTOK; tk += nb * 4) norm_tok(p, l, 1, tk);
    } break;
    case 10: conv_act(p, l, bid * 256 + tid_(), nb * 256); break;
  }
}

constexpr int DYN_LDS = 2 * SMEM_BYTES + 32;
__global__ void __launch_bounds__(512, 2) fwd_mega(Params p) {
  extern __shared__ __attribute__((aligned(16))) char sm[];
  uint4* xbw = (uint4*)(sm + 2 * SMEM_BYTES);
  cg::grid_group grid = cg::this_grid();
  if (p.coop == 2) grid.sync();
  if (__builtin_amdgcn_workitem_id_x() == 0) { xbw[0] = make_uint4(0u, 0u, 0u, 0u); xbw[1] = make_uint4(0u, 0u, 0u, 0u); }
  __syncthreads();
  XcdBarrier xb;
  if (p.coop) xb = xcd_barrier_post((unsigned*)(p.ws + WS_BAR), (volatile LAS unsigned*)xbw);
  for (int ph = p.phase_begin; ph < p.phase_end; ++ph) {
    if (ph > p.phase_begin && p.coop) xcd_barrier(xb);
    const int stepid = ph == 0 ? 12 : (ph == 25 ? 13 : (ph - 1) % 12);
    const int reps = (stepid == p.pad - 1) ? 2 : 1;
    for (int rep = 0; rep < reps; ++rep) {
      if (rep && p.coop) xcd_barrier(xb);
      run_phase(p, ph, sm, false);
    }
  }
}

extern "C" void kernel_launch(void* const* d_in, const int* in_sizes, int n_in, void* d_out, int out_size, void* d_ws,
                              size_t ws_size, hipStream_t stream) {
  static int grid_blocks = 0;
  if (!grid_blocks) {
    int dev = 0, cus = 0, per_cu = 0;
    (void)hipGetDevice(&dev);
    (void)hipDeviceGetAttribute(&cus, hipDeviceAttributeMultiprocessorCount, dev);
    (void)hipFuncSetAttribute((const void*)fwd_mega, hipFuncAttributeMaxDynamicSharedMemorySize, DYN_LDS);
    (void)hipOccupancyMaxActiveBlocksPerMultiprocessor(&per_cu, fwd_mega, 512, DYN_LDS);
    if (per_cu > 1) per_cu = 1;
    if (per_cu < 1) per_cu = 1;
    grid_blocks = cus * per_cu;
  }
  Params p{};
  const float** pp = (const float**)&p;
  for (int i = 0; i < 32; ++i) pp[i] = (const float*)d_in[i];
  p.out = (float*)d_out;
  p.ws = (char*)d_ws;
  if (ws_size < WS_END) { fprintf(stderr, "workspace too small: %zu < %zu\n", ws_size, (size_t)WS_END); return; }
  p.phase_begin = 0; p.phase_end = NPHASE; p.coop = 1; p.pad = PROBE_STEP + 1;
  (void)hipMemsetAsync((char*)d_ws + WS_BAR, 0, 16384, stream);
  void* args[] = {&p};
  hipError_t e = hipLaunchCooperativeKernel((void*)fwd_mega, dim3(grid_blocks), dim3(512), args, DYN_LDS, stream);
  if (e != hipSuccess) fprintf(stderr, "cooperative launch failed: %s (grid %d)\n", hipGetErrorString(e), grid_blocks);
}
```

```cpp
#include <hip/hip_runtime.h>
#include <hip/hip_bf16.h>
#include <hip/hip_cooperative_groups.h>
#include <cstdio>
namespace cg = cooperative_groups;

#ifndef MULTI
#define MULTI 0
#endif
#ifndef PROBE_STEP
#define PROBE_STEP -1
#endif

#define DI __device__ __forceinline__
typedef unsigned short u16;
using bf16x8 = __attribute__((ext_vector_type(8))) short;
using s16x4  = __attribute__((ext_vector_type(4))) short;
using f32x16 = __attribute__((ext_vector_type(16))) float;
using u32x4  = __attribute__((ext_vector_type(4))) unsigned;
using u32x2  = __attribute__((ext_vector_type(2))) unsigned;
#define MFMA(a, b, c) __builtin_amdgcn_mfma_f32_32x32x16_bf16((a), (b), (c), 0, 0, 0)

constexpr int NTOK = 6144, NCTX = 4096, DM = 1024, INW = 7456, DFF = 2816, DFF2 = 5632;
constexpr int ZA_Q = 0, ZA_K = 256, ZA_V = 384, ZC_Q = 512, ZC_K = 768, ZC_V = 1024, ZB_Q = 1280, ZB_I = 1536, ZB_FF = 1792,
              ZB_FB = 2048, ZB_G = 2304, ZD_Q = 2560, ZD_K = 2688, ZD_V = 2816, ZD_G = 3072, ZD_RF = 3328, Z_ML = 3360;
constexpr float EPSN = 1e-6f;
constexpr size_t O_CAK = 6291456, O_CAV = 7340032, O_CCK = 8388608, O_CCV = 10485760, O_SH = 12582912, O_SG = 13631488;
constexpr size_t WS_WIN = 0;
constexpr size_t WS_WBR = WS_WIN + (size_t)INW * 1024 * 2;
constexpr size_t WS_WOUT = WS_WBR + (size_t)4 * 1024 * 256 * 2;
constexpr size_t WS_WUP = WS_WOUT + (size_t)1024 * 1024 * 2;
constexpr size_t WS_WDN = WS_WUP + (size_t)DFF2 * 1024 * 2;
constexpr size_t WS_MOD = WS_WDN + (size_t)1024 * DFF * 2;
constexpr size_t WS_H = WS_MOD + (size_t)2 * 3 * 6144 * 4;
constexpr size_t WS_Z = WS_H + (size_t)NTOK * 1024 * 2;
constexpr size_t WS_QA = WS_Z + (size_t)NTOK * INW * 2;
constexpr size_t WS_QC = WS_QA + (size_t)NTOK * 256 * 2;
constexpr size_t WS_KA = WS_QC + (size_t)NTOK * 256 * 2;
constexpr size_t WS_VA = WS_KA + (size_t)7168 * 128 * 2;
constexpr size_t WS_KC = WS_VA + (size_t)7168 * 128 * 2;
constexpr size_t WS_VC = WS_KC + (size_t)7168 * 256 * 2;
constexpr size_t WS_YCAT = WS_VC + (size_t)7168 * 256 * 2;
constexpr size_t WS_ACT = WS_YCAT + (size_t)NTOK * 1024 * 2;
constexpr size_t WS_MIX = WS_ACT + (size_t)NTOK * DFF * 2;
constexpr size_t WS_CL = WS_MIX + (size_t)NTOK * 1024 * 2;
constexpr size_t WS_U = WS_ACT;
constexpr size_t WS_S = WS_CL + (size_t)2304 * 64 * 4;
constexpr size_t WS_BAR = WS_S + (size_t)2304 * 4096 * 4;
constexpr size_t WS_PA = WS_BAR + 16384;
constexpr size_t WS_PML = WS_PA + (size_t)3 * 2048 * 4 * 64 * 4;
constexpr size_t WS_END = WS_PML + (size_t)3 * 2048 * 8 * 2 * 2 * 4;
constexpr size_t WS_PC = WS_H;
static_assert((size_t)2304 * 4096 * 4 <= (size_t)NTOK * DFF * 2 + (size_t)NTOK * 1024 * 2, "U alias");
static_assert(WS_END <= (size_t)256 * 1024 * 1024, "ws budget");
constexpr size_t WS_PART = WS_Z;
constexpr int SMEM_BYTES = 73728;
constexpr int NPHASE = 26;

struct Params {
  const float *x_prompt, *x_sample, *cache_a_k, *cache_a_v, *cache_c_k, *cache_c_v, *state_hgrn, *state_gla, *c, *c_ctx,
      *w_ada, *b_ada, *norm1_g, *norm2_g, *w_in, *a_qn_g, *a_kn_g, *c_qn_g, *c_kn_g, *c_lambda, *c_subln_g, *b_lb_logits,
      *b_norm_g, *d_alpha_w, *d_alpha_b, *d_norm_g, *w_branch, *w_out, *w_up, *conv_w, *conv_b, *w_down;
  float* out;
  char* ws;
  int phase_begin, phase_end, coop, pad;
};

DI int tid_() { int t = __builtin_amdgcn_workitem_id_x() & 255; asm volatile("" : "+v"(t)); return t; }
DI void wave_sync_() { __builtin_amdgcn_fence(__ATOMIC_ACQ_REL, "wavefront"); __builtin_amdgcn_wave_barrier(); }
DI float bf2f(u16 u) { return __uint_as_float(((unsigned)u) << 16); }
DI u16 f2bf(float a) { __hip_bfloat16 b = __float2bfloat16(a); return *(u16*)&b; }
DI unsigned pack2(float a, float b) { __hip_bfloat162 q = __float22bfloat162_rn(make_float2(a, b)); return *(unsigned*)&q; }
DI float lo_bf(unsigned u) { return __uint_as_float(u << 16); }
DI float hi_bf(unsigned u) { return __uint_as_float(u & 0xffff0000u); }
DI float rcp_(float x) { return __builtin_amdgcn_rcpf(x); }
DI void st16_wt(void* ptr, u32x4 v) { asm volatile("global_store_dwordx4 %0, %1, off sc1\n\ts_nop 3" :: "v"(ptr), "v"(v) : "memory");     }
DI void st16_wt(void* ptr, float4 v) { u32x4 q; q[0] = __float_as_uint(v.x); q[1] = __float_as_uint(v.y); q[2] = __float_as_uint(v.z); q[3] = __float_as_uint(v.w); st16_wt(ptr, q); }
DI float sigmoidf_(float x) { return rcp_(1.f + __expf(-x)); }
DI int crow(int e, int h) { return (e & 3) + 8 * (e >> 2) + 4 * h; }
DI bf16x8 pack8(const f32x16& x, int s) {
  u32x4 q;
  q[0] = pack2(x[8 * s + 0], x[8 * s + 1]); q[1] = pack2(x[8 * s + 2], x[8 * s + 3]);
  q[2] = pack2(x[8 * s + 4], x[8 * s + 5]); q[3] = pack2(x[8 * s + 6], x[8 * s + 7]);
  return __builtin_bit_cast(bf16x8, q);
}
DI s16x4 trread(const u16* pl) {
  return __builtin_amdgcn_ds_read_tr16_b64_v4i16((__attribute__((address_space(3))) s16x4*)pl);
}
DI bf16x8 trpair(const u16* p0, const u16* p1) {
  s16x4 a = trread(p0), b = trread(p1);
  return __builtin_shufflevector(a, b, 0, 1, 2, 3, 4, 5, 6, 7);
}
DI float wave_sum(float v) {
#pragma unroll
  for (int o = 32; o >= 1; o >>= 1) v += __shfl_xor(v, o);
  return v;
}
DI int tok_cond(int t) { return t < NCTX ? 0 : 1 + ((t - NCTX) >> 10); }
DI const float* xin_row(const Params& p, int l, int tok) {
  if (l > 0) return p.out + (size_t)tok * DM;
  return tok < NCTX ? p.x_prompt + (size_t)tok * DM : p.x_sample + (size_t)(tok - NCTX) * DM;
}


constexpr int SMEM_BYTES_ = 73728;
DI void vb_sync() {
  extern __shared__ __attribute__((aligned(16))) char vb_dyn_[];
  const int half = __builtin_amdgcn_readfirstlane(__builtin_amdgcn_workitem_id_x() >> 8);
  unsigned* ctr = (unsigned*)(vb_dyn_ + 2 * SMEM_BYTES_ + 16) + half;
  asm volatile("s_waitcnt lgkmcnt(0)" ::: "memory");
  if ((__builtin_amdgcn_workitem_id_x() & 63) == 0) {
    const unsigned old = __hip_atomic_fetch_add(ctr, 1u, __ATOMIC_RELAXED, __HIP_MEMORY_SCOPE_WORKGROUP);
    const unsigned target = (old & ~3u) + 4u;
    unsigned spins = 0;
    while ((int)(__hip_atomic_load(ctr, __ATOMIC_RELAXED, __HIP_MEMORY_SCOPE_WORKGROUP) - target) < 0) {
      __builtin_amdgcn_s_sleep(1);
      if (++spins > (1u << 22)) break;
    }
  }
  asm volatile("" ::: "memory");
}

#define XB_TMO      128
#define XB_XCNT(j)  (256  + 64 * (j))
#define XB_XSUB(j)  (1280 + 64 * (j))
#define XB_XGEN(j)  (2304 + 64 * (j))
#define XB_TOP      3328
#define XB_TOPGEN   3392
#define XCD_BAR_WORDS 3456
#define XB_SPIN_CAP (1u << 22)
#define LAS __attribute__((address_space(3)))
DI unsigned xb_ld(unsigned* p) { return __hip_atomic_load(p, __ATOMIC_RELAXED, __HIP_MEMORY_SCOPE_AGENT); }
DI unsigned xb_add(unsigned* p, unsigned v) { return __hip_atomic_fetch_add(p, v, __ATOMIC_RELAXED, __HIP_MEMORY_SCOPE_AGENT); }
DI unsigned xb_xcc_id() { return (unsigned)__builtin_amdgcn_s_getreg((3 << 11) | 20) & 0xFu; }
#define XB_SPIN(cond, bar) do { unsigned _sp = 0; while (cond) { __builtin_amdgcn_s_sleep(1); \
    if ((++_sp & 255u) == 0u) { if (xb_ld(&(bar)[XB_TMO])) break; if (_sp > XB_SPIN_CAP) { atomicAdd(&(bar)[XB_TMO], 1u); break; } } } } while (0)
struct XcdBarrier { unsigned* bar; unsigned x; volatile LAS unsigned* st; };
DI XcdBarrier xcd_barrier_post(unsigned* bar, volatile LAS unsigned* st) {
  XcdBarrier b; b.bar = bar; b.x = xb_xcc_id(); b.st = st;
  if (__builtin_amdgcn_workitem_id_x() == 0) (void)xb_add(&bar[XB_XCNT(b.x)], 1u);
  return b;
}
DI void xcd_barrier_complete(unsigned* bar, unsigned x, unsigned& nloc, unsigned& nx) {
  const unsigned G = gridDim.x * gridDim.y * gridDim.z;
  unsigned sum, cnt, mine, sp = 0u;
  for (;;) {
    sum = 0u; cnt = 0u; mine = 0u;
#pragma unroll
    for (unsigned j = 0; j < 16; ++j) { const unsigned c = xb_ld(&bar[XB_XCNT(j)]); sum += c; cnt += (c > 0u) ? 1u : 0u; mine = (j == x) ? c : mine; }
    if (sum == G) break;
    __builtin_amdgcn_s_sleep(1);
    if ((++sp & 255u) == 0u) { if (xb_ld(&bar[XB_TMO])) break; if (sp > XB_SPIN_CAP) { atomicAdd(&bar[XB_TMO], 1u); break; } }
  }
  nloc = mine > 0u ? mine : 1u; nx = cnt > 0u ? cnt : 1u;
}
DI void xcd_barrier(const XcdBarrier& b) {
  asm volatile("s_waitcnt vmcnt(0)" ::: "memory");
  __syncthreads();
  if (__builtin_amdgcn_workitem_id_x() == 0) {
    unsigned* bar = b.bar;
    __builtin_amdgcn_s_waitcnt(0);
    unsigned nloc = b.st[0], nx = b.st[1];
    if (nloc == 0u) { xcd_barrier_complete(bar, b.x, nloc, nx); b.st[0] = nloc; b.st[1] = nx; }
    const unsigned old = xb_add(&bar[XB_XSUB(b.x)], 1u);
    const unsigned gen = old / nloc;
    if (old + 1u == (gen + 1u) * nloc) {
      __builtin_amdgcn_fence(__ATOMIC_RELEASE, "agent");
      asm volatile("s_waitcnt vmcnt(0)" ::: "memory");
      const unsigned og = xb_add(&bar[XB_TOP], 1u);
      const unsigned tg = og / nx;
      if (og + 1u == (tg + 1u) * nx) xb_add(&bar[XB_TOPGEN], 1u);
      else XB_SPIN(xb_ld(&bar[XB_TOPGEN]) == tg, bar);
      __builtin_amdgcn_fence(__ATOMIC_ACQUIRE, "agent");
      xb_add(&bar[XB_XGEN(b.x)], 1u);
      asm volatile("s_waitcnt vmcnt(0)" ::: "memory");
    } else {
      XB_SPIN(xb_ld(&bar[XB_XGEN(b.x)]) == gen, bar);
      __builtin_amdgcn_fence(__ATOMIC_ACQUIRE, "agent");
      asm volatile("s_waitcnt vmcnt(0)" ::: "memory");
    }
  }
  __syncthreads();
}

DI void convw_tile(const float* __restrict__ src, u16* __restrict__ dst, int K, int N, int item, float* T) {
  const int t = tid_();
  const int ntn = (N + 63) >> 6;
  const int n0 = (item % ntn) * 64, k0 = (item / ntn) * 64;
  {
    const int n4 = (t & 15) * 4;
    float4 v[4];
#pragma unroll
    for (int i = 0; i < 4; ++i) {
      const int kl = (t >> 4) + 16 * i;
      v[i] = (n0 + n4 < N) ? *(const float4*)(src + (size_t)(k0 + kl) * N + n0 + n4) : make_float4(0.f, 0.f, 0.f, 0.f);
    }
#pragma unroll
    for (int i = 0; i < 4; ++i) {
      const int kl = (t >> 4) + 16 * i;
      T[(n4 + 0) * 65 + kl] = v[i].x; T[(n4 + 1) * 65 + kl] = v[i].y;
      T[(n4 + 2) * 65 + kl] = v[i].z; T[(n4 + 3) * 65 + kl] = v[i].w;
    }
  }
  vb_sync();
  {
    const int n = t >> 2, k16 = (t & 3) * 16;
    const float* tr = T + n * 65 + k16;
    u32x4 q0, q1;
    q0[0] = pack2(tr[0], tr[1]); q0[1] = pack2(tr[2], tr[3]); q0[2] = pack2(tr[4], tr[5]); q0[3] = pack2(tr[6], tr[7]);
    q1[0] = pack2(tr[8], tr[9]); q1[1] = pack2(tr[10], tr[11]); q1[2] = pack2(tr[12], tr[13]); q1[3] = pack2(tr[14], tr[15]);
    if (n0 + n < N) {
      u16* dp = dst + (size_t)(n0 + n) * K + k0 + k16;
      *(u32x4*)dp = q0; *(u32x4*)(dp + 8) = q1;
    }
  }
  vb_sync();
}
constexpr int CONVW_ITEMS = 1872 + 256 + 256 + 1408 + 704;
DI void convw_item(const Params& p, int l, int item, char* sm) {
  float* T = (float*)sm;
  char* ws = p.ws;
  if (item < 1872) convw_tile(p.w_in + (size_t)l * 1024 * INW, (u16*)(ws + WS_WIN), 1024, INW, item, T);
  else if (item < 2128) convw_tile(p.w_branch + (size_t)l * 1024 * 1024, (u16*)(ws + WS_WBR), 1024, 1024, item - 1872, T);
  else if (item < 2384) convw_tile(p.w_out + (size_t)l * 1024 * 1024, (u16*)(ws + WS_WOUT), 1024, 1024, item - 2128, T);
  else if (item < 3792) convw_tile(p.w_up + (size_t)l * 1024 * DFF2, (u16*)(ws + WS_WUP), 1024, DFF2, item - 2384, T);
  else convw_tile(p.w_down + (size_t)l * DFF * 1024, (u16*)(ws + WS_WDN), DFF, 1024, item - 3792, T);
}

constexpr int MOD_ITEMS = 384;
DI void mod_item(const Params& p, int item, char* sm) {
  float* sc = (float*)sm;
  float* red = sc + 3072;
  const int t = tid_();
  const int l = item / 192, j0 = (item % 192) * 32;
  for (int i = t; i < 3072; i += 256) {
    const int cnd = i >> 10, k = i & 1023;
    const float v = cnd == 0 ? p.c_ctx[k] : p.c[(cnd - 1) * 1024 + k];
    sc[i] = v * sigmoidf_(v);
  }
  vb_sync();
  const int cq = t & 7, ks = t >> 3;
  float a0[4] = {0, 0, 0, 0}, a1[4] = {0, 0, 0, 0}, a2[4] = {0, 0, 0, 0};
  const float* wp = p.w_ada + (size_t)l * 1024 * 6144 + j0 + 4 * cq;
#pragma unroll 8
  for (int rr = 0; rr < 32; ++rr) {
    const int row = ks * 32 + rr;
    const float4 w4 = *(const float4*)(wp + (size_t)row * 6144);
    const float s0 = sc[row], s1 = sc[1024 + row], s2 = sc[2048 + row];
    a0[0] += s0 * w4.x; a0[1] += s0 * w4.y; a0[2] += s0 * w4.z; a0[3] += s0 * w4.w;
    a1[0] += s1 * w4.x; a1[1] += s1 * w4.y; a1[2] += s1 * w4.z; a1[3] += s1 * w4.w;
    a2[0] += s2 * w4.x; a2[1] += s2 * w4.y; a2[2] += s2 * w4.z; a2[3] += s2 * w4.w;
  }
#pragma unroll
  for (int q = 0; q < 4; ++q) {
    red[(ks * 3 + 0) * 32 + 4 * cq + q] = a0[q];
    red[(ks * 3 + 1) * 32 + 4 * cq + q] = a1[q];
    red[(ks * 3 + 2) * 32 + 4 * cq + q] = a2[q];
  }
  vb_sync();
  if (t < 96) {
    const int cnd = t >> 5, col = t & 31;
    float sacc = p.b_ada[l * 6144 + j0 + col];
    for (int k = 0; k < 32; ++k) sacc += red[(k * 3 + cnd) * 32 + col];
    ((float*)(p.ws + WS_MOD))[(l * 3 + cnd) * 6144 + j0 + col] = sacc;
  }
  vb_sync();
}

DI void norm_tok(const Params& p, int l, int which, int tok) {
  const int lane = tid_() & 63;
  const float* xr = which == 0 ? xin_row(p, l, tok) : p.out + (size_t)tok * DM;
  const float* g = (which == 0 ? p.norm1_g : p.norm2_g) + l * 1024;
  const float* mod = (const float*)(p.ws + WS_MOD) + (l * 3 + tok_cond(tok)) * 6144 + which * 3072;
  float4 v[4];
  float ss = 0.f;
  const bool fold = (which == 1) || (l > 0);
  const int gidx = which == 1 ? (l * 3 + tok_cond(tok)) * 6144 + 2048 : ((l - 1) * 3 + tok_cond(tok)) * 6144 + 5120;
#pragma unroll
  for (int i = 0; i < 4; ++i) {
    v[i] = *(const float4*)(xr + 4 * lane + 256 * i);
    if (fold) {
      const size_t o = (size_t)tok * DM + 4 * lane + 256 * i;
      const u16* P = (const u16*)(p.ws + WS_PART);
      const u32x2 pa = *(const u32x2*)(P + o), pb = *(const u32x2*)(P + (size_t)NTOK * DM + o);
      const float4 a = make_float4(lo_bf(pa[0]), hi_bf(pa[0]), lo_bf(pa[1]), hi_bf(pa[1])), b = make_float4(lo_bf(pb[0]), hi_bf(pb[0]), lo_bf(pb[1]), hi_bf(pb[1]));
      const float4 g2 = *(const float4*)((const float*)(p.ws + WS_MOD) + gidx + 4 * lane + 256 * i);
      v[i].x += g2.x * (a.x + b.x); v[i].y += g2.y * (a.y + b.y); v[i].z += g2.z * (a.z + b.z); v[i].w += g2.w * (a.w + b.w);
      st16_wt(p.out + o, v[i]);
    }
    ss += v[i].x * v[i].x + v[i].y * v[i].y + v[i].z * v[i].z + v[i].w * v[i].w;
  }
  ss = wave_sum(ss);
  const float rstd = rsqrtf(ss * (1.f / 1024.f) + EPSN);
  if (which == 0 && l == 0) {
#pragma unroll
    for (int i = 0; i < 4; ++i) st16_wt(p.out + (size_t)tok * DM + 4 * lane + 256 * i, v[i]);
  }
  u16* hr = (u16*)(p.ws + WS_H) + (size_t)tok * DM;
#pragma unroll
  for (int i = 0; i < 4; ++i) {
    const int c0 = 4 * lane + 256 * i;
    const float4 gg = *(const float4*)(g + c0);
    const float4 sh = *(const float4*)(mod + c0);
    const float4 scv = *(const float4*)(mod + 1024 + c0);
    u32x2 q;
    q[0] = pack2(v[i].x * rstd * gg.x * (1.f + scv.x) + sh.x, v[i].y * rstd * gg.y * (1.f + scv.y) + sh.y);
    q[1] = pack2(v[i].z * rstd * gg.z * (1.f + scv.z) + sh.z, v[i].w * rstd * gg.w * (1.f + scv.w) + sh.w);
    *(u32x2*)(hr + c0) = q;
  }
}

template <int NJ, bool GATED>
DI void gemm_core(const u16* __restrict__ A, int lda, const u16* __restrict__ Bt, int ldb, int K, int m0, int n0, int N,
                  f32x16 (&acc)[2][NJ], u16* sm, const u16* __restrict__ gz = nullptr, f32x16 (*tot)[NJ] = nullptr) {
  const int t = tid_(), lane = t & 63, w = t >> 6, r = lane & 31, h = lane >> 5;
  const int wm = w & 1, wn = w >> 1;
  u16* As = sm;
  u16* Bs = sm + 2 * 128 * 72;
  const int lrow = t >> 3, lc8 = (t & 7) * 8;
  int aoff[4], boff[2 * NJ];
#pragma unroll
  for (int i = 0; i < 4; ++i) aoff[i] = (m0 + lrow + 32 * i) * lda + lc8;
#pragma unroll
  for (int i = 0; i < 2 * NJ; ++i) {
    int bn = n0 + lrow + 32 * i;
    bn = bn < N ? bn : N - 1;
    boff[i] = bn * ldb + lc8;
  }
  u32x4 ra[2][4], rb[2][2 * NJ];
  const int KT = K >> 6;
  auto gload = [&](int set, int kt) {
    const int k0 = kt * 64;
#pragma unroll
    for (int i = 0; i < 4; ++i) ra[set][i] = *(const u32x4*)(A + aoff[i] + k0);
#pragma unroll
    for (int i = 0; i < 2 * NJ; ++i) rb[set][i] = *(const u32x4*)(Bt + boff[i] + k0);
  };
  auto sstore = [&](int set, int buf) {
    const int nb = buf * 128 * 72;
#pragma unroll
    for (int i = 0; i < 4; ++i) *(u32x4*)(As + nb + (lrow + 32 * i) * 72 + lc8) = ra[set][i];
#pragma unroll
    for (int i = 0; i < 2 * NJ; ++i) *(u32x4*)(Bs + nb + (lrow + 32 * i) * 72 + lc8) = rb[set][i];
  };
  auto compute = [&](int buf) {
    const u16* as = As + buf * 128 * 72 + (wm * 64 + r) * 72 + 8 * h;
    const u16* bs = Bs + buf * 128 * 72 + (wn * 32 * NJ + r) * 72 + 8 * h;
    __builtin_amdgcn_s_setprio(1);
#pragma unroll
    for (int ks = 0; ks < 4; ++ks) {
      const bf16x8 a0 = *(const bf16x8*)(as + ks * 16), a1 = *(const bf16x8*)(as + 32 * 72 + ks * 16);
#pragma unroll
      for (int j = 0; j < NJ; ++j) {
        const bf16x8 b0 = *(const bf16x8*)(bs + j * 32 * 72 + ks * 16);
        acc[0][j] = MFMA(a0, b0, acc[0][j]);
        acc[1][j] = MFMA(a1, b0, acc[1][j]);
      }
    }
    __builtin_amdgcn_s_setprio(0);
  };
  gload(0, 0);
  gload(1, 1);
  sstore(0, 0);
  vb_sync();
  for (int kt = 0; kt < KT; kt += 2) {
    if (kt + 2 < KT) gload(0, kt + 2);
    compute(0);
    sstore(1, 1);
    vb_sync();
    if (kt + 3 < KT) gload(1, kt + 3);
    u16 graw[GATED ? 32 * NJ : 1];
    if (GATED && (kt & 3) == 2) {
      const int n = kt >> 2;
#pragma unroll
      for (int i = 0; i < 2; ++i)
#pragma unroll
        for (int j = 0; j < NJ; ++j)
#pragma unroll
          for (int e = 0; e < 16; ++e)
            graw[(i * NJ + j) * 16 + e] = gz[(size_t)(m0 + wm * 64 + i * 32 + crow(e, h)) * INW + n * 1024 + n0 + wn * 32 * NJ + j * 32 + r];
    }
    compute(1);
    if (kt + 2 < KT) sstore(0, 0);
    vb_sync();
    if (GATED && (kt & 3) == 2) {
#pragma unroll
      for (int i = 0; i < 2; ++i)
#pragma unroll
        for (int j = 0; j < NJ; ++j)
#pragma unroll
          for (int e = 0; e < 16; ++e) {
            tot[i][j][e] += sigmoidf_(bf2f(graw[(i * NJ + j) * 16 + e])) * acc[i][j][e];
            acc[i][j][e] = 0.f;
          }
    }
  }
}
template <int NJ>
DI void zero_acc(f32x16 (&acc)[2][NJ]) {
#pragma unroll
  for (int i = 0; i < 2; ++i)
#pragma unroll
    for (int j = 0; j < NJ; ++j)
#pragma unroll
      for (int e = 0; e < 16; ++e) acc[i][j][e] = 0.f;
}
#define EPI_LOOP_N(NJ_, body)                                                       \
  {                                                                                 \
    const int lane_ = tid_() & 63, w_ = tid_() >> 6, r_ = lane_ & 31, h_ = lane_ >> 5; \
    _Pragma("unroll") for (int i_ = 0; i_ < 2; ++i_)                                 \
    _Pragma("unroll") for (int j_ = 0; j_ < NJ_; ++j_)                               \
    _Pragma("unroll") for (int e_ = 0; e_ < 16; ++e_) {                              \
      const int row = m0 + (w_ & 1) * 64 + i_ * 32 + crow(e_, h_);                  \
      const int col = n0 + (w_ >> 1) * 32 * NJ_ + j_ * 32 + r_;                     \
      body                                                                          \
    }                                                                               \
  }
#define EPI_LOOP(body) EPI_LOOP_N(2, body)

DI void gemm_in_item(const Params& p, int item, char* sm) {
  const int m0 = (item % 48) * 128, n0 = (item / 48) * 128;
  f32x16 acc[2][2];
  zero_acc<2>(acc);
  gemm_core<2, false>((const u16*)(p.ws + WS_H), 1024, (const u16*)(p.ws + WS_WIN), 1024, 1024, m0, n0, INW, acc, (u16*)sm);
  u16* z = (u16*)(p.ws + WS_Z);
  EPI_LOOP(if (col < INW) z[(size_t)row * INW + col] = f2bf(acc[i_][j_][e_]);)
}
DI void gemm_branch_item(const Params& p, int item, char* sm) {
  const int m0 = (item % 48) * 128, n0 = (item / 48) * 64;
  f32x16 tot[2][1], acc[2][1];
  zero_acc<1>(tot);
  zero_acc<1>(acc);
  gemm_core<1, true>((const u16*)(p.ws + WS_YCAT), 1024, (const u16*)(p.ws + WS_WBR), 1024, 1024, m0, n0, 1024, acc, (u16*)sm,
                     (const u16*)(p.ws + WS_Z) + Z_ML, tot);
  u16* mix = (u16*)(p.ws + WS_MIX);
  EPI_LOOP_N(1, mix[(size_t)row * 1024 + col] = f2bf(tot[i_][j_][e_]);)
}
DI void gemm_out_item(const Params& p, int l, int item, char* sm, bool dry) {
  const int m0 = (item % 48) * 128, n0 = (item / 48) * 128;
  f32x16 acc[2][2];
  zero_acc<2>(acc);
  gemm_core<2, false>((const u16*)(p.ws + WS_MIX), 1024, (const u16*)(p.ws + WS_WOUT), 1024, 1024, m0, n0, 1024, acc, (u16*)sm);
  const float* g1 = (const float*)(p.ws + WS_MOD) + (l * 3 + tok_cond(m0)) * 6144 + 2048;
  EPI_LOOP(const float xo = xin_row(p, l, row)[col]; const float xn = xo + g1[col] * acc[i_][j_][e_]; if (!dry) p.out[(size_t)row * DM + col] = xn;)
}
DI void gemm_up_item(const Params& p, int item, char* sm) {
  const int m0 = (item % 48) * 128, n0 = (item / 48) * 128;
  f32x16 acc[2][2];
  zero_acc<2>(acc);
  gemm_core<2, false>((const u16*)(p.ws + WS_H), 1024, (const u16*)(p.ws + WS_WUP), 1024, 1024, m0, n0, DFF2, acc, (u16*)sm);
  u16* u = (u16*)(p.ws + WS_Z);
  EPI_LOOP(u[(size_t)row * DFF2 + col] = f2bf(acc[i_][j_][e_]);)
}
DI void gemm_down_item(const Params& p, int l, int item, char* sm, bool dry) {
  const int m0 = (item % 48) * 128, n0 = (item / 48) * 128;
  f32x16 acc[2][2];
  zero_acc<2>(acc);
  gemm_core<2, false>((const u16*)(p.ws + WS_ACT), DFF, (const u16*)(p.ws + WS_WDN), DFF, DFF, m0, n0, 1024, acc, (u16*)sm);
  const float* g2 = (const float*)(p.ws + WS_MOD) + (l * 3 + tok_cond(m0)) * 6144 + 5120;
  EPI_LOOP(float* xp = p.out + (size_t)row * DM + col; const float xn = *xp + g2[col] * acc[i_][j_][e_]; if (!dry) *xp = xn;)
}

namespace pg8 {
#define PG8_LAS __attribute__((address_space(3)))
typedef unsigned short bf16_t;
typedef short bf16x8 __attribute__((ext_vector_type(8)));
typedef float f32x4 __attribute__((ext_vector_type(4)));
typedef unsigned u32x4 __attribute__((ext_vector_type(4)));
constexpr int BM = 256, BK = 64, HALF = 128, HTB = HALF * BK * 2  , STAGE_BYTES = 8 * HTB, NXCD = 8, WGM = 8;

__host__ __device__ __forceinline__ int lds_byte(int r, int c) { const int st = (r >> 4) * 2 + (c >> 5), rr = r & 15, cc = c & 31, ob = rr * 64 + cc * 2; return st * 1024 + (ob ^ (((ob >> 9) & 1) << 5)); }
__host__ __device__ __forceinline__ void stage_rc(int b, int& R, int& C) { const int st = b / 1024, sb = b % 1024, swz = sb ^ (((sb >> 9) & 1) << 5); R = (st >> 1) * 16 + swz / 64; C = (st & 1) * 32 + (swz % 64) / 2; }
__host__ __device__ __forceinline__ int perm32(int rho) { const int n = rho >> 4, i = rho & 15; return 8 * (i >> 2) + 4 * n + (i & 3); }

struct Unit { int pm, pn, kh; };
struct Gemm { const bf16_t* A; const bf16_t* Bt; int M, N, K; int ldk; size_t kpart; };

struct StaticOrder {
    int nM, nN, nwg, G, c;
    __host__ __device__ void init(int M, int N, int G_, int c_) { nM = M / BM; nN = N / BM; nwg = nM * nN; G = G_; c = c_; }
    __host__ __device__ bool next(int i, Unit& u) const {
        const long L = (long)i * G + c; if (L >= nwg) return false;
        int wgid = (int)L; { const int q = nwg / NXCD, r = nwg % NXCD, xcd = wgid % NXCD, off = wgid / NXCD; wgid = (xcd < r ? xcd * (q + 1) : r * (q + 1) + (xcd - r) * q) + off; }
        const int nig = WGM * nN, gid = wgid / nig, fm = gid * WGM, gsz = (nM - fm) < WGM ? (nM - fm) : WGM;
        u.pm = fm + ((wgid % nig) % gsz); u.pn = (wgid % nig) / gsz; u.kh = 0; return true;
    }
    __device__ __forceinline__ void a_ready(const Unit&) const {}
    __device__ __forceinline__ void done(const Unit&) const {}
};
struct CountedOrder : StaticOrder {
    const unsigned* ready; unsigned need; unsigned* tmo;
    __device__ __forceinline__ void a_ready(const Unit& u) const {
        if (threadIdx.x < 64) {
            const unsigned long long t0 = __builtin_amdgcn_s_memrealtime(); unsigned polls = 0;
            while ((unsigned)__builtin_amdgcn_readfirstlane(__hip_atomic_load(ready + 64 * u.pm, __ATOMIC_RELAXED, __HIP_MEMORY_SCOPE_AGENT)) < need) {
                if ((++polls & 255u) == 0u && __builtin_amdgcn_readfirstlane(__hip_atomic_load(tmo, __ATOMIC_RELAXED, __HIP_MEMORY_SCOPE_AGENT)) != 0u) break;
                if (__builtin_amdgcn_s_memrealtime() - t0 > 2000000ull) {
                    if (threadIdx.x == 0) { unsigned expect = 0u; __hip_atomic_compare_exchange_strong(tmo + 1, &expect, 0x600u | (unsigned)(u.pm & 0xff), __ATOMIC_RELAXED, __ATOMIC_RELAXED, __HIP_MEMORY_SCOPE_AGENT); __hip_atomic_store(tmo, 1u, __ATOMIC_RELAXED, __HIP_MEMORY_SCOPE_AGENT); }
                    break; }
                __builtin_amdgcn_s_sleep(2); }
            __builtin_amdgcn_fence(__ATOMIC_ACQUIRE, "agent");
            asm volatile("s_waitcnt vmcnt(0)" ::: "memory");
        }
#if !defined(BROKEN_HOOK_NO_BARRIER)
        asm volatile("" ::: "memory"); __builtin_amdgcn_s_barrier(); asm volatile("" ::: "memory");
#endif
    }
};

__device__ __forceinline__ unsigned cvt_pk_bf16(float lo, float hi) { unsigned r; asm volatile("v_cvt_pk_bf16_f32 %0, %1, %2" : "=v"(r) : "v"(lo), "v"(hi)); return r; }
template <class Epi, class Sched, bool STAMP = false>
__device__ __forceinline__ void gemm_phase(PG8_LAS unsigned char* lds, const Gemm g, const Sched& S, const Epi& E, unsigned long long* stamps) {
    int tid_raw = threadIdx.x; asm volatile("" : "+v"(tid_raw));
    const int tid = tid_raw, wid = __builtin_amdgcn_readfirstlane(tid >> 6), lane = tid & 63, wr = wid >> 2, wc = wid & 3, fr = lane & 15, fq = lane >> 4;
    const int K = g.K, nt = K / BK;
    int ts_lo = 0, ts_hi = 0, nts = 0; const unsigned long long rt_entry = STAMP ? (unsigned long long)wall_clock64() : 0ull;
#define PG8_STAMP() do { if (STAMP && wid == 0 && nts < 64) { const unsigned long long _c = (unsigned long long)clock64(); \
        ts_lo = (lane == nts) ? (int)(unsigned)_c : ts_lo; ts_hi = (lane == nts) ? (int)(unsigned)(_c >> 32) : ts_hi; ++nts; } } while (0)
    PG8_STAMP();
    unsigned voffA[2], voffB[2];
#pragma unroll
    for (int i = 0; i < 2; ++i) { int R, C; stage_rc(tid * 16 + i * 8192, R, C); const int Rb = Epi::PERM ? ((R & ~31) + perm32(R & 31)) : R;
        voffA[i] = (unsigned)(R * g.ldk + C) * 2u; voffB[i] = (unsigned)(Rb * g.ldk + C) * 2u; }
    const size_t kstep = (size_t)(BK * 2);
    const size_t hstep = (size_t)HALF * g.ldk * 2;
    const size_t tstep = 2 * hstep;
    const unsigned ldsw = (unsigned)wid * 1024u;
    const int aoff = lds_byte(wr * 64 + fr, fq * 8), boff = lds_byte(wc * 32 + fr, fq * 8);
#define PG8_SA(b, h) (((b) * 2 + (h)) * HTB)
#define PG8_SB(b, h) ((4 + (b) * 2 + (h)) * HTB)
#define PG8_STAGE(bufoff, gbase, voff) do { _Pragma("unroll") for (int _i = 0; _i < 2; ++_i) \
        __builtin_amdgcn_global_load_lds((const unsigned*)((const char*)(gbase) + (voff)[_i]), (PG8_LAS unsigned*)(lds + (bufoff) + ldsw + _i * 8192), 16, 0, 0); } while (0)
#define PG8_LDA(dst, b, h) do { _Pragma("unroll") for (int m = 0; m < 4; ++m) _Pragma("unroll") for (int k = 0; k < 2; ++k) dst[m][k] = *(const PG8_LAS bf16x8*)(lds + PG8_SA(b, h) + aoff + m * 2048 + k * 1024); } while (0)
#define PG8_LDB(dst, b, h) do { _Pragma("unroll") for (int n = 0; n < 2; ++n) _Pragma("unroll") for (int k = 0; k < 2; ++k) dst[n][k] = *(const PG8_LAS bf16x8*)(lds + PG8_SB(b, h) + boff + n * 2048 + k * 1024); } while (0)
#define PG8_MMA(ai, bj, At, Bt) do { __builtin_amdgcn_s_setprio(1); _Pragma("unroll") for (int m = 0; m < 4; ++m) _Pragma("unroll") for (int n = 0; n < 2; ++n) _Pragma("unroll") for (int k = 0; k < 2; ++k) \
        acc[ai][bj][m][n] = __builtin_amdgcn_mfma_f32_16x16x32_bf16(Bt[n][k], At[m][k], acc[ai][bj][m][n], 0, 0, 0); __builtin_amdgcn_s_setprio(0); } while (0)
#define PG8_WAIT_V(n) asm volatile("s_waitcnt vmcnt(" #n ")" ::: "memory")
#define PG8_WAIT_L(n) asm volatile("s_waitcnt lgkmcnt(" #n ")" ::: "memory")
#define PG8_BAR __builtin_amdgcn_s_barrier()
#define PG8_SCHED __builtin_amdgcn_sched_barrier(0)
    Unit cur, nxt; int ui = 0;
    if (!S.next(0, cur)) return;
    f32x4 acc[2][2][4][2];
#pragma unroll
    for (int a = 0; a < 2; ++a)
#pragma unroll
        for (int b = 0; b < 2; ++b)
#pragma unroll
            for (int m = 0; m < 4; ++m)
#pragma unroll
                for (int n = 0; n < 2; ++n) acc[a][b][m][n] = (f32x4){0.f, 0.f, 0.f, 0.f};
    bf16x8 At[4][2], B0[2][2], B1[2][2];
    const char* cA = (const char*)g.A + (size_t)cur.pm * tstep + cur.kh * g.kpart; const char* cB = (const char*)g.Bt + (size_t)cur.pn * tstep + cur.kh * g.kpart;
    S.a_ready(cur);
    PG8_STAGE(PG8_SB(0, 0), cB, voffB); PG8_STAGE(PG8_SA(0, 0), cA, voffA); PG8_STAGE(PG8_SB(0, 1), cB + hstep, voffB); PG8_STAGE(PG8_SA(0, 1), cA + hstep, voffA);
    if (wr == 1) PG8_BAR;
    PG8_WAIT_V(4); PG8_BAR;
    PG8_STAGE(PG8_SB(1, 0), cB + kstep, voffB); PG8_STAGE(PG8_SA(1, 0), cA + kstep, voffA); PG8_STAGE(PG8_SB(1, 1), cB + hstep + kstep, voffB);
    PG8_WAIT_V(6); PG8_BAR;
    PG8_STAMP();
    for (;;) {
        const bool has_next = S.next(ui + 1, nxt);
        const char* nA = has_next ? (const char*)g.A + (size_t)nxt.pm * tstep + nxt.kh * g.kpart : cA; const char* nB = has_next ? (const char*)g.Bt + (size_t)nxt.pn * tstep + nxt.kh * g.kpart : cB;
        for (int t = 0; t < nt; t += 2) {
            const bool last = (t == nt - 2);
            const char* a1 = cA + (size_t)(t + 1) * kstep;
            const char* a2 = last ? nA : cA + (size_t)(t + 2) * kstep; const char* b2 = last ? nB : cB + (size_t)(t + 2) * kstep;
            const char* a3 = a2 + kstep; const char* b3 = b2 + kstep;
            if (last && has_next) S.a_ready(nxt);
            PG8_LDB(B0, 0, 0); PG8_SCHED; PG8_LDA(At, 0, 0); PG8_STAGE(PG8_SA(1, 1), a1 + hstep, voffA);
            PG8_WAIT_L(8); PG8_BAR; PG8_WAIT_L(0); PG8_MMA(0, 0, At, B0); PG8_BAR; PG8_SCHED;
            PG8_LDB(B1, 0, 1); PG8_STAGE(PG8_SB(0, 0), b2, voffB);
            PG8_BAR; PG8_WAIT_L(0); PG8_MMA(0, 1, At, B1); PG8_BAR;
            PG8_LDA(At, 0, 1); PG8_STAGE(PG8_SA(0, 0), a2, voffA);
            PG8_BAR; PG8_WAIT_L(0); PG8_MMA(1, 0, At, B0); PG8_BAR; PG8_SCHED;
            PG8_STAGE(PG8_SB(0, 1), b2 + hstep, voffB);
            PG8_WAIT_V(6); PG8_BAR; PG8_MMA(1, 1, At, B1); PG8_BAR;
            PG8_LDB(B0, 1, 0); PG8_SCHED; PG8_LDA(At, 1, 0); PG8_STAGE(PG8_SA(0, 1), a2 + hstep, voffA);
            PG8_WAIT_L(8); PG8_BAR; PG8_WAIT_L(0); PG8_MMA(0, 0, At, B0); PG8_BAR; PG8_SCHED;
            PG8_LDB(B1, 1, 1); PG8_STAGE(PG8_SB(1, 0), b3, voffB);
            PG8_BAR; PG8_WAIT_L(0); PG8_MMA(0, 1, At, B1); PG8_BAR;
            PG8_LDA(At, 1, 1); PG8_STAGE(PG8_SA(1, 0), a3, voffA);
            PG8_BAR; PG8_WAIT_L(0); PG8_MMA(1, 0, At, B0); PG8_BAR; PG8_SCHED;
            PG8_STAGE(PG8_SB(1, 1), b3 + hstep, voffB);
            PG8_WAIT_V(6); PG8_BAR; PG8_MMA(1, 1, At, B1); PG8_BAR;
        }
        PG8_STAMP();
        if constexpr (!Epi::AFTER_DRAIN) { E(acc, cur, wr, wc, fr, fq); S.done(cur); }
        PG8_STAMP();
        if (!has_next) break;
#pragma unroll
        for (int a = 0; a < 2; ++a)
#pragma unroll
            for (int b = 0; b < 2; ++b)
#pragma unroll
                for (int m = 0; m < 4; ++m)
#pragma unroll
                    for (int n = 0; n < 2; ++n) acc[a][b][m][n] = (f32x4){0.f, 0.f, 0.f, 0.f};
        cur = nxt; cA = nA; cB = nB; ++ui;
    }
    PG8_WAIT_V(0);
    if (wr == 0) PG8_BAR;
    PG8_BAR;
    if constexpr (Epi::AFTER_DRAIN) { E.fused(acc, cur, wr, wc, fr, fq, lds, wid, lane); S.done(cur); }
    PG8_STAMP();
    if (STAMP && wid == 0) { stamps[lane] = lane < nts ? (((unsigned long long)(unsigned)ts_hi << 32) | (unsigned)ts_lo) : 0ull;
        if (lane == 62) stamps[62] = rt_entry; if (lane == 63) stamps[63] = (unsigned long long)wall_clock64(); }
#undef PG8_STAMP
#undef PG8_SA
#undef PG8_SB
#undef PG8_STAGE
#undef PG8_LDA
#undef PG8_LDB
#undef PG8_MMA
#undef PG8_WAIT_V
#undef PG8_WAIT_L
#undef PG8_BAR
#undef PG8_SCHED
}
}

struct EpiBf16N {
  static constexpr bool PERM = true, AFTER_DRAIN = false;
  unsigned short* O; int ldc; int nvalid; size_t khstride;
  unsigned short* O3;
  __device__ __forceinline__ void operator()(const pg8::f32x4 (&acc)[2][2][4][2], const pg8::Unit& u, int wr, int wc, int fr, int fq) const {
    const int row0 = u.pm * 256 + wr * 64 + fr, col0 = u.pn * 256 + wc * 32 + 8 * fq;
#pragma unroll
    for (int ai = 0; ai < 2; ++ai)
#pragma unroll
      for (int m = 0; m < 4; ++m) {
        unsigned short* rowp = ((O3 && u.kh == 3) ? O3 : O + (size_t)u.kh * khstride) + (size_t)(row0 + ai * 128 + m * 16) * ldc + col0;
#pragma unroll
        for (int bj = 0; bj < 2; ++bj) {
          if (col0 + bj * 128 < nvalid) {
            const pg8::f32x4 v0 = acc[ai][bj][m][0], v1 = acc[ai][bj][m][1];
            pg8::u32x4 w;
            w.x = pg8::cvt_pk_bf16(v0[0], v0[1]); w.y = pg8::cvt_pk_bf16(v0[2], v0[3]); w.z = pg8::cvt_pk_bf16(v1[0], v1[1]); w.w = pg8::cvt_pk_bf16(v1[2], v1[3]);
            asm volatile("global_store_dwordx4 %0, %1, off sc1\n\ts_nop 3" :: "v"(rowp + bj * 128), "v"(w) : "memory");
          }
        }
      }
  }
};


struct SplitKOrder {
  int nM, nN, G, c, NP;
  __device__ void init(int M, int N, int G_, int c_, int np) { nM = M / 256; nN = N / 256; G = G_; c = c_; NP = np; }
  __device__ bool next(int i, pg8::Unit& u) const {
    const int L = i * G + c; if (L >= nM * nN * NP) return false;
    u.kh = L % NP; const int t = L / NP; u.pm = t % nM; u.pn = t / nM; return true;
  }
  __device__ __forceinline__ void a_ready(const pg8::Unit&) const {}
  __device__ __forceinline__ void done(const pg8::Unit&) const {}
};

struct EpiPartF32 {
  static constexpr bool PERM = false, AFTER_DRAIN = false;
  float* P;
  __device__ __forceinline__ void operator()(const pg8::f32x4 (&acc)[2][2][4][2], const pg8::Unit& u, int wr, int wc, int fr, int fq) const {
    const int row0 = u.pm * 256 + wr * 64 + fr, col0 = u.pn * 256 + wc * 32 + 4 * fq;
    float* pb = P + (size_t)u.kh * NTOK * DM;
#pragma unroll
    for (int ai = 0; ai < 2; ++ai)
#pragma unroll
      for (int m = 0; m < 4; ++m) {
        float* rowp = pb + (size_t)(row0 + ai * 128 + m * 16) * DM + col0;
#pragma unroll
        for (int bj = 0; bj < 2; ++bj)
#pragma unroll
          for (int n = 0; n < 2; ++n) *(pg8::f32x4*)(rowp + bj * 128 + n * 16) = acc[ai][bj][m][n];
      }
  }
};


DI void gemm8_step(const Params& p, int s, char* smfull) {
  char* ws = p.ws;
  const u16* A; const u16* Bt; u16* O; u16* O3 = nullptr;
  int N, nvalid, K, ldk, ldc, np; size_t kpart = 0, khstride = 0;
  if (s == 1)      { A = (const u16*)(ws + WS_H);    Bt = (const u16*)(ws + WS_WIN);  N = 7680; nvalid = INW;  K = 1024; ldk = 1024; np = 1; O = (u16*)(ws + WS_Z); ldc = INW; }
  else if (s == 5) { A = (const u16*)(ws + WS_YCAT); Bt = (const u16*)(ws + WS_WBR);  N = 1024; nvalid = 1024; K = 256;  ldk = 1024; np = 4; O = (u16*)(ws + WS_S); ldc = DM;
                     kpart = 512; khstride = (size_t)NTOK * DM; O3 = (u16*)(ws + WS_H); }
  else if (s == 7) { A = (const u16*)(ws + WS_MIX);  Bt = (const u16*)(ws + WS_WOUT); N = 1024; nvalid = 1024; K = 512;  ldk = 1024; np = 2; O = (u16*)(ws + WS_PART); ldc = DM;
                     kpart = 1024; khstride = (size_t)NTOK * DM; }
  else if (s == 9) { A = (const u16*)(ws + WS_H);    Bt = (const u16*)(ws + WS_WUP);  N = DFF2; nvalid = DFF2; K = 1024; ldk = 1024; np = 1; O = (u16*)(ws + WS_Z); ldc = DFF2; }
  else             { A = (const u16*)(ws + WS_ACT);  Bt = (const u16*)(ws + WS_WDN);  N = 1024; nvalid = 1024; K = 1408; ldk = DFF;  np = 2; O = (u16*)(ws + WS_PART); ldc = DM;
                     kpart = 2816; khstride = (size_t)NTOK * DM; }
  asm volatile("" : "+s"(A), "+s"(Bt));
  pg8::Gemm g; g.A = A; g.Bt = Bt; g.M = NTOK; g.N = N; g.K = K; g.ldk = ldk; g.kpart = kpart;
  SplitKOrder S; S.init(NTOK, N, (int)gridDim.x, (int)blockIdx.x, np);
  EpiBf16N E; E.O = O; E.ldc = ldc; E.nvalid = nvalid; E.khstride = khstride; E.O3 = O3;
  pg8::gemm_phase<EpiBf16N, SplitKOrder, false>((PG8_LAS unsigned char*)smfull, g, S, E, nullptr);
}
DI void fold_branch_tok(const Params& p, int tok) {
  const int lane = tid_() & 63;
  const u16* zr = (const u16*)(p.ws + WS_Z) + (size_t)tok * INW + Z_ML;
  u16* mix = (u16*)(p.ws + WS_MIX) + (size_t)tok * DM;
#pragma unroll
  for (int i = 0; i < 4; ++i) {
    const int c = 4 * lane + 256 * i;
    u32x2 gt[4], pv[4];
#pragma unroll
    for (int n = 0; n < 4; ++n) {
      gt[n] = *(const u32x2*)(zr + n * 1024 + c);
      const u16* P = (n == 3) ? (const u16*)(p.ws + WS_H) : (const u16*)(p.ws + WS_S) + (size_t)n * NTOK * DM;
      pv[n] = *(const u32x2*)(P + (size_t)tok * DM + c);
    }
    float m0 = 0.f, m1 = 0.f, m2 = 0.f, m3 = 0.f;
#pragma unroll
    for (int n = 0; n < 4; ++n) {
      m0 += sigmoidf_(lo_bf(gt[n][0])) * lo_bf(pv[n][0]); m1 += sigmoidf_(hi_bf(gt[n][0])) * hi_bf(pv[n][0]);
      m2 += sigmoidf_(lo_bf(gt[n][1])) * lo_bf(pv[n][1]); m3 += sigmoidf_(hi_bf(gt[n][1])) * hi_bf(pv[n][1]);
    }
    u32x2 q; q[0] = pack2(m0, m1); q[1] = pack2(m2, m3);
    *(u32x2*)(mix + c) = q;
  }
}
DI void fold_part_tok(const Params& p, int lprev, int tok) {
  const int lane = tid_() & 63;
  const u16* P = (const u16*)(p.ws + WS_PART);
  const float* g2 = (const float*)(p.ws + WS_MOD) + (lprev * 3 + tok_cond(tok)) * 6144 + 5120;
#pragma unroll
  for (int i = 0; i < 4; ++i) {
    const size_t o = (size_t)tok * DM + 4 * lane + 256 * i;
    float4 x = *(const float4*)(p.out + o);
    const u32x2 pa = *(const u32x2*)(P + o), pb = *(const u32x2*)(P + (size_t)NTOK * DM + o);
    const float4 a = make_float4(lo_bf(pa[0]), hi_bf(pa[0]), lo_bf(pa[1]), hi_bf(pa[1])), b = make_float4(lo_bf(pb[0]), hi_bf(pb[0]), lo_bf(pb[1]), hi_bf(pb[1]));
    const float4 g = *(const float4*)(g2 + 4 * lane + 256 * i);
    x.x += g.x * (a.x + b.x); x.y += g.y * (a.y + b.y); x.z += g.z * (a.z + b.z); x.w += g.w * (a.w + b.w);
    st16_wt(p.out + o, x);
  }
}

DI void conv_act(const Params& p, int l, int gid, int gstride) {
  const u16* u = (const u16*)(p.ws + WS_Z);
  u16* act = (u16*)(p.ws + WS_ACT);
  const float* cw = p.conv_w + (size_t)l * 3 * DFF2;
  const float* cb = p.conv_b + (size_t)l * DFF2;
  for (int idx = gid; idx < (NTOK / 4) * 352; idx += gstride) {
    const int tok0 = (idx / 352) * 4, c0 = (idx % 352) * 8;
    int pos, L;
    if (tok0 < NCTX) { pos = tok0 & 255; L = 256; } else { pos = (tok0 - NCTX) & 1023; L = 1024; }
    u32x4 ua[6], ug[6];
#pragma unroll
    for (int d = 0; d < 6; ++d) {
      const int pp = pos + d - 1;
      if (pp >= 0 && pp < L) {
        const u16* ur = u + (size_t)(tok0 + d - 1) * DFF2;
        ua[d] = *(const u32x4*)(ur + c0); ug[d] = *(const u32x4*)(ur + DFF + c0);
      } else { ua[d] = u32x4{0u, 0u, 0u, 0u}; ug[d] = u32x4{0u, 0u, 0u, 0u}; }
    }
    float wa[3][8], wg[3][8], ba[8], bg[8];
#pragma unroll
    for (int d = 0; d < 3; ++d) {
      const float4 x0 = *(const float4*)(cw + d * DFF2 + c0), x1 = *(const float4*)(cw + d * DFF2 + c0 + 4);
      const float4 y0 = *(const float4*)(cw + d * DFF2 + DFF + c0), y1 = *(const float4*)(cw + d * DFF2 + DFF + c0 + 4);
      wa[d][0] = x0.x; wa[d][1] = x0.y; wa[d][2] = x0.z; wa[d][3] = x0.w; wa[d][4] = x1.x; wa[d][5] = x1.y; wa[d][6] = x1.z; wa[d][7] = x1.w;
      wg[d][0] = y0.x; wg[d][1] = y0.y; wg[d][2] = y0.z; wg[d][3] = y0.w; wg[d][4] = y1.x; wg[d][5] = y1.y; wg[d][6] = y1.z; wg[d][7] = y1.w;
    }
    {
      const float4 x0 = *(const float4*)(cb + c0), x1 = *(const float4*)(cb + c0 + 4);
      const float4 y0 = *(const float4*)(cb + DFF + c0), y1 = *(const float4*)(cb + DFF + c0 + 4);
      ba[0] = x0.x; ba[1] = x0.y; ba[2] = x0.z; ba[3] = x0.w; ba[4] = x1.x; ba[5] = x1.y; ba[6] = x1.z; ba[7] = x1.w;
      bg[0] = y0.x; bg[1] = y0.y; bg[2] = y0.z; bg[3] = y0.w; bg[4] = y1.x; bg[5] = y1.y; bg[6] = y1.z; bg[7] = y1.w;
    }
#pragma unroll
    for (int tt = 0; tt < 4; ++tt) {
      u32x4 o;
#pragma unroll
      for (int q = 0; q < 4; ++q) {
        float a0 = ba[2 * q], a1 = ba[2 * q + 1], g0 = bg[2 * q], g1 = bg[2 * q + 1];
#pragma unroll
        for (int d = 0; d < 3; ++d) {
          a0 += wa[d][2 * q] * lo_bf(ua[tt + d][q]); a1 += wa[d][2 * q + 1] * hi_bf(ua[tt + d][q]);
          g0 += wg[d][2 * q] * lo_bf(ug[tt + d][q]); g1 += wg[d][2 * q + 1] * hi_bf(ug[tt + d][q]);
        }
        o[q] = pack2(g0 * sigmoidf_(g0) * a0, g1 * sigmoidf_(g1) * a1);
      }
      st16_wt(act + (size_t)(tok0 + tt) * DFF + c0, o);
    }
  }
}

DI void prep_wave(const Params& p, int l, int item) {
  const int lane = tid_() & 63;
  char* ws = p.ws;
  u16* qA = (u16*)(ws + WS_QA); u16* qC = (u16*)(ws + WS_QC);
  u16* kA = (u16*)(ws + WS_KA); u16* vA = (u16*)(ws + WS_VA);
  u16* kC = (u16*)(ws + WS_KC); u16* vC = (u16*)(ws + WS_VC);
  if (item >= NTOK) {
    const int cr = item - NTOK, b = cr >> 9, key = cr & 511;
    const size_t keyrow = 4096 + b * 1536 + key;
    const size_t srow = (size_t)(b * 2 + l) * 512 + key;
    float v[12];
#pragma unroll
    for (int u = 0; u < 12; ++u) {
      if (u < 2) v[u] = p.cache_a_k[srow * 128 + u * 64 + lane];
      else if (u < 4) v[u] = p.cache_a_v[srow * 128 + (u - 2) * 64 + lane];
      else if (u < 8) v[u] = p.cache_c_k[srow * 256 + (u - 4) * 64 + lane];
      else v[u] = p.cache_c_v[srow * 256 + (u - 8) * 64 + lane];
    }
#pragma unroll
    for (int u = 0; u < 12; ++u) {
      if (u < 2) kA[keyrow * 128 + u * 64 + lane] = f2bf(v[u]);
      else if (u < 4) vA[keyrow * 128 + (u - 2) * 64 + lane] = f2bf(v[u]);
      else if (u < 8) kC[keyrow * 256 + (u - 4) * 64 + lane] = f2bf(v[u]);
      else vC[keyrow * 256 + (u - 8) * 64 + lane] = f2bf(v[u]);
    }
    return;
  }
  const int tok = item;
  const bool sample = tok >= NCTX;
  int b, pos;
  size_t keyrow;
  if (!sample) { b = tok >> 8; pos = tok & 255; keyrow = tok; }
  else { b = (tok - NCTX) >> 10; pos = (tok - NCTX) & 1023; keyrow = 4096 + b * 1536 + 512 + pos; }
  const size_t crow_o = (size_t)(b * 2 + l) * 256 + pos;
  const u16* zr = (const u16*)(ws + WS_Z) + (size_t)tok * INW;
  const float rowp = (float)(pos >> 6), colp = (float)(pos & 63);
  u16 raw[20];
#pragma unroll
  for (int u = 0; u < 20; ++u) raw[u] = zr[u * 64 + lane];
  float cosA = 1.f, sinA = 0.f, cosC = 1.f, sinC = 0.f;
  if (sample) {
    {
      const int a = lane >> 5, i = lane & 15;
      const float ang = (a ? colp : rowp) * exp2f(-(float)i * (0.0625f * 13.287712379549449f));
      cosA = __cosf(ang); sinA = __sinf(ang);
      if (!((lane >> 4) & 1)) sinA = -sinA;
    }
    {
      const int dd = lane & 31, a = dd >> 4, i = dd & 7;
      const float ang = (a ? colp : rowp) * exp2f(-(float)i * (0.125f * 13.287712379549449f));
      cosC = __cosf(ang); sinC = __sinf(ang);
      if (!((dd >> 3) & 1)) sinC = -sinC;
    }
  }
  const float gaq = p.a_qn_g[l * 64 + lane], gak = p.a_kn_g[l * 64 + lane];
  const float gcq = p.c_qn_g[l * 32 + (lane & 31)], gck = p.c_kn_g[l * 32 + (lane & 31)];
#pragma unroll
  for (int u = 0; u < 20; ++u) {
    const float x = bf2f(raw[u]);
    if (u < 6) {
      const bool isq = u < 4;
      const int hd = isq ? u : u - 4;
      const float ss = wave_sum(x * x);
      float y = x * rsqrtf(ss * (1.f / 64.f) + EPSN) * (isq ? gaq : gak);
      if (!sample && !isq) p.out[O_CAK + crow_o * 128 + hd * 64 + lane] = y;
      if (sample) { const float pr = __shfl_xor(y, 16); y = y * cosA + pr * sinA; }
      if (isq) qA[(size_t)tok * 256 + hd * 64 + lane] = f2bf(y);
      else kA[keyrow * 128 + hd * 64 + lane] = f2bf(y);
    } else if (u < 8) {
      const int hd = u - 6;
      if (!sample) p.out[O_CAV + crow_o * 128 + hd * 64 + lane] = x;
      vA[keyrow * 128 + hd * 64 + lane] = raw[u];
    } else if (u < 16) {
      const bool isq = u < 12;
      const int pr2 = isq ? u - 8 : u - 12;
      float ss = x * x;
#pragma unroll
      for (int o = 16; o >= 1; o >>= 1) ss += __shfl_xor(ss, o);
      float y = x * rsqrtf(ss * (1.f / 32.f) + EPSN) * (isq ? gcq : gck);
      if (!sample && !isq) p.out[O_CCK + crow_o * 256 + pr2 * 64 + lane] = y;
      if (sample) { const float pr = __shfl_xor(y, 8); y = y * cosC + pr * sinC; }
      if (isq) qC[(size_t)tok * 256 + pr2 * 64 + lane] = f2bf(y);
      else kC[keyrow * 256 + pr2 * 64 + lane] = f2bf(y);
    } else {
      const int hd = u - 16;
      if (!sample) p.out[O_CCV + crow_o * 256 + hd * 64 + lane] = x;
      vC[keyrow * 256 + hd * 64 + lane] = raw[u];
    }
  }
}

template <bool ISC>
DI void attn_item(const Params& p, int l, int tok0, int keyrow0, int nkeys, int head, int split, char* smraw) {
  constexpr int NM = ISC ? 2 : 1;
  u16* Ks = (u16*)smraw;
  u16* Vs = Ks + 2 * 64 * 72;
  const u16* qbuf = (const u16*)(p.ws + (ISC ? WS_QC : WS_QA));
  const u16* kbuf = (const u16*)(p.ws + (ISC ? WS_KC : WS_KA));
  const u16* vbuf = (const u16*)(p.ws + (ISC ? WS_VC : WS_VA));
  const int kstride = ISC ? 256 : 128;
  const int koff = ISC ? head * 64 : (head >> 1) * 64;
  const float c2 = (ISC ? 0.17677669529663687f : 0.125f) * 1.4426950408889634f;
  const int t = tid_(), lane = t & 63, w = t >> 6, r = lane & 31, h = lane >> 5;
  const int i16 = lane & 15, tq = i16 >> 2, tp = i16 & 3, blk = (lane >> 4) & 1;
  bf16x8 qf[4];
  {
    const u16* qp = qbuf + (size_t)(tok0 + 32 * w + r) * 256 + head * 64 + 8 * h;
#pragma unroll
    for (int s = 0; s < 4; ++s) qf[s] = *(const bf16x8*)(qp + 16 * s);
  }
  f32x16 O[NM][2];
  float mrun[NM], lsum[NM];
#pragma unroll
  for (int m = 0; m < NM; ++m) {
    mrun[m] = -INFINITY; lsum[m] = 0.f;
#pragma unroll
    for (int d = 0; d < 2; ++d)
#pragma unroll
      for (int e = 0; e < 16; ++e) O[m][d][e] = 0.f;
  }
  const int lrow = t >> 3, lc8 = (t & 7) * 8;
  const u16* kg = kbuf + (size_t)(keyrow0 + lrow) * kstride + koff + lc8;
  const u16* vg = vbuf + (size_t)(keyrow0 + lrow) * kstride + koff + lc8;
  u32x4 rk[2], rv[2];
#pragma unroll
  for (int i = 0; i < 2; ++i) { rk[i] = *(const u32x4*)(kg + (size_t)(32 * i) * kstride); rv[i] = *(const u32x4*)(vg + (size_t)(32 * i) * kstride); }
#pragma unroll
  for (int i = 0; i < 2; ++i) {
    *(u32x4*)(Ks + (lrow + 32 * i) * 72 + lc8) = rk[i];
    *(u32x4*)(Vs + (lrow + 32 * i) * 72 + lc8) = rv[i];
  }
  vb_sync();
  const int NT = nkeys >> 6;
  for (int kt = 0; kt < NT; ++kt) {
    const int buf = kt & 1;
    if (kt + 1 < NT) {
#pragma unroll
      for (int i = 0; i < 2; ++i) {
        rk[i] = *(const u32x4*)(kg + (size_t)((kt + 1) * 64 + 32 * i) * kstride);
        rv[i] = *(const u32x4*)(vg + (size_t)((kt + 1) * 64 + 32 * i) * kstride);
      }
    }
    const u16* kb_ = Ks + buf * 64 * 72;
    const u16* vb_ = Vs + buf * 64 * 72;
#pragma unroll
    for (int kb = 0; kb < 2; ++kb) {
      f32x16 S[NM];
#pragma unroll
      for (int m = 0; m < NM; ++m)
#pragma unroll
        for (int e = 0; e < 16; ++e) S[m][e] = 0.f;
      __builtin_amdgcn_s_setprio(1);
#pragma unroll
      for (int s = 0; s < 4; ++s) {
        const int m = ISC ? (s >> 1) : 0;
        const bf16x8 kf = *(const bf16x8*)(kb_ + (kb * 32 + r) * 72 + 16 * s + 8 * h);
        S[m] = MFMA(kf, qf[s], S[m]);
      }
      __builtin_amdgcn_s_setprio(0);
#pragma unroll
      for (int m = 0; m < NM; ++m) {
        float mx = S[m][0];
#pragma unroll
        for (int e = 1; e < 16; ++e) mx = fmaxf(mx, S[m][e]);
        mx = fmaxf(mx, __shfl_xor(mx, 32));
        const float mnew = fmaxf(mrun[m], mx);
        const float alpha = __builtin_amdgcn_exp2f((mrun[m] - mnew) * c2);
        mrun[m] = mnew;
        const float mc = mnew * c2;
        float ps = 0.f;
#pragma unroll
        for (int e = 0; e < 16; ++e) { const float pe = __builtin_amdgcn_exp2f(S[m][e] * c2 - mc); S[m][e] = pe; ps += pe; }
        lsum[m] = lsum[m] * alpha + ps;
        if (__any(alpha != 1.f)) {
#pragma unroll
          for (int d = 0; d < 2; ++d)
#pragma unroll
            for (int e = 0; e < 16; ++e) O[m][d][e] *= alpha;
        }
      }
#pragma unroll
      for (int st = 0; st < 2; ++st) {
        bf16x8 pf[NM];
#pragma unroll
        for (int m = 0; m < NM; ++m) pf[m] = pack8(S[m], st);
#pragma unroll
        for (int d = 0; d < 2; ++d) {
          const u16* vp = vb_ + (kb * 32 + 16 * st + 4 * h + tq) * 72 + d * 32 + 16 * blk + 4 * tp;
          const bf16x8 vf = trpair(vp, vp + 8 * 72);
          __builtin_amdgcn_s_setprio(1);
#pragma unroll
          for (int m = 0; m < NM; ++m) O[m][d] = MFMA(vf, pf[m], O[m][d]);
          __builtin_amdgcn_s_setprio(0);
        }
      }
    }
    if (kt + 1 < NT) {
      const int nb = (buf ^ 1) * 64 * 72;
#pragma unroll
      for (int i = 0; i < 2; ++i) {
        *(u32x4*)(Ks + nb + (lrow + 32 * i) * 72 + lc8) = rk[i];
        *(u32x4*)(Vs + nb + (lrow + 32 * i) * 72 + lc8) = rv[i];
      }
    }
    vb_sync();
  }
  if (split >= 0) {
    const int ts = tok0 - NCTX + 32 * w + r;
#pragma unroll
    for (int m = 0; m < NM; ++m) {
      const float lt = lsum[m] + __shfl_xor(lsum[m], 32);
      float* op = ISC ? (float*)(p.ws + WS_PC) + ((size_t)((split * 2048 + ts) * 4 + head) * 2 + m) * 64
                      : (float*)(p.ws + WS_PA) + (size_t)((split * 2048 + ts) * 4 + head) * 64;
#pragma unroll
      for (int d = 0; d < 2; ++d)
#pragma unroll
        for (int g = 0; g < 4; ++g)
          st16_wt(op + d * 32 + 8 * g + 4 * h, make_float4(O[m][d][4 * g], O[m][d][4 * g + 1], O[m][d][4 * g + 2], O[m][d][4 * g + 3]));
      if (h == 0) {
        float* mp = (float*)(p.ws + WS_PML) + ((size_t)((split * 2048 + ts) * 8 + (ISC ? 4 : 0) + head) * 2 + m) * 2;
        mp[0] = mrun[m]; mp[1] = lt;
      }
    }
    return;
  }
  float inv[NM];
#pragma unroll
  for (int m = 0; m < NM; ++m) { const float lt = lsum[m] + __shfl_xor(lsum[m], 32); inv[m] = rcp_(lt); }
  const int tok = tok0 + 32 * w + r;
  u16* yc = (u16*)(p.ws + WS_YCAT) + (size_t)tok * 1024;
  if (!ISC) {
#pragma unroll
    for (int d = 0; d < 2; ++d)
#pragma unroll
      for (int g = 0; g < 4; ++g) {
        u32x2 q;
        q[0] = pack2(O[0][d][4 * g] * inv[0], O[0][d][4 * g + 1] * inv[0]);
        q[1] = pack2(O[0][d][4 * g + 2] * inv[0], O[0][d][4 * g + 3] * inv[0]);
        *(u32x2*)(yc + head * 64 + d * 32 + 8 * g + 4 * h) = q;
      }
  } else {
    const float* cl = p.c_lambda + l * 128;
    float d1 = 0.f, d2 = 0.f;
    for (int i = 0; i < 32; ++i) { d1 += cl[i] * cl[32 + i]; d2 += cl[64 + i] * cl[96 + i]; }
    const float lam_init = 0.8f - 0.6f * __expf(-0.3f * (float)l);
    const float lam = __expf(d1) - __expf(d2) + lam_init;
    float ss = 0.f;
#pragma unroll
    for (int d = 0; d < 2; ++d)
#pragma unroll
      for (int e = 0; e < 16; ++e) {
        const float dv = O[0][d][e] * inv[0] - lam * (O[NM - 1][d][e] * inv[NM - 1]);
        O[0][d][e] = dv; ss += dv * dv;
      }
    ss += __shfl_xor(ss, 32);
    const float sc = rsqrtf(ss * (1.f / 64.f) + EPSN) * (1.f - lam_init);
    const float* sg = p.c_subln_g + l * 64;
#pragma unroll
    for (int d = 0; d < 2; ++d)
#pragma unroll
      for (int g = 0; g < 4; ++g) {
        const int dv0 = d * 32 + 8 * g + 4 * h;
        u32x2 q;
        q[0] = pack2(O[0][d][4 * g] * sc * sg[dv0], O[0][d][4 * g + 1] * sc * sg[dv0 + 1]);
        q[1] = pack2(O[0][d][4 * g + 2] * sc * sg[dv0 + 2], O[0][d][4 * g + 3] * sc * sg[dv0 + 3]);
        *(u32x2*)(yc + 512 + head * 64 + dv0) = q;
      }
  }
}
DI void attn_dispatch(const Params& p, int l, int item, char* sm) {
  if (item < 384) {
    const int j = item % 192, split = j / 64, jj = j & 63, b = jj >> 5, qb = (jj >> 2) & 7, head = jj & 3;
    const int tok0 = NCTX + b * 1024 + qb * 128, kr0 = 4096 + b * 1536 + split * 512;
    if (item < 192) attn_item<true>(p, l, tok0, kr0, 512, head, split, sm);
    else attn_item<false>(p, l, tok0, kr0, 512, head, split, sm);
  } else {
    const int j = (item - 384) & 127, sq = j >> 3, qb = (j >> 2) & 1, head = j & 3;
    const int tok0 = sq * 256 + qb * 128, kr0 = sq * 256;
    if (item < 512) attn_item<true>(p, l, tok0, kr0, 256, head, -1, sm);
    else attn_item<false>(p, l, tok0, kr0, 256, head, -1, sm);
  }
}
DI void attn_combine(const Params& p, int l, int item) {
  const int lane = tid_() & 63;
  const int ts = item >> 1, isc = item & 1;
  const float* ml = (const float*)(p.ws + WS_PML);
  u16* yc = (u16*)(p.ws + WS_YCAT) + (size_t)(NCTX + ts) * 1024;
  if (!isc) {
    const float c2 = 0.125f * 1.4426950408889634f;
    float m[4][3], lv[4][3], o[4][3];
#pragma unroll
    for (int hd = 0; hd < 4; ++hd)
#pragma unroll
      for (int sp = 0; sp < 3; ++sp) {
        const float2 mm = *(const float2*)(ml + ((size_t)((sp * 2048 + ts) * 8 + hd) * 2) * 2);
        m[hd][sp] = mm.x; lv[hd][sp] = mm.y;
        o[hd][sp] = ((const float*)(p.ws + WS_PA))[(size_t)((sp * 2048 + ts) * 4 + hd) * 64 + lane];
      }
#pragma unroll
    for (int hd = 0; hd < 4; ++hd) {
      const float M = fmaxf(m[hd][0], fmaxf(m[hd][1], m[hd][2]));
      float num = 0.f, den = 0.f;
#pragma unroll
      for (int sp = 0; sp < 3; ++sp) { const float wgt = exp2f((m[hd][sp] - M) * c2); num += wgt * o[hd][sp]; den += wgt * lv[hd][sp]; }
      yc[hd * 64 + lane] = f2bf(num * rcp_(den));
    }
  } else {
    const float c2 = 0.17677669529663687f * 1.4426950408889634f;
    const float* cl = p.c_lambda + l * 128;
    const float d1 = wave_sum(lane < 32 ? cl[lane] * cl[32 + lane] : 0.f), d2 = wave_sum(lane < 32 ? cl[64 + lane] * cl[96 + lane] : 0.f);
    const float lam_init = 0.8f - 0.6f * __expf(-0.3f * (float)l);
    const float lam = __expf(d1) - __expf(d2) + lam_init;
    const float sgv = p.c_subln_g[l * 64 + lane];
    float m[4][2][3], lv[4][2][3], o[4][2][3];
#pragma unroll
    for (int hd = 0; hd < 4; ++hd)
#pragma unroll
      for (int mm = 0; mm < 2; ++mm)
#pragma unroll
        for (int sp = 0; sp < 3; ++sp) {
          const float2 q = *(const float2*)(ml + ((size_t)((sp * 2048 + ts) * 8 + 4 + hd) * 2 + mm) * 2);
          m[hd][mm][sp] = q.x; lv[hd][mm][sp] = q.y;
          o[hd][mm][sp] = ((const float*)(p.ws + WS_PC))[((size_t)((sp * 2048 + ts) * 4 + hd) * 2 + mm) * 64 + lane];
        }
#pragma unroll
    for (int hd = 0; hd < 4; ++hd) {
      float res[2];
#pragma unroll
      for (int mm = 0; mm < 2; ++mm) {
        const float M = fmaxf(m[hd][mm][0], fmaxf(m[hd][mm][1], m[hd][mm][2]));
        float num = 0.f, den = 0.f;
#pragma unroll
        for (int sp = 0; sp < 3; ++sp) { const float wgt = exp2f((m[hd][mm][sp] - M) * c2); num += wgt * o[hd][mm][sp]; den += wgt * lv[hd][mm][sp]; }
        res[mm] = num * rcp_(den);
      }
      const float dv = res[0] - lam * res[1];
      const float ss = wave_sum(dv * dv);
      const float sc = rsqrtf(ss * (1.f / 64.f) + EPSN) * (1.f - lam_init);
      yc[512 + hd * 64 + lane] = f2bf(dv * sc * sgv);
    }
  }
}

template <bool GLA>
struct ScanCtx { float wa[16]; float ba, lbm, oml; int ldir; };
template <bool GLA>
DI void scan_init(const Params& p, int l, int head, int dirh, int lane, ScanCtx<GLA>& cx) {
  const int ldir = GLA ? (lane >> 5) : dirh;
  cx.ldir = ldir;
  if (GLA) {
    const int kc = lane & 31;
#pragma unroll
    for (int j = 0; j < 16; ++j) cx.wa[j] = p.d_alpha_w[((size_t)(l * 2 + ldir) * 16 + j) * 128 + head * 32 + kc];
    cx.ba = p.d_alpha_b[(l * 2 + ldir) * 128 + head * 32 + kc];
  } else {
    float lb = 0.f;
    if (l > 0) {
      const float x0 = p.b_lb_logits[(ldir * 2 + 0) * 256 + head * 64 + lane], x1 = p.b_lb_logits[(ldir * 2 + 1) * 256 + head * 64 + lane];
      lb = 1.f / (1.f + __expf(x0 - x1));
    }
    cx.lbm = fmaxf(lb, 1e-30f); cx.oml = 1.f - lb;
  }
}
template <bool GLA>
DI float scan_la(const ScanCtx<GLA>& cx, const u16* kraw, const u16* rt, int pp, int lane, float& kk) {
  if (GLA) {
    const u32x4 r0 = *(const u32x4*)(rt + pp * 32 + cx.ldir * 16), r1 = *(const u32x4*)(rt + pp * 32 + cx.ldir * 16 + 8);
    float v = cx.ba;
#pragma unroll
    for (int q = 0; q < 4; ++q) {
      v += cx.wa[2 * q] * lo_bf(r0[q]) + cx.wa[2 * q + 1] * hi_bf(r0[q]);
      v += cx.wa[8 + 2 * q] * lo_bf(r1[q]) + cx.wa[8 + 2 * q + 1] * hi_bf(r1[q]);
    }
    kk = bf2f(kraw[pp * 72 + lane]);
    return (fminf(v, 0.f) - __logf(1.f + __expf(-fabsf(v)))) * (1.f / 16.f);
  } else {
    const float zz = bf2f(kraw[pp * 72 + lane]);
    const float sig = rcp_(1.f + __expf(-zz));
    kk = cx.oml * rcp_(1.f + __expf(zz));
    return __logf(cx.lbm + cx.oml * sig);
  }
}
DI void stage64(u16* dst, const u16* z, int start, int col, int lane) {
  u32x4 v[4];
#pragma unroll
  for (int i = 0; i < 4; ++i) v[i] = *(const u32x4*)(z + (size_t)(start + (lane >> 3) + 8 * i) * INW + col + (lane & 7) * 8);
#pragma unroll
  for (int i = 0; i < 4; ++i) *(u32x4*)(dst + ((lane >> 3) + 8 * i) * 72 + (lane & 7) * 8) = v[i];
}
DI void stage32dup(u16* dst, const u16* z, int start, int col, int lane) {
  const int row = lane >> 1, c16 = (lane & 1) * 16;
  const u16* sp = z + (size_t)(start + row) * INW + col + c16;
  const u32x4 v0 = *(const u32x4*)sp, v1 = *(const u32x4*)(sp + 8);
  *(u32x4*)(dst + row * 72 + c16) = v0; *(u32x4*)(dst + row * 72 + c16 + 8) = v1;
  *(u32x4*)(dst + row * 72 + 32 + c16) = v0; *(u32x4*)(dst + row * 72 + 32 + c16 + 8) = v1;
}
DI void stage_r(u16* rt, const u16* z, int start, int lane) {
  const int row = lane >> 1, c16 = (lane & 1) * 16;
  const u16* sp = z + (size_t)(start + row) * INW + ZD_RF + c16;
  const u32x4 v0 = *(const u32x4*)sp, v1 = *(const u32x4*)(sp + 8);
  *(u32x4*)(rt + row * 32 + c16) = v0; *(u32x4*)(rt + row * 32 + c16 + 8) = v1;
}
DI int tile_id(bool gla, int chunk, int head, int dir) { return gla ? 1536 + chunk * 4 + head : (chunk * 4 + head) * 2 + dir; }

constexpr int S1_WAVE_U16 = 2 * 32 * 72 + 32 * 32;
template <bool GLA>
DI void scan_s1(const Params& p, int l, int chunk, int head, int dir, u16* smw) {
  const int lane = tid_() & 63, r = lane & 31, h = lane >> 5;
  const int i16 = lane & 15, tq = i16 >> 2, tp = i16 & 3, blk = (lane >> 4) & 1;
  u16* ko = smw;
  u16* vt = smw + 32 * 72;
  u16* rt = smw + 2 * 32 * 72;
  const int start = chunk * 32;
  const u16* z = (const u16*)(p.ws + WS_Z);
  stage64(vt, z, start, (GLA ? ZD_V : ZB_I) + head * 64, lane);
  if (GLA) { stage32dup(ko, z, start, ZD_K + head * 32, lane); stage_r(rt, z, start, lane); }
  else stage64(ko, z, start, (dir ? ZB_FB : ZB_FF) + head * 64, lane);
  ScanCtx<GLA> cx;
  scan_init<GLA>(p, l, head, dir, lane, cx);
  wave_sync_();
  float cl_lane;
  {
    const int ldir = cx.ldir;
    float kk, cum = 0.f;
#pragma unroll 8
    for (int i = 0; i < 32; ++i) {
      const int pp = ldir ? 31 - i : i;
      cum += scan_la<GLA>(cx, ko, rt, pp, lane, kk);
      ko[pp * 72 + lane] = f2bf(kk * __expf(-cum));
    }
    cl_lane = cum;
    ((float*)(p.ws + WS_CL))[tile_id(GLA, chunk, head, dir) * 64 + lane] = cum;
  }
  wave_sync_();
  f32x16 acc[2][2];
  zero_acc<2>(acc);
#pragma unroll
  for (int st = 0; st < 2; ++st) {
    bf16x8 a[2], b[2];
#pragma unroll
    for (int x = 0; x < 2; ++x) {
      const u16* ap = vt + (16 * st + 8 * h + tq) * 72 + x * 32 + 16 * blk + 4 * tp;
      a[x] = trpair(ap, ap + 4 * 72);
      const u16* bp = ko + (16 * st + 8 * h + tq) * 72 + x * 32 + 16 * blk + 4 * tp;
      b[x] = trpair(bp, bp + 4 * 72);
    }
#pragma unroll
    for (int x = 0; x < 2; ++x)
#pragma unroll
      for (int y = 0; y < 2; ++y) acc[x][y] = MFMA(a[x], b[y], acc[x][y]);
  }
  {
    float* U = (float*)(p.ws + WS_U) + (size_t)tile_id(GLA, chunk, head, dir) * 4096;
    const float ecl_own = __expf(cl_lane);
    float ecl[2];
    ecl[0] = __shfl(ecl_own, r); ecl[1] = __shfl(ecl_own, 32 + r);
#pragma unroll
    for (int x = 0; x < 2; ++x)
#pragma unroll
      for (int y = 0; y < 2; ++y)
#pragma unroll
        for (int e = 0; e < 16; ++e) U[(x * 32 + crow(e, h)) * 64 + y * 32 + r] = acc[x][y][e] * ecl[y];
  }
  wave_sync_();
}
DI void scan_s1_block(const Params& p, int l, int bitem, char* sm) {
  const int w = tid_() >> 6;
  int wi = bitem * 4 + w;
  u16* smw = (u16*)sm + w * S1_WAVE_U16;
  if (bitem < 384) scan_s1<false>(p, l, wi >> 3, (wi >> 1) & 3, wi & 1, smw);
  else { wi -= 1536; scan_s1<true>(p, l, wi >> 2, wi & 3, 0, smw); }
}

DI void scan_s2_item(const Params& p, int l, int item) {
  const int t = tid_();
  const int unit = item >> 2, vq = item & 3;
  bool gla;
  int seq, head, dir;
  if (unit < 16) { gla = false; seq = 16 + (unit >> 3); head = (unit >> 1) & 3; dir = unit & 1; }
  else if (unit < 24) { gla = true; const int g = unit - 16; seq = 16 + (g >> 2); head = g & 3; dir = 0; }
  else if (unit < 152) { gla = false; const int u = unit - 24; seq = u >> 3; head = (u >> 1) & 3; dir = u & 1; }
  else { gla = true; const int g = unit - 152; seq = g >> 2; head = g & 3; dir = 0; }
  const int c = t & 63;
  const int dc = gla ? (c >> 5) : dir;
  int N, chunk0;
  if (seq < 16) { N = 8; chunk0 = seq * 8; } else { N = 32; chunk0 = 128 + (seq - 16) * 32; }
  float S[4];
  int vv[4];
#pragma unroll
  for (int i = 0; i < 4; ++i) {
    vv[i] = vq * 16 + (t >> 6) + 4 * i;
    if (seq < 16) S[i] = 0.f;
    else {
      const int b = seq - 16;
      S[i] = gla ? p.state_gla[(size_t)(((b * 2 + l) * 2 + dc) * 4 + head) * 2048 + (c & 31) * 64 + vv[i]]
                 : p.state_hgrn[(size_t)(((b * 2 + l) * 2 + dc) * 4 + head) * 4096 + c * 64 + vv[i]];
    }
  }
  const float* __restrict__ U = (const float*)(p.ws + WS_U);
  const float* __restrict__ CL = (const float*)(p.ws + WS_CL);
  float* __restrict__ SS = (float*)(p.ws + WS_S);
  for (int m0 = 0; m0 < N; m0 += 8) {
    float tmp[8][4], a[8];
    int ids[8];
#pragma unroll
    for (int mm = 0; mm < 8; ++mm) {
      const int m = m0 + mm;
      ids[mm] = tile_id(gla, chunk0 + (dc ? N - 1 - m : m), head, dir);
      a[mm] = CL[ids[mm] * 64 + c];
#pragma unroll
      for (int i = 0; i < 4; ++i) tmp[mm][i] = U[(size_t)ids[mm] * 4096 + vv[i] * 64 + c];
    }
#pragma unroll
    for (int mm = 0; mm < 8; ++mm) {
      const float ea = __expf(a[mm]);
#pragma unroll
      for (int i = 0; i < 4; ++i) {
        SS[(size_t)ids[mm] * 4096 + vv[i] * 64 + c] = S[i];
        S[i] = ea * S[i] + tmp[mm][i];
      }
    }
  }
  if (seq < 16) {
#pragma unroll
    for (int i = 0; i < 4; ++i) {
      if (gla) p.out[O_SG + (size_t)(((seq * 2 + l) * 2 + dc) * 4 + head) * 2048 + (c & 31) * 64 + vv[i]] = S[i];
      else p.out[O_SH + (size_t)(((seq * 2 + l) * 2 + dc) * 4 + head) * 4096 + c * 64 + vv[i]] = S[i];
    }
  }
}

constexpr int S3_WAVE_U16 = 3 * 32 * 72 + 128 + 32 * 32;
template <bool GLA>
DI void scan_s3(const Params& p, int l, int chunk, int head, u16* smw) {
  const int lane = tid_() & 63, r = lane & 31, h = lane >> 5;
  const int i16 = lane & 15, tq = i16 >> 2, tp = i16 & 3, blk = (lane >> 4) & 1;
  u16* qt = smw;
  u16* kt = smw + 32 * 72;
  u16* vt = smw + 2 * 32 * 72;
  float* sref = (float*)(smw + 3 * 32 * 72);
  u16* rt = smw + 3 * 32 * 72 + 128;
  const int start = chunk * 32;
  const u16* z = (const u16*)(p.ws + WS_Z);
  stage64(vt, z, start, (GLA ? ZD_V : ZB_I) + head * 64, lane);
  if (GLA) stage_r(rt, z, start, lane);
  f32x16 o[2];
#pragma unroll
  for (int x = 0; x < 2; ++x)
#pragma unroll
    for (int e = 0; e < 16; ++e) o[x][e] = 0.f;
  constexpr int NPASS = GLA ? 1 : 2;
#pragma unroll 1
  for (int pass = 0; pass < NPASS; ++pass) {
    if (GLA) { stage32dup(qt, z, start, ZD_Q + head * 32, lane); stage32dup(kt, z, start, ZD_K + head * 32, lane); }
    else { stage64(qt, z, start, ZB_Q + head * 64, lane); stage64(kt, z, start, (pass ? ZB_FB : ZB_FF) + head * 64, lane); }
    const float* Sg = (const float*)(p.ws + WS_S) + (size_t)tile_id(GLA, chunk, head, pass) * 4096;
    ScanCtx<GLA> cx;
    scan_init<GLA>(p, l, head, pass, lane, cx);
    wave_sync_();
    {
      const int ldir = cx.ldir;
      float kk, cum = 0.f;
      const float ref = 0.5f * ((const float*)(p.ws + WS_CL))[tile_id(GLA, chunk, head, pass) * 64 + lane];
      sref[lane] = __expf(ref);
#pragma unroll 8
      for (int i = 0; i < 32; ++i) {
        const int pp = ldir ? 31 - i : i;
        cum += scan_la<GLA>(cx, kt, rt, pp, lane, kk);
        const float zq = bf2f(qt[pp * 72 + lane]);
        const float qv = GLA ? zq * 0.17677669529663687f : zq * sigmoidf_(zq);
        qt[pp * 72 + lane] = f2bf(qv * __expf(cum - ref));
        kt[pp * 72 + lane] = f2bf(kk * __expf(ref - cum));
      }
    }
    wave_sync_();
    constexpr int NS = GLA ? 2 : 1;
    f32x16 sc[NS];
#pragma unroll
    for (int m = 0; m < NS; ++m)
#pragma unroll
      for (int e = 0; e < 16; ++e) sc[m][e] = 0.f;
    bf16x8 qfr[4];
#pragma unroll
    for (int st = 0; st < 4; ++st) {
      qfr[st] = *(const bf16x8*)(qt + r * 72 + 16 * st + 8 * h);
      const bf16x8 kf = *(const bf16x8*)(kt + r * 72 + 16 * st + 8 * h);
      const int m = GLA ? (st >> 1) : 0;
      sc[m] = MFMA(kf, qfr[st], sc[m]);
    }
#pragma unroll
    for (int m = 0; m < NS; ++m) {
      const int d = GLA ? m : pass;
#pragma unroll
      for (int e = 0; e < 16; ++e) {
        const int srow = crow(e, h);
        const bool keep = d ? (srow >= r) : (srow <= r);
        sc[m][e] = keep ? sc[m][e] : 0.f;
      }
#pragma unroll
      for (int st = 0; st < 2; ++st) {
        const bf16x8 pf = pack8(sc[m], st);
#pragma unroll
        for (int x = 0; x < 2; ++x) {
          const u16* vp = vt + (16 * st + 4 * h + tq) * 72 + x * 32 + 16 * blk + 4 * tp;
          const bf16x8 vf = trpair(vp, vp + 8 * 72);
          o[x] = MFMA(vf, pf, o[x]);
        }
      }
    }
#pragma unroll
    for (int x = 0; x < 2; ++x) {
      float4 s0[4], s1[4];
#pragma unroll
      for (int st = 0; st < 4; ++st) {
        const float* sp = Sg + (x * 32 + r) * 64 + 16 * st + 8 * h;
        s0[st] = *(const float4*)sp; s1[st] = *(const float4*)(sp + 4);
      }
#pragma unroll
      for (int st = 0; st < 4; ++st) {
        const float4 e0 = *(const float4*)(sref + 16 * st + 8 * h), e1 = *(const float4*)(sref + 16 * st + 8 * h + 4);
        u32x4 q;
        q[0] = pack2(s0[st].x * e0.x, s0[st].y * e0.y); q[1] = pack2(s0[st].z * e0.z, s0[st].w * e0.w);
        q[2] = pack2(s1[st].x * e1.x, s1[st].y * e1.y); q[3] = pack2(s1[st].z * e1.z, s1[st].w * e1.w);
        o[x] = MFMA(__builtin_bit_cast(bf16x8, q), qfr[st], o[x]);
      }
    }
    wave_sync_();
  }
  float ss = 0.f;
#pragma unroll
  for (int x = 0; x < 2; ++x)
#pragma unroll
    for (int e = 0; e < 16; ++e) ss += o[x][e] * o[x][e];
  ss += __shfl_xor(ss, 32);
  const float rstd = rsqrtf(ss * (1.f / 64.f) + EPSN);
  const int tok = start + r;
  const float* gn = (GLA ? p.d_norm_g : p.b_norm_g) + l * 64;
  const u16* gz = z + (size_t)tok * INW + (GLA ? ZD_G : ZB_G) + head * 64;
  u16* yc = (u16*)(p.ws + WS_YCAT) + (size_t)tok * 1024 + (GLA ? 768 : 256) + head * 64;
#pragma unroll
  for (int x = 0; x < 2; ++x)
#pragma unroll
    for (int g = 0; g < 4; ++g) {
      const int v0 = x * 32 + 8 * g + 4 * h;
      const u32x2 gr = *(const u32x2*)(gz + v0);
      const float g0 = lo_bf(gr[0]), g1 = hi_bf(gr[0]), g2 = lo_bf(gr[1]), g3 = hi_bf(gr[1]);
      u32x2 q;
      q[0] = pack2(o[x][4 * g] * rstd * gn[v0] * g0 * sigmoidf_(g0), o[x][4 * g + 1] * rstd * gn[v0 + 1] * g1 * sigmoidf_(g1));
      q[1] = pack2(o[x][4 * g + 2] * rstd * gn[v0 + 2] * g2 * sigmoidf_(g2), o[x][4 * g + 3] * rstd * gn[v0 + 3] * g3 * sigmoidf_(g3));
      *(u32x2*)(yc + v0) = q;
    }
}
DI void scan_s3_block(const Params& p, int l, int bitem, char* sm) {
  const int w = tid_() >> 6;
  u16* smw = (u16*)sm + w * S3_WAVE_U16;
  int wi = bitem * 4 + w;
  if (bitem < 192) scan_s3<false>(p, l, wi >> 2, wi & 3, smw);
  else { wi -= 768; scan_s3<true>(p, l, wi >> 2, wi & 3, smw); }
}

DI void run_phase(const Params& p, int ph, char* smfull, bool dry) {
  const int half = __builtin_amdgcn_readfirstlane(__builtin_amdgcn_workitem_id_x() >> 8);
  const int bid = 2 * blockIdx.x + half, nb = 2 * gridDim.x;
  char* sm = smfull + half * SMEM_BYTES;
#ifdef PHASE_ONLY
  if (ph != 0 && (ph - 1) % 11 != PHASE_ONLY - 1) return;
  if (ph == 0 && PHASE_ONLY != 0) return;
#endif
  if (ph == 0) {
    if (nb == 512) {
      const int vb = (int)blockIdx.x + 256 * half;
      if (vb < MOD_ITEMS) {
        mod_item(p, vb, sm);
        for (int j = 0; j < 6; ++j) { const int q = 6 * vb + j; convw_item(p, 0, q < 1872 ? q : q + 512, sm); }
      } else {
        for (int q = 6 * MOD_ITEMS + (vb - MOD_ITEMS); q < 3280; q += 128) convw_item(p, 0, q < 1872 ? q : q + 512, sm);
      }
    } else {
      for (int it = bid; it < MOD_ITEMS + CONVW_ITEMS; it += nb) {
        if (it < MOD_ITEMS) mod_item(p, it, sm); else convw_item(p, 0, it - MOD_ITEMS, sm);
      }
    }
    return;
  }
  if (ph == 25) {
    const int w = tid_() >> 6;
    for (int tk = bid * 4 + w; tk < NTOK; tk += nb * 4) fold_part_tok(p, 1, tk);
    return;
  }
  const int l = (ph - 1) / 12, s = (ph - 1) % 12;
  if (s == 1 || s == 5 || s == 7 || s == 9 || s == 11) {
    gemm8_step(p, s, smfull);
    if (l == 0 && nb == 512) {
      if (s == 1 && blockIdx.x >= 208) { for (int it = 1872 + 2 * ((int)blockIdx.x - 208) + half; it < 2384; it += 96) convw_item(p, 0, it, sm); }
      else if (s == 7 && blockIdx.x >= 192) { for (int it = 2 * ((int)blockIdx.x - 192) + half; it < 384; it += 128) convw_item(p, 1, it, sm); }
      else if (s == 9 && blockIdx.x >= 16) {
        for (int it = 3792 + 2 * ((int)blockIdx.x - 16) + half; it < 4496; it += 480) convw_item(p, 0, it, sm);
        for (int it = 384 + 2 * ((int)blockIdx.x - 16) + half; it < 2384; it += 480) convw_item(p, 1, it, sm);
      }
      else if (s == 11 && blockIdx.x >= 192) { for (int it = 2384 + 2 * ((int)blockIdx.x - 192) + half; it < 3664; it += 128) convw_item(p, 1, it, sm); }
    }
    return;
  }
  switch (s) {
    case 0: {
      const int w = tid_() >> 6;
      for (int tk = bid * 4 + w; tk < NTOK; tk += nb * 4) norm_tok(p, l, 0, tk);
      if (l > 0) for (int it = (nb == 512 ? 3664 : 0) + bid; it < CONVW_ITEMS; it += nb) convw_item(p, l, it, sm);
    } break;
    case 2:
      if (nb == 512) {
        const int vb = (int)blockIdx.x + 256 * half;
        scan_s1_block(p, l, vb, sm);
        if (vb < 64) scan_s1_block(p, l, 512 + vb, sm);
        else for (int j = 0; j < 4; ++j) prep_wave(p, l, (4 * (vb - 64) + j) * 4 + (tid_() >> 6));
      } else {
        for (int it = bid; it < 576 + 1792; it += nb) {
          if (it < 576) scan_s1_block(p, l, it, sm); else prep_wave(p, l, (it - 576) * 4 + (tid_() >> 6));
        }
      }
      break;
    case 3:
      if (nb == 512) {
        const int bid = (int)blockIdx.x + 256 * half;
        if (bid < 192) attn_dispatch(p, l, bid, sm);
        else if (bid < 320) { attn_dispatch(p, l, bid, sm); attn_dispatch(p, l, 512 + (bid - 192), sm); scan_s2_item(p, l, 96 + 640 + (bid - 192)); }
        else if (bid < 384) { attn_dispatch(p, l, bid, sm); for (int j = 0; j < 6; ++j) scan_s2_item(p, l, 96 + 6 * (bid - 320) + j); }
        else if (bid < 480) { scan_s2_item(p, l, bid - 384); attn_dispatch(p, l, bid, sm); }
        else { attn_dispatch(p, l, bid, sm); for (int j = 0; j < 8; ++j) scan_s2_item(p, l, 96 + 384 + 8 * (bid - 480) + j); }
      } else {
        for (int it = bid; it < 640 + 864; it += nb) {
          if (it < 96) scan_s2_item(p, l, it);
          else if (it < 480) attn_dispatch(p, l, it - 96, sm);
          else if (it < 1248) scan_s2_item(p, l, it - 384);
          else attn_dispatch(p, l, it - 864, sm);
        }
      }
      break;
    case 4:
      if (nb == 512) {
        const int vb = (int)blockIdx.x + 256 * half;
        if (vb < 384) scan_s3_block(p, l, vb, sm);
        else for (int j = 0; j < 8; ++j) attn_combine(p, l, (8 * (vb - 384) + j) * 4 + (tid_() >> 6));
      } else {
        for (int it = bid; it < 384 + 1024; it += nb) {
          if (it < 384) scan_s3_block(p, l, it, sm); else attn_combine(p, l, (it - 384) * 4 + (tid_() >> 6));
        }
      }
      break;
    case 6: {
      const int w = tid_() >> 6;
      for (int tk = bid * 4 + w; tk < NTOK; tk += nb * 4) fold_branch_tok(p, tk);
    } break;
    case 8: {
      const int w = tid_() >> 6;
      for (int tk = bid * 4 + w; tk < NTOK; tk += nb * 4) norm_tok(p, l, 1, tk);
    } break;
    case 10: conv_act(p, l, bid * 256 + tid_(), nb * 256); break;
  }
}

constexpr int DYN_LDS = 2 * SMEM_BYTES + 32;
__global__ void __launch_bounds__(512, 2) fwd_mega(Params p) {
  extern __shared__ __attribute__((aligned(16))) char sm[];
  uint4* xbw = (uint4*)(sm + 2 * SMEM_BYTES);
  cg::grid_group grid = cg::this_grid();
  if (p.coop == 2) grid.sync();
  if (__builtin_amdgcn_workitem_id_x() == 0) { xbw[0] = make_uint4(0u, 0u, 0u, 0u); xbw[1] = make_uint4(0u, 0u, 0u, 0u); }
  __syncthreads();
  XcdBarrier xb;
  if (p.coop) xb = xcd_barrier_post((unsigned*)(p.ws + WS_BAR), (volatile LAS unsigned*)xbw);
  for (int ph = p.phase_begin; ph < p.phase_end; ++ph) {
    if (ph > p.phase_begin && p.coop) xcd_barrier(xb);
    const int stepid = ph == 0 ? 12 : (ph == 25 ? 13 : (ph - 1) % 12);
    const int reps = (stepid == p.pad - 1) ? 2 : 1;
    for (int rep = 0; rep < reps; ++rep) {
      if (rep && p.coop) xcd_barrier(xb);
      run_phase(p, ph, sm, false);
    }
  }
}

extern "C" void kernel_launch(void* const* d_in, const int* in_sizes, int n_in, void* d_out, int out_size, void* d_ws,
                              size_t ws_size, hipStream_t stream) {
  static int grid_blocks = 0;
  if (!grid_blocks) {
    int dev = 0, cus = 0, per_cu = 0;
    (void)hipGetDevice(&dev);
    (void)hipDeviceGetAttribute(&cus, hipDeviceAttributeMultiprocessorCount, dev);
    (void)hipFuncSetAttribute((const void*)fwd_mega, hipFuncAttributeMaxDynamicSharedMemorySize, DYN_LDS);
    (void)hipOccupancyMaxActiveBlocksPerMultiprocessor(&per_cu, fwd_mega, 512, DYN_LDS);
    if (per_cu > 1) per_cu = 1;
    if (per_cu < 1) per_cu = 1;
    grid_blocks = cus * per_cu;
  }
  Params p{};
  const float** pp = (const float**)&p;
  for (int i = 0; i < 32; ++i) pp[i] = (const float*)d_in[i];
  p.out = (float*)d_out;
  p.ws = (char*)d_ws;
  if (ws_size < WS_END) { fprintf(stderr, "workspace too small: %zu < %zu\n", ws_size, (size_t)WS_END); return; }
  p.phase_begin = 0; p.phase_end = NPHASE; p.coop = 1; p.pad = PROBE_STEP + 1;
  (void)hipMemsetAsync((char*)d_ws + WS_BAR, 0, 16384, stream);
  void* args[] = {&p};
  hipError_t e = hipLaunchCooperativeKernel((void*)fwd_mega, dim3(grid_blocks), dim3(512), args, DYN_LDS, stream);
  if (e != hipSuccess) fprintf(stderr, "cooperative launch failed: %s (grid %d)\n", hipGetErrorString(e), grid_blocks);
}
```
